# Optimizing an MI355X kernel written in HIP

```python
import math
import jax, jax.numpy as jnp
from jax import lax
import numpy as np

D_MODEL = 1024
BATCH = 8
SEQ = 4096
DEPTH = 2

HEAD_DIM = 64
N_MOBA_HEADS = 6
N_FOX_HEADS = 6
CONV_CH = 256
MOBA_W = N_MOBA_HEADS * HEAD_DIM
FOX_W = N_FOX_HEADS * HEAD_DIM
MIX_W = MOBA_W + FOX_W + CONV_CH
SPLIT_SIZES = [MOBA_W, MOBA_W, MOBA_W, FOX_W, FOX_W, FOX_W, N_FOX_HEADS, CONV_CH, CONV_CH, CONV_CH]
IN_W = int(sum(SPLIT_SIZES))
SPLIT_IDX = [int(v) for v in np.cumsum(SPLIT_SIZES)[:-1]]
MOBA_BLOCK = 256
MOBA_TOPK = 3
MOBA_Q_CHUNK = 32
FOX_Q_BLOCK = 128
CONV_WIDTH = 3
REL_BUCKETS = 32
REL_MAX_DIST = 128
D_FF = -(-8 * D_MODEL // (3 * 256)) * 256
RMS_EPS = 1e-6

kernel_name = "hybrid_moba_fox_shortconv_block"


def rms_norm(x, g):
    xf = x.astype(jnp.float32)
    y = xf * lax.rsqrt(jnp.mean(xf * xf, axis=-1, keepdims=True) + RMS_EPS)
    return (y * g.astype(jnp.float32)).astype(x.dtype)


def t5_bucket(dist):
    max_exact = REL_BUCKETS // 2
    n = jnp.maximum(dist, 0)
    nf = jnp.maximum(n, 1).astype(jnp.float32)
    large = max_exact + (jnp.log(nf / max_exact) / math.log(REL_MAX_DIST / max_exact)
                         * (REL_BUCKETS - max_exact)).astype(jnp.int32)
    large = jnp.minimum(large, REL_BUCKETS - 1)
    return jnp.where(n < max_exact, n, large)


def moba_attention(q, k, v, rel_bias):
    B, H, S, Dh = q.shape
    nb = -(-S // MOBA_BLOCK)
    pad = nb * MOBA_BLOCK - S
    kp = jnp.pad(k, ((0, 0), (0, 0), (0, pad), (0, 0)))
    vp = jnp.pad(v, ((0, 0), (0, 0), (0, pad), (0, 0)))
    kb = kp.reshape(B, H, nb, MOBA_BLOCK, Dh)
    vb = vp.reshape(B, H, nb, MOBA_BLOCK, Dh)
    kmean = jnp.mean(kb.astype(jnp.float32), axis=3)
    topk = min(MOBA_TOPK, nb)
    scale = Dh ** -0.5
    rb = rel_bias.astype(jnp.float32)
    rb_t = rb.T
    b_idx = jnp.arange(B)[:, None, None, None]
    h_idx = jnp.arange(H)[None, :, None, None]
    offs = jnp.arange(MOBA_BLOCK)
    C = MOBA_Q_CHUNK
    nC = S // C
    q_chunks = q.reshape(B, H, nC, C, Dh).transpose(2, 0, 1, 3, 4)

    def chunk(args):
        qc, c = args
        t = c * C + jnp.arange(C)
        own = (c * C) // MOBA_BLOCK
        gate = jnp.einsum('bhcd,bhnd->bhcn', qc.astype(jnp.float32), kmean)
        gate = jnp.where(jnp.arange(nb) < own, gate, -jnp.inf)
        _, sel = lax.top_k(gate, topk)
        sel_ok = jnp.arange(topk) < own
        kg = kb[b_idx, h_idx, sel]
        vg = vb[b_idx, h_idx, sel]
        kpos = sel[..., None] * MOBA_BLOCK + offs
        lg = jnp.einsum('bhcd,bhcjpd->bhcjp', qc, kg).astype(jnp.float32) * scale
        lg = lg + rb_t[h_idx[..., None], t5_bucket(t[None, None, :, None, None] - kpos)]
        lg = jnp.where(sel_ok[:, None], lg, -jnp.inf)
        ko = lax.dynamic_slice_in_dim(kp, own * MOBA_BLOCK, MOBA_BLOCK, axis=2)
        vo = lax.dynamic_slice_in_dim(vp, own * MOBA_BLOCK, MOBA_BLOCK, axis=2)
        dist = t[:, None] - (own * MOBA_BLOCK + offs)[None, :]
        lo = jnp.einsum('bhcd,bhpd->bhcp', qc, ko).astype(jnp.float32) * scale
        lo = lo + jnp.transpose(rb[t5_bucket(dist)], (2, 0, 1))
        lo = jnp.where(dist >= 0, lo, -jnp.inf)
        logits = jnp.concatenate([lo, lg.reshape(B, H, C, topk * MOBA_BLOCK)], axis=-1)
        p = jax.nn.softmax(logits, axis=-1).astype(v.dtype)
        po = p[..., :MOBA_BLOCK]
        pg = p[..., MOBA_BLOCK:].reshape(B, H, C, topk, MOBA_BLOCK)
        return (jnp.einsum('bhcp,bhpd->bhcd', po, vo)
                + jnp.einsum('bhcjp,bhcjpd->bhcd', pg, vg))

    out = lax.map(chunk, (q_chunks, jnp.arange(nC)))
    return out.transpose(1, 2, 0, 3, 4).reshape(B, H, S, Dh)


def forgetting_attention(q, k, v, log_f):
    B, H, S, Dh = q.shape
    scale = Dh ** -0.5
    cum = lax.cumsum(log_f, axis=2)
    nQ = S // FOX_Q_BLOCK
    qb = q.reshape(B, H, nQ, FOX_Q_BLOCK, Dh).transpose(2, 0, 1, 3, 4)
    cb = cum.reshape(B, H, nQ, FOX_Q_BLOCK).transpose(2, 0, 1, 3)
    kpos = jnp.arange(S)

    def blk(args):
        qi, ci, i = args
        t = i * FOX_Q_BLOCK + jnp.arange(FOX_Q_BLOCK)
        lg = (jnp.einsum('bhqd,bhsd->bhqs', qi, k).astype(jnp.float32) * scale
              + ci[..., None] - cum[:, :, None, :])
        lg = jnp.where(kpos[None, :] <= t[:, None], lg, -jnp.inf)
        p = jax.nn.softmax(lg, axis=-1).astype(v.dtype)
        return jnp.einsum('bhqs,bhsd->bhqd', p, v)

    out = lax.map(blk, (qb, cb, jnp.arange(nQ)))
    return out.transpose(1, 2, 0, 3, 4).reshape(B, H, S, Dh)


def short_conv_mixer(gate_b, gate_c, h, conv_w):
    u = gate_c * h
    y = lax.conv_general_dilated(u, conv_w[:, None, :].astype(u.dtype), window_strides=(1,),
                                 padding=[(CONV_WIDTH - 1, 0)],
                                 dimension_numbers=('NWC', 'WIO', 'NWC'),
                                 feature_group_count=CONV_CH)
    return gate_b * y


def hybrid_layer(x, w_in, b_f, conv_w, w_out, rel_bias, g_pre_mix, g_post_mix,
                 g_pre_ffn, g_post_ffn, w_gate, w_up, w_down):
    B, S, _ = x.shape
    hn = rms_norm(x, g_pre_mix)
    proj = hn @ w_in
    mq, mk, mv, fq, fk, fv, f_logit, cvb, cvc, cvh = jnp.split(proj, SPLIT_IDX, axis=-1)

    def heads(t, n):
        return t.reshape(B, S, n, HEAD_DIM).transpose(0, 2, 1, 3)

    def merge(o):
        return o.transpose(0, 2, 1, 3).reshape(B, S, -1)

    moba = moba_attention(heads(mq, N_MOBA_HEADS), heads(mk, N_MOBA_HEADS),
                          heads(mv, N_MOBA_HEADS), rel_bias)
    log_f = jax.nn.log_sigmoid((f_logit + b_f).astype(jnp.float32)).transpose(0, 2, 1)
    fox = forgetting_attention(heads(fq, N_FOX_HEADS), heads(fk, N_FOX_HEADS),
                               heads(fv, N_FOX_HEADS), log_f)
    conv = short_conv_mixer(cvb, cvc, cvh, conv_w)
    mixed = jnp.concatenate([merge(moba), merge(fox), conv], axis=-1) @ w_out
    x = x + rms_norm(mixed, g_post_mix)
    h2 = rms_norm(x, g_pre_ffn)
    ff = (jax.nn.silu(h2 @ w_gate) * (h2 @ w_up)) @ w_down
    return x + rms_norm(ff, g_post_ffn)


def setup_inputs(seed: int = 0) -> dict:
    key = jax.random.key(seed)
    ks = jax.random.split(key, 14)
    f32 = jnp.float32
    nrm = lambda k, shape, s: (jax.random.normal(k, shape, f32) * s).astype(f32)
    return {
        "x": nrm(ks[0], (BATCH, SEQ, D_MODEL), 1.0),
        "w_in": nrm(ks[1], (DEPTH, D_MODEL, IN_W), D_MODEL ** -0.5),
        "b_f": 2.0 + nrm(ks[2], (DEPTH, N_FOX_HEADS), 0.1),
        "conv_w": nrm(ks[3], (DEPTH, CONV_WIDTH, CONV_CH), CONV_WIDTH ** -0.5),
        "w_out": nrm(ks[4], (DEPTH, MIX_W, D_MODEL), MIX_W ** -0.5),
        "rel_bias": nrm(ks[5], (REL_BUCKETS, N_MOBA_HEADS), 0.5),
        "g_pre_mix": 1.0 + nrm(ks[6], (DEPTH, D_MODEL), 0.05),
        "g_post_mix": 1.0 + nrm(ks[7], (DEPTH, D_MODEL), 0.05),
        "g_pre_ffn": 1.0 + nrm(ks[8], (DEPTH, D_MODEL), 0.05),
        "g_post_ffn": 1.0 + nrm(ks[9], (DEPTH, D_MODEL), 0.05),
        "w_gate": nrm(ks[10], (DEPTH, D_MODEL, D_FF), D_MODEL ** -0.5),
        "w_up": nrm(ks[11], (DEPTH, D_MODEL, D_FF), D_MODEL ** -0.5),
        "w_down": nrm(ks[12], (DEPTH, D_FF, D_MODEL), D_FF ** -0.5),
    }


def reference(x, w_in, b_f, conv_w, w_out, rel_bias, g_pre_mix, g_post_mix,
              g_pre_ffn, g_post_ffn, w_gate, w_up, w_down):
    for l in range(DEPTH):
        x = hybrid_layer(x, w_in[l], b_f[l], conv_w[l], w_out[l], rel_bias,
                         g_pre_mix[l], g_post_mix[l], g_pre_ffn[l], g_post_ffn[l],
                         w_gate[l], w_up[l], w_down[l])
    return x
```

```cpp
#include <hip/hip_runtime.h>
#include <cstdio>
#include <cstdint>

typedef unsigned short bf16;
typedef short bf16x8 __attribute__((ext_vector_type(8)));
typedef float f32x4 __attribute__((ext_vector_type(4)));
typedef unsigned u32x4 __attribute__((ext_vector_type(4)));
typedef unsigned u32x2 __attribute__((ext_vector_type(2)));

constexpr int DM = 1024, BATCH = 8, SEQ = 4096, DEPTH = 2, HD = 64, NH = 6, CCH = 256;
constexpr int M = BATCH * SEQ;
constexpr int INW = 3078, PW = 3072, DFF = 2816, NGU = 2 * DFF;
constexpr int MBLK = 256, NBLK = SEQ / MBLK;
constexpr float RMS_EPS = 1e-6f;
constexpr float LOG2E = 1.4426950408889634f;
constexpr float C2 = 0.125f * LOG2E;
constexpr int P_MQ = 0, P_MK = 384, P_MV = 768, P_FQ = 1152, P_FK = 1536, P_FV = 1920, P_CB = 2304, P_CC = 2560, P_CH = 2816;
constexpr size_t MiB = 1u << 20;
constexpr size_t WS_CTL = 0;
constexpr size_t WS_W = 2 * MiB, W_LAYER = 25 * MiB;
constexpr size_t WO_IN = 0, WO_OUT = 6 * MiB, WO_GU = 8 * MiB, WO_D = 19 * MiB, WO_F = 24 * MiB + 512 * 1024;
constexpr size_t WS_LOGF = 52 * MiB, WS_CUM = 53 * MiB, WS_KMEAN = 54 * MiB;
constexpr size_t WS_XN = 56 * MiB, WS_MIXIN = 120 * MiB, WS_XA = 184 * MiB, WS_P = 312 * MiB, WS_H = WS_P, WS_END = 504 * MiB;

__constant__ int c_bucket[129] = {0, 1, 2, 3, 4, 5, 6, 7, 8, 9, 10, 11, 12, 13, 14, 15, 16, 16, 16, 17, 17, 18, 18, 18, 19, 19, 19, 20, 20, 20, 20, 21, 21, 21, 21, 22, 22, 22, 22, 22, 23, 23, 23, 23, 23, 23, 24, 24, 24, 24, 24, 24, 25, 25, 25, 25, 25, 25, 25, 26, 26, 26, 26, 26, 26, 26, 26, 27, 27, 27, 27, 27, 27, 27, 27, 27, 27, 28, 28, 28, 28, 28, 28, 28, 28, 28, 28, 29, 29, 29, 29, 29, 29, 29, 29, 29, 29, 29, 29, 30, 30, 30, 30, 30, 30, 30, 30, 30, 30, 30, 30, 30, 30, 31, 31, 31, 31, 31, 31, 31, 31, 31, 31, 31, 31, 31, 31, 31, 31};

__device__ __forceinline__ unsigned f2bf(float f) { unsigned u = __builtin_bit_cast(unsigned, f); return (u + 0x7fffu + ((u >> 16) & 1u)) >> 16; }
__device__ __forceinline__ unsigned pk2(float lo, float hi) { return f2bf(lo) | (f2bf(hi) << 16); }
__device__ __forceinline__ float bf2f(unsigned short b) { return __builtin_bit_cast(float, (unsigned)b << 16); }
__device__ __forceinline__ float wave_sum(float v) {
#pragma unroll
    for (int o = 1; o < 64; o <<= 1) v += __shfl_xor(v, o);
    return v;
}

__global__ void nk_prep_w(const float* w_in, const float* w_out, const float* w_gate, const float* w_up, const float* w_down, unsigned char* ws) {
    const size_t gt = (size_t)blockIdx.x * blockDim.x + threadIdx.x, gs = (size_t)gridDim.x * blockDim.x;
    for (int l = 0; l < DEPTH; ++l) {
        unsigned char* wl = ws + WS_W + (size_t)l * W_LAYER;
        bf16* Win_t = (bf16*)(wl + WO_IN); bf16* Wout_t = (bf16*)(wl + WO_OUT); bf16* Wgu_t = (bf16*)(wl + WO_GU); bf16* Wd_t = (bf16*)(wl + WO_D); float* WF = (float*)(wl + WO_F);
        const float* wi = w_in + (size_t)l * DM * INW; const float* wo = w_out + (size_t)l * DM * DM;
        const float* wg = w_gate + (size_t)l * DM * DFF; const float* wu = w_up + (size_t)l * DM * DFF; const float* wd = w_down + (size_t)l * DFF * DM;
        for (size_t i = gt; i < (size_t)PW * DM; i += gs) { const int p = (int)(i / DM), k = (int)(i % DM); const int src = p < 2304 ? p : p + 6;
            const float sc = (p < 384 || (p >= 1152 && p < 1536)) ? C2 : 1.f; Win_t[i] = (bf16)f2bf(wi[(size_t)k * INW + src] * sc); }
        for (size_t i = gt; i < (size_t)NH * DM; i += gs) { const int h = (int)(i / DM), k = (int)(i % DM); WF[i] = wi[(size_t)k * INW + 2304 + h]; }
        for (size_t i = gt; i < (size_t)DM * DM; i += gs) { const int n = (int)(i / DM), k = (int)(i % DM); Wout_t[i] = (bf16)f2bf(wo[(size_t)k * DM + n]); }
        for (size_t i = gt; i < (size_t)NGU * DM; i += gs) { const int r = (int)(i / DM), k = (int)(i % DM); const int pn = r >> 8, bj = (r >> 7) & 1, j = r & 127;
            const float* src = bj ? wu : wg; Wgu_t[i] = (bf16)f2bf(src[(size_t)k * DFF + pn * 128 + j]); }
        for (size_t i = gt; i < (size_t)DM * DFF; i += gs) { const int n = (int)(i / DFF), k = (int)(i % DFF); Wd_t[i] = (bf16)f2bf(wd[(size_t)k * DM + n]); }
    }
}

__device__ __forceinline__ float log_sigmoid(float z) { return z < 0.f ? z - log1pf(expf(z)) : -log1pf(expf(-z)); }
__device__ __forceinline__ void row_phase(int lane, const float* resid, const float* y, const float* gpost, float* xout, const float* gpre, bf16* xn, const float* WF, const float* bfv, float* logf_out) {
    f32x4 v[4];
#pragma unroll
    for (int j = 0; j < 4; ++j) v[j] = ((const f32x4*)resid)[lane + 64 * j];
    if (y) {
        f32x4 yv[4]; float ss = 0.f;
#pragma unroll
        for (int j = 0; j < 4; ++j) { yv[j] = ((const f32x4*)y)[lane + 64 * j]; ss += (yv[j].x * yv[j].x + yv[j].y * yv[j].y) + (yv[j].z * yv[j].z + yv[j].w * yv[j].w); }
        const float r = 1.0f / sqrtf(wave_sum(ss) * (1.f / DM) + RMS_EPS);
#pragma unroll
        for (int j = 0; j < 4; ++j) { const f32x4 g = ((const f32x4*)gpost)[lane + 64 * j]; v[j] += yv[j] * r * g; }
    }
    if (xout) {
#pragma unroll
        for (int j = 0; j < 4; ++j) ((f32x4*)xout)[lane + 64 * j] = v[j];
    }
    if (xn) {
        float ss = 0.f;
#pragma unroll
        for (int j = 0; j < 4; ++j) ss += (v[j].x * v[j].x + v[j].y * v[j].y) + (v[j].z * v[j].z + v[j].w * v[j].w);
        const float r = 1.0f / sqrtf(wave_sum(ss) * (1.f / DM) + RMS_EPS);
#pragma unroll
        for (int j = 0; j < 4; ++j) { const f32x4 g = ((const f32x4*)gpre)[lane + 64 * j]; v[j] = v[j] * r * g;
            u32x2 w; w.x = pk2(v[j].x, v[j].y); w.y = pk2(v[j].z, v[j].w); ((u32x2*)xn)[lane + 64 * j] = w; }
        if (WF) {
            float mine = 0.f;
#pragma unroll
            for (int h = 0; h < NH; ++h) { float d = 0.f;
#pragma unroll
                for (int j = 0; j < 4; ++j) { const f32x4 w = ((const f32x4*)(WF + h * DM))[lane + 64 * j]; d += (v[j].x * w.x + v[j].y * w.y) + (v[j].z * w.z + v[j].w * w.w); }
                d = wave_sum(d); if (lane == h) mine = d; }
            if (lane < NH) logf_out[lane] = log_sigmoid(mine + bfv[lane]);
        }
    }
}
__global__ __launch_bounds__(256) void nk_rows(const float* resid, const float* y, const float* gpost, float* xout, const float* gpre, bf16* xn, const float* WF, const float* bfv, float* logf) {
    const int lane = threadIdx.x & 63, wv = threadIdx.x >> 6;
    for (int m = blockIdx.x * 4 + wv; m < M; m += gridDim.x * 4)
        row_phase(lane, resid + (size_t)m * DM, y ? y + (size_t)m * DM : nullptr, gpost, xout ? xout + (size_t)m * DM : nullptr, gpre, xn ? xn + (size_t)m * DM : nullptr, WF, bfv, logf ? logf + (size_t)m * NH : nullptr);
}

template <int MODE> __global__ __launch_bounds__(256) void nk_gemm(const bf16* A, const bf16* Bt, int K, void* Cout, int ldc) {
    const int w = threadIdx.x >> 6, lane = threadIdx.x & 63, fr = lane & 15, fq = lane >> 4;
    const int m0 = blockIdx.y * 128 + (w >> 1) * 64, n0 = blockIdx.x * 128 + (w & 1) * 64;
    f32x4 acc[4][4], acc2[MODE == 2 ? 4 : 1][MODE == 2 ? 4 : 1];
#pragma unroll
    for (int i = 0; i < 4; ++i)
#pragma unroll
        for (int j = 0; j < 4; ++j) { acc[i][j] = (f32x4){0.f, 0.f, 0.f, 0.f}; if (MODE == 2) acc2[i][j] = (f32x4){0.f, 0.f, 0.f, 0.f}; }
    int bn0 = n0, bn1 = 0;
    if (MODE == 2) { const int pn = n0 >> 7, wi = n0 & 127; bn0 = pn * 256 + wi; bn1 = pn * 256 + 128 + wi; }
    for (int k0 = 0; k0 < K; k0 += 32) {
        bf16x8 a[4], b[4], b2[4];
#pragma unroll
        for (int i = 0; i < 4; ++i) a[i] = *(const bf16x8*)(A + (size_t)(m0 + 16 * i + fr) * K + k0 + fq * 8);
#pragma unroll
        for (int j = 0; j < 4; ++j) { b[j] = *(const bf16x8*)(Bt + (size_t)(bn0 + 16 * j + fr) * K + k0 + fq * 8);
            if (MODE == 2) b2[j] = *(const bf16x8*)(Bt + (size_t)(bn1 + 16 * j + fr) * K + k0 + fq * 8); }
#pragma unroll
        for (int i = 0; i < 4; ++i)
#pragma unroll
            for (int j = 0; j < 4; ++j) { acc[i][j] = __builtin_amdgcn_mfma_f32_16x16x32_bf16(a[i], b[j], acc[i][j], 0, 0, 0);
                if (MODE == 2) acc2[i][j] = __builtin_amdgcn_mfma_f32_16x16x32_bf16(a[i], b2[j], acc2[i][j], 0, 0, 0); }
    }
#pragma unroll
    for (int i = 0; i < 4; ++i)
#pragma unroll
        for (int j = 0; j < 4; ++j)
#pragma unroll
            for (int r = 0; r < 4; ++r) { const int row = m0 + 16 * i + fq * 4 + r, col = n0 + 16 * j + fr; const float v = acc[i][j][r];
                if (MODE == 0) ((bf16*)Cout)[(size_t)row * ldc + col] = (bf16)f2bf(v);
                else if (MODE == 1) ((float*)Cout)[(size_t)row * ldc + col] = v;
                else { const float u = acc2[i][j][r]; ((bf16*)Cout)[(size_t)row * ldc + col] = (bf16)f2bf(v / (1.f + expf(-v)) * u); } }
}

__global__ __launch_bounds__(256) void nk_cumsum(const float* logf, float* cum2) {
    __shared__ float part[256];
    const int bh = blockIdx.x, b = bh / NH, h = bh % NH, t0 = threadIdx.x * 16;
    float loc[16]; float s = 0.f;
#pragma unroll
    for (int i = 0; i < 16; ++i) { s += logf[((size_t)b * SEQ + t0 + i) * NH + h]; loc[i] = s; }
    part[threadIdx.x] = s; __syncthreads();
    float off = 0.f; for (int i = 0; i < (int)threadIdx.x; ++i) off += part[i];
#pragma unroll
    for (int i = 0; i < 16; ++i) cum2[(size_t)bh * SEQ + t0 + i] = (off + loc[i]) * LOG2E;
}
__global__ __launch_bounds__(64) void nk_kmean(const bf16* P, float* kmean) {
    const int bhn = blockIdx.x, n = bhn % NBLK, bh = bhn / NBLK, b = bh / NH, h = bh % NH, d = threadIdx.x;
    float s = 0.f;
    for (int i = 0; i < MBLK; ++i) s += bf2f(P[((size_t)b * SEQ + n * MBLK + i) * PW + P_MK + h * HD + d]);
    kmean[(size_t)bhn * HD + d] = s * (1.f / MBLK);
}

__global__ __launch_bounds__(64) void nk_moba(const bf16* P, const float* kmean, const float* rel_bias, bf16* mixin) {
    const int gid = blockIdx.x * 64 + threadIdx.x;
    const int t = gid % SEQ, bh = gid / SEQ, b = bh / NH, h = bh % NH, own = t / MBLK;
    float q[HD], o[HD];
    const bf16* qp = P + ((size_t)b * SEQ + t) * PW + P_MQ + h * HD;
#pragma unroll
    for (int c = 0; c < 8; ++c) { const bf16x8 v = *(const bf16x8*)(qp + 8 * c);
#pragma unroll
        for (int j = 0; j < 8; ++j) { q[8 * c + j] = bf2f((unsigned short)v[j]); o[8 * c + j] = 0.f; } }
    int s0 = -1, s1 = -1, s2 = -1; float g0 = -INFINITY, g1 = -INFINITY, g2 = -INFINITY;
    for (int n = 0; n < own; ++n) { const float* km = kmean + ((size_t)bh * NBLK + n) * HD; float g = 0.f;
#pragma unroll
        for (int d = 0; d < HD; ++d) g += q[d] * km[d];
        if (g > g0) { g2 = g1; s2 = s1; g1 = g0; s1 = s0; g0 = g; s0 = n; } else if (g > g1) { g2 = g1; s2 = s1; g1 = g; s1 = n; } else if (g > g2) { g2 = g; s2 = n; } }
    float mrun = -INFINITY, l = 0.f;
    for (int sl = 0; sl < 4; ++sl) {
        const int blk = sl == 0 ? own : (sl == 1 ? s0 : (sl == 2 ? s1 : s2));
        if (blk < 0) continue;
        const int kend = sl == 0 ? (t - own * MBLK + 1) : MBLK;
        for (int i = 0; i < kend; ++i) {
            const int kpos = blk * MBLK + i; const bf16* kp = P + ((size_t)b * SEQ + kpos) * PW + P_MK + h * HD; const bf16* vp = kp + (P_MV - P_MK);
            float s = 0.f;
#pragma unroll
            for (int c = 0; c < 8; ++c) { const bf16x8 v = *(const bf16x8*)(kp + 8 * c);
#pragma unroll
                for (int j = 0; j < 8; ++j) s += q[8 * c + j] * bf2f((unsigned short)v[j]); }
            int dist = t - kpos; if (dist > 128) dist = 128;
            s += rel_bias[c_bucket[dist] * NH + h] * LOG2E;
            if (s > mrun) { const float f = exp2f(mrun - s);
#pragma unroll
                for (int d = 0; d < HD; ++d) o[d] *= f;
                l *= f; mrun = s; }
            const float p = exp2f(s - mrun); l += p;
#pragma unroll
            for (int c = 0; c < 8; ++c) { const bf16x8 v = *(const bf16x8*)(vp + 8 * c);
#pragma unroll
                for (int j = 0; j < 8; ++j) o[8 * c + j] += p * bf2f((unsigned short)v[j]); }
        }
    }
    const float rl = 1.f / l; bf16* op = mixin + ((size_t)b * SEQ + t) * DM + h * HD;
#pragma unroll
    for (int c = 0; c < 8; ++c) { u32x4 w; w.x = pk2(o[8 * c] * rl, o[8 * c + 1] * rl); w.y = pk2(o[8 * c + 2] * rl, o[8 * c + 3] * rl); w.z = pk2(o[8 * c + 4] * rl, o[8 * c + 5] * rl); w.w = pk2(o[8 * c + 6] * rl, o[8 * c + 7] * rl);
        *(u32x4*)(op + 8 * c) = w; }
}

__global__ __launch_bounds__(64) void nk_fox(const bf16* P, const float* cum2, bf16* mixin) {
    const int gid = blockIdx.x * 64 + threadIdx.x;
    const int t = gid % SEQ, bh = gid / SEQ, b = bh / NH, h = bh % NH;
    float q[HD], o[HD];
    const bf16* qp = P + ((size_t)b * SEQ + t) * PW + P_FQ + h * HD;
#pragma unroll
    for (int c = 0; c < 8; ++c) { const bf16x8 v = *(const bf16x8*)(qp + 8 * c);
#pragma unroll
        for (int j = 0; j < 8; ++j) { q[8 * c + j] = bf2f((unsigned short)v[j]); o[8 * c + j] = 0.f; } }
    const float* cb = cum2 + (size_t)bh * SEQ; const float ct = cb[t];
    float mrun = -INFINITY, l = 0.f;
    const int tmax = (t | 63);
    for (int s_ = 0; s_ <= tmax; ++s_) {
        const bf16* kp = P + ((size_t)b * SEQ + s_) * PW + P_FK + h * HD; const bf16* vp = kp + (P_FV - P_FK);
        float s = 0.f;
#pragma unroll
        for (int c = 0; c < 8; ++c) { const bf16x8 v = *(const bf16x8*)(kp + 8 * c);
#pragma unroll
            for (int j = 0; j < 8; ++j) s += q[8 * c + j] * bf2f((unsigned short)v[j]); }
        s += ct - cb[s_];
        if (s_ <= t) {
            if (s > mrun) { const float f = exp2f(mrun - s);
#pragma unroll
                for (int d = 0; d < HD; ++d) o[d] *= f;
                l *= f; mrun = s; }
            const float p = exp2f(s - mrun); l += p;
#pragma unroll
            for (int c = 0; c < 8; ++c) { const bf16x8 v = *(const bf16x8*)(vp + 8 * c);
#pragma unroll
                for (int j = 0; j < 8; ++j) o[8 * c + j] += p * bf2f((unsigned short)v[j]); }
        }
    }
    const float rl = 1.f / l; bf16* op = mixin + ((size_t)b * SEQ + t) * DM + 384 + h * HD;
#pragma unroll
    for (int c = 0; c < 8; ++c) { u32x4 w; w.x = pk2(o[8 * c] * rl, o[8 * c + 1] * rl); w.y = pk2(o[8 * c + 2] * rl, o[8 * c + 3] * rl); w.z = pk2(o[8 * c + 4] * rl, o[8 * c + 5] * rl); w.w = pk2(o[8 * c + 6] * rl, o[8 * c + 7] * rl);
        *(u32x4*)(op + 8 * c) = w; }
}

__global__ __launch_bounds__(256) void nk_conv(const bf16* P, const float* conv_w, bf16* mixin) {
    const size_t gs = (size_t)gridDim.x * blockDim.x;
    for (size_t i = (size_t)blockIdx.x * blockDim.x + threadIdx.x; i < (size_t)M * CCH; i += gs) {
        const int c = (int)(i % CCH); const size_t m = i / CCH; const int t = (int)(m % SEQ);
        float y = 0.f;
#pragma unroll
        for (int j = 0; j < 3; ++j) { const int tt = t - 2 + j; if (tt >= 0) { const bf16* r = P + (m - 2 + j) * PW; y += conv_w[j * CCH + c] * (bf2f(r[P_CC + c]) * bf2f(r[P_CH + c])); } }
        mixin[m * DM + 768 + c] = (bf16)f2bf(bf2f(P[m * PW + P_CB + c]) * y);
    }
}

extern "C" void kernel_launch(void* const* d_in, const int* in_sizes, int n_in, void* d_out, int out_size, void* d_ws, size_t ws_size, hipStream_t stream) {
    if (n_in != 13 || in_sizes[0] != M * DM || out_size != M * DM || ws_size < WS_END) { fprintf(stderr, "kernel_launch: unexpected shapes (n_in %d, in0 %d, out %d, ws %zu)\n", n_in, n_in > 0 ? in_sizes[0] : -1, out_size, ws_size); return; }
    const float* x = (const float*)d_in[0]; const float* w_in = (const float*)d_in[1]; const float* b_f = (const float*)d_in[2]; const float* conv_w = (const float*)d_in[3];
    const float* w_out = (const float*)d_in[4]; const float* rel_bias = (const float*)d_in[5]; const float* g_pre_mix = (const float*)d_in[6]; const float* g_post_mix = (const float*)d_in[7];
    const float* g_pre_ffn = (const float*)d_in[8]; const float* g_post_ffn = (const float*)d_in[9]; const float* w_gate = (const float*)d_in[10]; const float* w_up = (const float*)d_in[11]; const float* w_down = (const float*)d_in[12];
    unsigned char* ws = (unsigned char*)d_ws; float* out = (float*)d_out;
    float* LOGF = (float*)(ws + WS_LOGF); float* CUM = (float*)(ws + WS_CUM); float* KMEAN = (float*)(ws + WS_KMEAN);
    bf16* XN = (bf16*)(ws + WS_XN); bf16* MIXIN = (bf16*)(ws + WS_MIXIN); float* XA = (float*)(ws + WS_XA); bf16* P = (bf16*)(ws + WS_P); bf16* H = (bf16*)(ws + WS_H);
    nk_prep_w<<<2048, 256, 0, stream>>>(w_in, w_out, w_gate, w_up, w_down, ws);
    {
        const float* WF0 = (const float*)(ws + WS_W + WO_F);
        nk_rows<<<2048, 256, 0, stream>>>(x, nullptr, nullptr, nullptr, g_pre_mix, XN, WF0, b_f, LOGF);
    }
    for (int l = 0; l < DEPTH; ++l) {
        unsigned char* wl = ws + WS_W + (size_t)l * W_LAYER;
        const bf16* Win_t = (const bf16*)(wl + WO_IN); const bf16* Wout_t = (const bf16*)(wl + WO_OUT); const bf16* Wgu_t = (const bf16*)(wl + WO_GU); const bf16* Wd_t = (const bf16*)(wl + WO_D);
        const bool last = (l == DEPTH - 1);
        nk_gemm<0><<<dim3(PW / 128, M / 128), 256, 0, stream>>>(XN, Win_t, DM, P, PW);
        nk_cumsum<<<BATCH * NH, 256, 0, stream>>>(LOGF, CUM);
        nk_kmean<<<BATCH * NH * NBLK, 64, 0, stream>>>(P, KMEAN);
        nk_moba<<<BATCH * NH * SEQ / 64, 64, 0, stream>>>(P, KMEAN, rel_bias, MIXIN);
        nk_fox<<<BATCH * NH * SEQ / 64, 64, 0, stream>>>(P, CUM, MIXIN);
        nk_conv<<<4096, 256, 0, stream>>>(P, conv_w + (size_t)l * 3 * CCH, MIXIN);
        nk_gemm<1><<<dim3(DM / 128, M / 128), 256, 0, stream>>>(MIXIN, Wout_t, DM, out, DM);
        nk_rows<<<2048, 256, 0, stream>>>(l == 0 ? x : XA, out, g_post_mix + (size_t)l * DM, XA, g_pre_ffn + (size_t)l * DM, XN, nullptr, nullptr, nullptr);
        nk_gemm<2><<<dim3(DFF / 128, M / 128), 256, 0, stream>>>(XN, Wgu_t, DM, H, DFF);
        nk_gemm<1><<<dim3(DM / 128, M / 128), 256, 0, stream>>>(H, Wd_t, DFF, out, DM);
        if (!last) { const float* WFn = (const float*)(ws + WS_W + (size_t)(l + 1) * W_LAYER + WO_F);
            nk_rows<<<2048, 256, 0, stream>>>(XA, out, g_post_ffn + (size_t)l * DM, XA, g_pre_mix + (size_t)(l + 1) * DM, XN, WFn, b_f + (size_t)(l + 1) * NH, LOGF); }
        else nk_rows<<<2048, 256, 0, stream>>>(XA, out, g_post_ffn + (size_t)l * DM, out, nullptr, nullptr, nullptr, nullptr, nullptr);
    }
}
```

```cpp
#include <hip/hip_runtime.h>
#include <cstdio>
#include <cstdint>

typedef unsigned short bf16;
typedef short bf16x8 __attribute__((ext_vector_type(8)));
typedef float f32x4 __attribute__((ext_vector_type(4)));
typedef unsigned u32x4 __attribute__((ext_vector_type(4)));
typedef unsigned u32x2 __attribute__((ext_vector_type(2)));

constexpr int DM = 1024, BATCH = 8, SEQ = 4096, DEPTH = 2, HD = 64, NH = 6, CCH = 256;
constexpr int M = BATCH * SEQ;
constexpr int INW = 3078, PW = 3072, DFF = 2816, NGU = 2 * DFF;
constexpr int MBLK = 256, NBLK = SEQ / MBLK;
constexpr float RMS_EPS = 1e-6f;
constexpr float LOG2E = 1.4426950408889634f;
constexpr float C2 = 0.125f * LOG2E;
constexpr int P_MQ = 0, P_MK = 384, P_MV = 768, P_FQ = 1152, P_FK = 1536, P_FV = 1920, P_CB = 2304, P_CC = 2560, P_CH = 2816;
constexpr size_t MiB = 1u << 20;
constexpr size_t WS_CTL = 0;
constexpr size_t WS_W = 2 * MiB, W_LAYER = 25 * MiB;
constexpr size_t WO_IN = 0, WO_OUT = 6 * MiB, WO_GU = 8 * MiB, WO_D = 19 * MiB, WO_F = 24 * MiB + 512 * 1024;
constexpr size_t WS_LOGF = 52 * MiB, WS_CUM = 53 * MiB, WS_KMEAN = 54 * MiB;
constexpr size_t WS_XN = 56 * MiB, WS_MIXIN = 120 * MiB, WS_XA = 184 * MiB, WS_P = 312 * MiB, WS_H = WS_P, WS_END = 504 * MiB;

__constant__ int c_bucket[129] = {0, 1, 2, 3, 4, 5, 6, 7, 8, 9, 10, 11, 12, 13, 14, 15, 16, 16, 16, 17, 17, 18, 18, 18, 19, 19, 19, 20, 20, 20, 20, 21, 21, 21, 21, 22, 22, 22, 22, 22, 23, 23, 23, 23, 23, 23, 24, 24, 24, 24, 24, 24, 25, 25, 25, 25, 25, 25, 25, 26, 26, 26, 26, 26, 26, 26, 26, 27, 27, 27, 27, 27, 27, 27, 27, 27, 27, 28, 28, 28, 28, 28, 28, 28, 28, 28, 28, 29, 29, 29, 29, 29, 29, 29, 29, 29, 29, 29, 29, 30, 30, 30, 30, 30, 30, 30, 30, 30, 30, 30, 30, 30, 30, 31, 31, 31, 31, 31, 31, 31, 31, 31, 31, 31, 31, 31, 31, 31, 31};

__device__ __forceinline__ unsigned f2bf(float f) { unsigned u = __builtin_bit_cast(unsigned, f); return (u + 0x7fffu + ((u >> 16) & 1u)) >> 16; }
__device__ __forceinline__ unsigned pk2(float lo, float hi) { return f2bf(lo) | (f2bf(hi) << 16); }
__device__ __forceinline__ float bf2f(unsigned short b) { return __builtin_bit_cast(float, (unsigned)b << 16); }
__device__ __forceinline__ float wave_sum(float v) {
#pragma unroll
    for (int o = 1; o < 64; o <<= 1) v += __shfl_xor(v, o);
    return v;
}

__device__ __forceinline__ float log_sigmoid(float z) { return z < 0.f ? z - log1pf(expf(z)) : -log1pf(expf(-z)); }
namespace pg8 {
#define PG8_LAS __attribute__((address_space(3)))
typedef unsigned short bf16_t;
typedef short bf16x8 __attribute__((ext_vector_type(8)));
typedef float f32x4 __attribute__((ext_vector_type(4)));
typedef unsigned u32x4 __attribute__((ext_vector_type(4)));
constexpr int BM = 256, BK = 64, HALF = 128, HTB = HALF * BK * 2  , STAGE_BYTES = 8 * HTB, NXCD = 8, WGM = 8;

__host__ __device__ __forceinline__ int lds_byte(int r, int c) { const int st = (r >> 4) * 2 + (c >> 5), rr = r & 15, cc = c & 31, ob = rr * 64 + cc * 2; return st * 1024 + (ob ^ (((ob >> 9) & 1) << 5)); }
__host__ __device__ __forceinline__ void stage_rc(int b, int& R, int& C) { const int st = b / 1024, sb = b % 1024, swz = sb ^ (((sb >> 9) & 1) << 5); R = (st >> 1) * 16 + swz / 64; C = (st & 1) * 32 + (swz % 64) / 2; }
__host__ __device__ __forceinline__ int perm32(int rho) { const int n = rho >> 4, i = rho & 15; return 8 * (i >> 2) + 4 * n + (i & 3); }

struct Unit { int pm, pn; };
struct Gemm { const bf16_t* A; const bf16_t* Bt; int M, N, K; };

struct StaticOrder {
    int nM, nN, nwg, G, c;
    __host__ __device__ void init(int M, int N, int G_, int c_) { nM = M / BM; nN = N / BM; nwg = nM * nN; G = G_; c = c_; }
    __host__ __device__ bool next(int i, Unit& u) const {
        const long L = (long)i * G + c; if (L >= nwg) return false;
        int wgid = (int)L; { const int q = nwg / NXCD, r = nwg % NXCD, xcd = wgid % NXCD, off = wgid / NXCD; wgid = (xcd < r ? xcd * (q + 1) : r * (q + 1) + (xcd - r) * q) + off; }
        const int nig = WGM * nN, gid = wgid / nig, fm = gid * WGM, gsz = (nM - fm) < WGM ? (nM - fm) : WGM;
        u.pm = fm + ((wgid % nig) % gsz); u.pn = (wgid % nig) / gsz; return true;
    }
    __device__ __forceinline__ void a_ready(const Unit&) const {}
    __device__ __forceinline__ void done(const Unit&) const {}
};
__device__ __forceinline__ unsigned cvt_pk_bf16(float lo, float hi) { unsigned r; asm volatile("v_cvt_pk_bf16_f32 %0, %1, %2" : "=v"(r) : "v"(lo), "v"(hi)); return r; }
typedef float f32x2 __attribute__((ext_vector_type(2)));
struct EpiStoreBf16 {
    static constexpr bool PERM = true, AFTER_DRAIN = false;
    bf16_t* O; int ldc;
    __device__ __forceinline__ void operator()(const f32x4 (&acc)[2][2][4][2], const Unit& u, int wr, int wc, int fr, int fq) const {
        const int row0 = u.pm * BM + wr * 64 + fr, col0 = u.pn * BM + wc * 32 + 8 * fq;
#pragma unroll
        for (int ai = 0; ai < 2; ++ai)
#pragma unroll
            for (int m = 0; m < 4; ++m) { bf16_t* rowp = O + (size_t)(row0 + ai * HALF + m * 16) * ldc + col0;
#pragma unroll
                for (int bj = 0; bj < 2; ++bj) { const f32x4 v0 = acc[ai][bj][m][0], v1 = acc[ai][bj][m][1];
                    u32x4 w; w.x = cvt_pk_bf16(v0[0], v0[1]); w.y = cvt_pk_bf16(v0[2], v0[3]); w.z = cvt_pk_bf16(v1[0], v1[1]); w.w = cvt_pk_bf16(v1[2], v1[3]);
                    *(u32x4*)(rowp + bj * HALF) = w; } }
    }
};
struct EpiStoreF32 {
    static constexpr bool PERM = false, AFTER_DRAIN = false;
    float* C; int ldc;
    __device__ __forceinline__ void operator()(const f32x4 (&acc)[2][2][4][2], const Unit& u, int wr, int wc, int fr, int fq) const {
        const int row0 = u.pm * BM + wr * 64 + fr, col0 = u.pn * BM + wc * 32 + 4 * fq;
#pragma unroll
        for (int ai = 0; ai < 2; ++ai)
#pragma unroll
            for (int m = 0; m < 4; ++m) { float* rowp = C + (size_t)(row0 + ai * HALF + m * 16) * ldc + col0;
#pragma unroll
                for (int bj = 0; bj < 2; ++bj)
#pragma unroll
                    for (int n = 0; n < 2; ++n) *(f32x4*)(rowp + bj * HALF + n * 16) = acc[ai][bj][m][n]; }
    }
};
__device__ __forceinline__ float silu_mul(float g, float u) { return g * __builtin_amdgcn_rcpf(1.0f + __builtin_amdgcn_exp2f(g * -1.4426950408889634f)) * u; }
struct EpiSwiGLU {
    static constexpr bool PERM = true, AFTER_DRAIN = false;
    bf16_t* O; int ldc;
    __device__ __forceinline__ void operator()(f32x4 (&acc)[2][2][4][2], const Unit& u, int wr, int wc, int fr, int fq) const {
        const int row0 = u.pm * BM + wr * 64 + fr, col0 = u.pn * HALF + wc * 32 + 8 * fq;
#pragma unroll
        for (int ai = 0; ai < 2; ++ai)
#pragma unroll
            for (int m = 0; m < 4; ++m) { bf16_t* rowp = O + (size_t)(row0 + ai * HALF + m * 16) * ldc + col0;
                const f32x4 g0 = acc[ai][0][m][0], g1 = acc[ai][0][m][1], u0 = acc[ai][1][m][0], u1 = acc[ai][1][m][1];
                u32x4 w; w.x = cvt_pk_bf16(silu_mul(g0[0], u0[0]), silu_mul(g0[1], u0[1])); w.y = cvt_pk_bf16(silu_mul(g0[2], u0[2]), silu_mul(g0[3], u0[3]));
                w.z = cvt_pk_bf16(silu_mul(g1[0], u1[0]), silu_mul(g1[1], u1[1])); w.w = cvt_pk_bf16(silu_mul(g1[2], u1[2]), silu_mul(g1[3], u1[3]));
                *(u32x4*)rowp = w; }
    }
};
struct EpiInProj {
    static constexpr bool PERM = true, AFTER_DRAIN = false;
    bf16_t* O; int ldc; float* kmean; float* knp;
    __device__ __forceinline__ void operator()(f32x4 (&acc)[2][2][4][2], const Unit& u, int wr, int wc, int fr, int fq) const {
        const int row0 = u.pm * BM + wr * 64 + fr, col0 = u.pn * BM + wc * 32 + 8 * fq;
#pragma unroll
        for (int ai = 0; ai < 2; ++ai)
#pragma unroll
            for (int m = 0; m < 4; ++m) { bf16_t* rowp = O + (size_t)(row0 + ai * HALF + m * 16) * ldc + col0;
#pragma unroll
                for (int bj = 0; bj < 2; ++bj) { const f32x4 v0 = acc[ai][bj][m][0], v1 = acc[ai][bj][m][1];
                    u32x4 w; w.x = cvt_pk_bf16(v0[0], v0[1]); w.y = cvt_pk_bf16(v0[2], v0[3]); w.z = cvt_pk_bf16(v1[0], v1[1]); w.w = cvt_pk_bf16(v1[2], v1[3]);
                    *(u32x4*)(rowp + bj * HALF) = w; } }
        if (u.pn == 6 || u.pn == 7) {
#pragma unroll
            for (int bj = 0; bj < 2; ++bj) {
                if (u.pn == 7 && bj == 1) continue;
                const int head = 4 * (u.pn - 6) + 2 * bj + (wc >> 1);
#pragma unroll
                for (int ai = 0; ai < 2; ++ai) { float mx = 0.f;
#pragma unroll
                    for (int m = 0; m < 4; ++m) { const f32x4 v0 = acc[ai][bj][m][0], v1 = acc[ai][bj][m][1];
                        float ss = (v0[0] * v0[0] + v0[1] * v0[1]) + (v0[2] * v0[2] + v0[3] * v0[3]) + (v1[0] * v1[0] + v1[1] * v1[1]) + (v1[2] * v1[2] + v1[3] * v1[3]);
                        ss += __shfl_xor(ss, 16); ss += __shfl_xor(ss, 32); mx = fmaxf(mx, ss); }
                    mx = fmaxf(mx, __shfl_xor(mx, 1)); mx = fmaxf(mx, __shfl_xor(mx, 2)); mx = fmaxf(mx, __shfl_xor(mx, 4)); mx = fmaxf(mx, __shfl_xor(mx, 8));
                    if (fr == 0 && fq == 0) knp[((size_t)((u.pm >> 4) * 6 + head) * 64 + ((u.pm & 15) * 4 + ai * 2 + wr)) * 2 + (wc & 1)] = mx * 1.02f; }
            }
        }
        if (u.pn == 1 || u.pn == 2) {
#pragma unroll
            for (int bj = 0; bj < 2; ++bj) {
                if (u.pn == 1 && bj == 0) continue;
                const int cp = u.pn * BM + bj * HALF + wc * 32 + 8 * fq - 384;
                float* dst = kmean + ((size_t)((u.pm >> 4) * 6 + (cp >> 6)) * 16 + (u.pm & 15)) * 64 + (cp & 63);
#pragma unroll
                for (int n = 0; n < 2; ++n)
#pragma unroll
                    for (int i = 0; i < 4; ++i) { float s = 0.f;
#pragma unroll
                        for (int ai = 0; ai < 2; ++ai)
#pragma unroll
                            for (int m = 0; m < 4; ++m) s += acc[ai][bj][m][n][i];
                        s += __shfl_xor(s, 1); s += __shfl_xor(s, 2); s += __shfl_xor(s, 4); s += __shfl_xor(s, 8);
                        if (fr == 0) atomicAdd(dst + 4 * n + i, s * (1.0f / 256.0f)); }
            }
        }
    }
};
template <class Epi, class Sched, bool ALIGN_EPI = false, bool SP2 = false>
__device__ __forceinline__ void gemm_phase(PG8_LAS unsigned char* lds, const Gemm g, const Sched& S, const Epi& E) {
    int tid_ = threadIdx.x; asm volatile("" : "+v"(tid_));
    const int tid = tid_, wid = __builtin_amdgcn_readfirstlane(tid >> 6), lane = tid & 63, wr = wid >> 2, wc = wid & 3, fr = lane & 15, fq = lane >> 4;
    const int K = g.K, nt = K / BK;
    unsigned voffA[2], voffB[2];
#pragma unroll
    for (int i = 0; i < 2; ++i) { int R, C; stage_rc(tid * 16 + i * 8192, R, C); const int Rb = Epi::PERM ? ((R & ~31) + perm32(R & 31)) : R;
        voffA[i] = (unsigned)(R * K + C) * 2u; voffB[i] = (unsigned)(Rb * K + C) * 2u; }
    const size_t kstep = (size_t)(BK * 2);
    const size_t hstep = (size_t)HALF * K * 2;
    const size_t tstep = 2 * hstep;
    const unsigned ldsw = (unsigned)wid * 1024u;
    const int aoff = lds_byte(wr * 64 + fr, fq * 8), boff = lds_byte(wc * 32 + fr, fq * 8);
#define PG8_SA(b, h) (((b) * 2 + (h)) * HTB)
#define PG8_SB(b, h) ((4 + (b) * 2 + (h)) * HTB)
#define PG8_STAGE(bufoff, gbase, voff) do { _Pragma("unroll") for (int _i = 0; _i < 2; ++_i) \
        __builtin_amdgcn_global_load_lds((const unsigned*)((const char*)(gbase) + (voff)[_i]), (PG8_LAS unsigned*)(lds + (bufoff) + ldsw + _i * 8192), 16, 0, 0); } while (0)
#define PG8_LDA(dst, b, h) do { _Pragma("unroll") for (int m = 0; m < 4; ++m) _Pragma("unroll") for (int k = 0; k < 2; ++k) dst[m][k] = *(const PG8_LAS bf16x8*)(lds + PG8_SA(b, h) + aoff + m * 2048 + k * 1024); } while (0)
#define PG8_LDB(dst, b, h) do { _Pragma("unroll") for (int n = 0; n < 2; ++n) _Pragma("unroll") for (int k = 0; k < 2; ++k) dst[n][k] = *(const PG8_LAS bf16x8*)(lds + PG8_SB(b, h) + boff + n * 2048 + k * 1024); } while (0)
#define PG8_MMA(ai, bj, At, Bt) do { __builtin_amdgcn_s_setprio(1); _Pragma("unroll") for (int m = 0; m < 4; ++m) _Pragma("unroll") for (int n = 0; n < 2; ++n) _Pragma("unroll") for (int k = 0; k < 2; ++k) \
        acc[ai][bj][m][n] = __builtin_amdgcn_mfma_f32_16x16x32_bf16(Bt[n][k], At[m][k], acc[ai][bj][m][n], 0, 0, 0); __builtin_amdgcn_s_setprio(0); } while (0)
#define PG8_WAIT_V(n) asm volatile("s_waitcnt vmcnt(" #n ")" ::: "memory")
#define PG8_WAIT_L(n) asm volatile("s_waitcnt lgkmcnt(" #n ")" ::: "memory")
#define PG8_BAR __builtin_amdgcn_s_barrier()
#define PG8_SCHED __builtin_amdgcn_sched_barrier(0)
    Unit cur, nxt; int ui = 0;
    if (!S.next(0, cur)) return;
    f32x4 acc[2][2][4][2];
#pragma unroll
    for (int a = 0; a < 2; ++a)
#pragma unroll
        for (int b = 0; b < 2; ++b)
#pragma unroll
            for (int m = 0; m < 4; ++m)
#pragma unroll
                for (int n = 0; n < 2; ++n) acc[a][b][m][n] = (f32x4){0.f, 0.f, 0.f, 0.f};
    bf16x8 At[4][2], B0[2][2], B1[2][2];
    const char* cA = (const char*)g.A + (size_t)cur.pm * tstep; const char* cB = (const char*)g.Bt + (size_t)cur.pn * tstep;
    S.a_ready(cur);
    if constexpr (SP2) {
        PG8_STAGE(PG8_SB(0, 0), cB, voffB); PG8_STAGE(PG8_SB(0, 1), cB + hstep, voffB); PG8_STAGE(PG8_SA(0, 0), cA, voffA); PG8_STAGE(PG8_SA(0, 1), cA + hstep, voffA);
        if (wr == 1) PG8_BAR;
        PG8_WAIT_V(2); PG8_BAR;
        PG8_STAGE(PG8_SB(1, 0), cB + kstep, voffB); PG8_STAGE(PG8_SA(1, 0), cA + kstep, voffA); PG8_STAGE(PG8_SB(1, 1), cB + hstep + kstep, voffB);
        PG8_WAIT_V(6); PG8_BAR;
    } else {
        PG8_STAGE(PG8_SB(0, 0), cB, voffB); PG8_STAGE(PG8_SA(0, 0), cA, voffA); PG8_STAGE(PG8_SB(0, 1), cB + hstep, voffB); PG8_STAGE(PG8_SA(0, 1), cA + hstep, voffA);
        if (wr == 1) PG8_BAR;
        PG8_WAIT_V(4); PG8_BAR;
        PG8_STAGE(PG8_SB(1, 0), cB + kstep, voffB); PG8_STAGE(PG8_SA(1, 0), cA + kstep, voffA); PG8_STAGE(PG8_SB(1, 1), cB + hstep + kstep, voffB);
        PG8_WAIT_V(6); PG8_BAR;
    }
    for (;;) {
        const bool has_next = S.next(ui + 1, nxt);
        const char* nA = has_next ? (const char*)g.A + (size_t)nxt.pm * tstep : cA; const char* nB = has_next ? (const char*)g.Bt + (size_t)nxt.pn * tstep : cB;
        for (int t = 0; t < nt; t += 2) {
            const bool last = (t == nt - 2);
            const char* a1 = cA + (size_t)(t + 1) * kstep;
            const char* a2 = last ? nA : cA + (size_t)(t + 2) * kstep; const char* b2 = last ? nB : cB + (size_t)(t + 2) * kstep;
            const char* a3 = a2 + kstep; const char* b3 = b2 + kstep;
            if (last && has_next) S.a_ready(nxt);
            if constexpr (SP2) {
            PG8_LDB(B0, 0, 0); PG8_LDB(B1, 0, 1); PG8_SCHED; PG8_LDA(At, 0, 0); PG8_STAGE(PG8_SA(1, 1), a1 + hstep, voffA);
            PG8_WAIT_V(8); PG8_WAIT_L(0); PG8_BAR; PG8_MMA(0, 0, At, B0); PG8_MMA(0, 1, At, B1); PG8_BAR; PG8_SCHED;
            PG8_LDA(At, 0, 1); PG8_STAGE(PG8_SB(0, 0), b2, voffB); PG8_STAGE(PG8_SB(0, 1), b2 + hstep, voffB); PG8_STAGE(PG8_SA(0, 0), a2, voffA);
            PG8_WAIT_V(8); PG8_WAIT_L(0); PG8_BAR; PG8_MMA(1, 0, At, B0); PG8_MMA(1, 1, At, B1); PG8_BAR; PG8_SCHED;
            PG8_LDB(B0, 1, 0); PG8_LDB(B1, 1, 1); PG8_SCHED; PG8_LDA(At, 1, 0); PG8_STAGE(PG8_SA(0, 1), a2 + hstep, voffA);
            PG8_WAIT_V(8); PG8_WAIT_L(0); PG8_BAR; PG8_MMA(0, 0, At, B0); PG8_MMA(0, 1, At, B1); PG8_BAR; PG8_SCHED;
            PG8_LDA(At, 1, 1); PG8_STAGE(PG8_SB(1, 0), b3, voffB); PG8_STAGE(PG8_SB(1, 1), b3 + hstep, voffB); PG8_STAGE(PG8_SA(1, 0), a3, voffA);
            PG8_WAIT_V(8); PG8_WAIT_L(0); PG8_BAR; PG8_MMA(1, 0, At, B0); PG8_MMA(1, 1, At, B1); PG8_BAR; PG8_SCHED;
            } else {
            PG8_LDB(B0, 0, 0); PG8_SCHED; PG8_LDA(At, 0, 0); PG8_STAGE(PG8_SA(1, 1), a1 + hstep, voffA);
            PG8_WAIT_L(8); PG8_BAR; PG8_WAIT_L(0); PG8_MMA(0, 0, At, B0); PG8_BAR; PG8_SCHED;
            PG8_LDB(B1, 0, 1); PG8_STAGE(PG8_SB(0, 0), b2, voffB);
            PG8_BAR; PG8_WAIT_L(0); PG8_MMA(0, 1, At, B1); PG8_BAR;
            PG8_LDA(At, 0, 1); PG8_STAGE(PG8_SA(0, 0), a2, voffA);
            PG8_BAR; PG8_WAIT_L(0); PG8_MMA(1, 0, At, B0); PG8_BAR; PG8_SCHED;
            PG8_STAGE(PG8_SB(0, 1), b2 + hstep, voffB);
            PG8_WAIT_V(6); PG8_BAR; PG8_MMA(1, 1, At, B1); PG8_BAR;
            PG8_LDB(B0, 1, 0); PG8_SCHED; PG8_LDA(At, 1, 0); PG8_STAGE(PG8_SA(0, 1), a2 + hstep, voffA);
            PG8_WAIT_L(8); PG8_BAR; PG8_WAIT_L(0); PG8_MMA(0, 0, At, B0); PG8_BAR; PG8_SCHED;
            PG8_LDB(B1, 1, 1); PG8_STAGE(PG8_SB(1, 0), b3, voffB);
            PG8_BAR; PG8_WAIT_L(0); PG8_MMA(0, 1, At, B1); PG8_BAR;
            PG8_LDA(At, 1, 1); PG8_STAGE(PG8_SA(1, 0), a3, voffA);
            PG8_BAR; PG8_WAIT_L(0); PG8_MMA(1, 0, At, B0); PG8_BAR; PG8_SCHED;
            PG8_STAGE(PG8_SB(1, 1), b3 + hstep, voffB);
            PG8_WAIT_V(6); PG8_BAR; PG8_MMA(1, 1, At, B1); PG8_BAR;
            }
        }
        if constexpr (ALIGN_EPI) { if (wr == 0) PG8_BAR; }
        if constexpr (!Epi::AFTER_DRAIN) { E(acc, cur, wr, wc, fr, fq); S.done(cur); }
        if (!has_next) break;
#pragma unroll
        for (int a = 0; a < 2; ++a)
#pragma unroll
            for (int b = 0; b < 2; ++b)
#pragma unroll
                for (int m = 0; m < 4; ++m)
#pragma unroll
                    for (int n = 0; n < 2; ++n) acc[a][b][m][n] = (f32x4){0.f, 0.f, 0.f, 0.f};
        cur = nxt; cA = nA; cB = nB; ++ui;
        if constexpr (ALIGN_EPI) { if (wr == 1) PG8_BAR; }
    }
    PG8_WAIT_V(0);
    if constexpr (!ALIGN_EPI) { if (wr == 0) PG8_BAR; }
    PG8_BAR;
    if constexpr (Epi::AFTER_DRAIN) { E.fused(acc, cur, wr, wc, fr, fq, lds, wid, lane); S.done(cur); }
#undef PG8_SA
#undef PG8_SB
#undef PG8_STAGE
#undef PG8_LDA
#undef PG8_LDB
#undef PG8_MMA
#undef PG8_WAIT_V
#undef PG8_WAIT_L
#undef PG8_BAR
#undef PG8_SCHED
}
}

#include <hip/hip_bf16.h>
#include <cmath>
namespace attn_body {
using bf16=__hip_bfloat16;
using bf16x8=__attribute__((ext_vector_type(8)))short;
using s16x4=__attribute__((ext_vector_type(4)))short;
using f32x16=__attribute__((ext_vector_type(16)))float;
using u32x4=__attribute__((ext_vector_type(4)))unsigned;
using f32x4_t=__attribute__((ext_vector_type(4)))float;
constexpr int D=64;
constexpr int NW=8,QBLK=32,QB=QBLK*NW,KVBLK=64;
constexpr int QP=3072, OPITCH=1024;
constexpr int AUX_R0=0, AUX_INFO=1024, AUX_TAB=2048, AUX_BYTES=2048+16384+1024;
__device__ __forceinline__ int crow(int r,int hi){return (r&3)+8*(r>>2)+4*hi;}
#define SBAR() __builtin_amdgcn_sched_barrier(0)
__device__ __forceinline__ void cmask(f32x16&p0,f32x16&p1,int jb,int qrel,int hi){
  const float NEG=-INFINITY; int kb=64*jb+4*hi;
  #pragma unroll
  for(int r=0;r<16;++r){int kv=kb+(r&3)+8*(r>>2); if(kv>qrel)p0[r]=NEG; if(kv+32>qrel)p1[r]=NEG;}
}

constexpr int NSLOT=3, SLOTB=8192;
constexpr int LDS_K=0, LDS_V=NSLOT*SLOTB, LDS_WS=2*NSLOT*SLOTB, LDS_OST=LDS_WS+NW*64*4, LDS_BYTES=LDS_OST+NW*4096;
constexpr float C2=0.125f*1.4426950408889634f;
__device__ __forceinline__ void glds16(const void*gsrc,unsigned lds_dst){unsigned keep;
  asm volatile("s_mov_b32 %0, m0\n\ts_mov_b32 m0, %2\n\ts_nop 0\n\tglobal_load_lds_dwordx4 %1, off\n\ts_mov_b32 m0, %0":"=&s"(keep):"v"(gsrc),"s"(lds_dst):"memory");}
__device__ __forceinline__ float max3f(float a,float b,float c){float r;asm("v_max3_f32 %0, %1, %2, %3":"=v"(r):"v"(a),"v"(b),"v"(c));return r;}
__device__ __forceinline__ float max2f(float a,float b){float r;asm("v_max_f32_e32 %0, %1, %2":"=v"(r):"v"(a),"v"(b));return r;}
__device__ __forceinline__ float fadd_s(float a,float b){float r;asm("v_add_f32_e32 %0, %1, %2":"=v"(r):"v"(a),"v"(b));return r;}
__device__ __forceinline__ float fsub_s(float a,float b){float r;asm("v_sub_f32_e32 %0, %1, %2":"=v"(r):"v"(a),"v"(b));return r;}
typedef float f32x2_t __attribute__((ext_vector_type(2))); typedef __bf16 bf16x2_t __attribute__((ext_vector_type(2)));
__device__ __forceinline__ unsigned cvtpk_s(float lo,float hi){f32x2_t v={lo,hi};bf16x2_t b=__builtin_convertvector(v,bf16x2_t);return __builtin_bit_cast(unsigned,b);}
#define WAIT_BAR(N) asm volatile("s_waitcnt vmcnt(" #N ") lgkmcnt(0)\n\ts_barrier":::"memory")

__device__ __forceinline__ void qkt(f32x16&p0,f32x16&p1,const char*Kslot,const bf16x8*qr,const f32x16&negm,int r32,int hi){
  const char*kb=Kslot+hi*1024+r32*16;
  #pragma unroll
  for(int d0=0;d0<4;++d0){
    const bf16x8 b0=*reinterpret_cast<const bf16x8*>(kb+d0*2048);
    const bf16x8 b1=*reinterpret_cast<const bf16x8*>(kb+d0*2048+512);
    if(d0==0){p0=__builtin_amdgcn_mfma_f32_32x32x16_bf16(b0,qr[0],negm,0,0,0);p1=__builtin_amdgcn_mfma_f32_32x32x16_bf16(b1,qr[0],negm,0,0,0);}
    else{p0=__builtin_amdgcn_mfma_f32_32x32x16_bf16(b0,qr[d0],p0,0,0,0);p1=__builtin_amdgcn_mfma_f32_32x32x16_bf16(b1,qr[d0],p1,0,0,0);}}
}
typedef __attribute__((address_space(3))) const char* lds_cptr;
typedef short v4i16_t __attribute__((ext_vector_type(4)));
__device__ __forceinline__ void kload8(bf16x8*kf,lds_cptr kp){
  kf[0]=*(const __attribute__((address_space(3))) bf16x8*)(kp);      kf[1]=*(const __attribute__((address_space(3))) bf16x8*)(kp+512);
  kf[2]=*(const __attribute__((address_space(3))) bf16x8*)(kp+2048); kf[3]=*(const __attribute__((address_space(3))) bf16x8*)(kp+2560);
  kf[4]=*(const __attribute__((address_space(3))) bf16x8*)(kp+4096); kf[5]=*(const __attribute__((address_space(3))) bf16x8*)(kp+4608);
  kf[6]=*(const __attribute__((address_space(3))) bf16x8*)(kp+6144); kf[7]=*(const __attribute__((address_space(3))) bf16x8*)(kp+6656);
}
__device__ __forceinline__ void kload2(bf16x8*kf,lds_cptr kp,int j){ kf[2*j]=*(const __attribute__((address_space(3))) bf16x8*)(kp+j*2048); kf[2*j+1]=*(const __attribute__((address_space(3))) bf16x8*)(kp+j*2048+512); }
__device__ __forceinline__ s16x4 vtr(lds_cptr p){ return __builtin_bit_cast(s16x4,__builtin_amdgcn_ds_read_tr16_b64_v4i16((__attribute__((address_space(3))) v4i16_t*)p)); }
__device__ __forceinline__ float rowmax(const f32x16&p0,const f32x16&p1){
  float a=max3f(p0[0],p0[1],p1[0]),b=max3f(p0[2],p0[3],p1[1]);a=max3f(a,p1[2],p1[3]);
  #pragma unroll
  for(int r=4;r<16;r+=4){a=max3f(a,p0[r],p0[r+1]);b=max3f(b,p0[r+2],p0[r+3]);a=max3f(a,p1[r],p1[r+1]);b=max3f(b,p1[r+2],p1[r+3]);}
  const float m=max2f(a,b);
  auto rr=__builtin_amdgcn_permlane32_swap(__float_as_uint(m),__float_as_uint(m),false,false);
  return max2f(__uint_as_float(rr[0]),__uint_as_float(rr[1]));
}
__device__ __forceinline__ void pv(f32x16*o,int vb,bf16x8 pa0,bf16x8 pa1,bf16x8 pa2,bf16x8 pa3){
  #pragma unroll
  for(int d0=0;d0<2;++d0){s16x4 lo[4],hi[4];
    #pragma unroll
    for(int ks=0;ks<4;++ks){
      asm volatile("ds_read_b64_tr_b16 %0,%1 offset:%c2":"=&v"(lo[ks]):"v"(vb),"i"(d0*4096+ks*1024):"memory");
      asm volatile("ds_read_b64_tr_b16 %0,%1 offset:%c2":"=&v"(hi[ks]):"v"(vb),"i"(d0*4096+ks*1024+512):"memory");}
    asm volatile("s_waitcnt lgkmcnt(0)":::"memory");SBAR();
    #define PK(k) (bf16x8){lo[k][0],lo[k][1],lo[k][2],lo[k][3],hi[k][0],hi[k][1],hi[k][2],hi[k][3]}
    o[d0]=__builtin_amdgcn_mfma_f32_32x32x16_bf16(pa0,PK(0),o[d0],0,0,0);
    o[d0]=__builtin_amdgcn_mfma_f32_32x32x16_bf16(pa1,PK(1),o[d0],0,0,0);
    o[d0]=__builtin_amdgcn_mfma_f32_32x32x16_bf16(pa2,PK(2),o[d0],0,0,0);
    o[d0]=__builtin_amdgcn_mfma_f32_32x32x16_bf16(pa3,PK(3),o[d0],0,0,0);
    #undef PK
  }
}

#ifndef ATTN_STORE16
#define ATTN_STORE16(p,v) (*(u32x4*)(p)=(v))
#endif
template<int KIND,int THRL> __device__ __forceinline__ void attn_unit(const bf16*Qg,const bf16*__restrict__ Kg,const bf16*__restrict__ Vg,bf16*Og,const int NT,const int tile0,const int q0,const int qb,char*shm,lds_cptr aux){
  int tid_=threadIdx.x; asm volatile("":"+v"(tid_));
  const int tid=tid_,lane=tid&63,r32=lane&31,hi=lane>>5; const int wid=__builtin_amdgcn_readfirstlane(tid>>6);
  const bf16*Qw=Qg+(long)(wid*QBLK)*QP;
  const bf16*Kh=Kg,*Vh=Vg;
  const unsigned lds0=(unsigned)(uintptr_t)shm;
  float*wsf=(float*)(shm+LDS_WS)+wid*64;
  const bf16*ksrc=Kh+(long)lane*QP+wid*8;
  const bf16*vsrc=Vh+(long)(16*(wid&3)+(lane>>2))*QP+(wid>>2)*32+(lane&3)*8;
  const unsigned kdst=lds0+LDS_K+wid*1024, vdst=lds0+LDS_V+wid*1024;
  #define DMA_K(t,slot) glds16(ksrc+(long)(t)*KVBLK*QP,(unsigned)__builtin_amdgcn_readfirstlane(kdst+(slot)))
  #define DMA_V(t,slot) glds16(vsrc+(long)(t)*KVBLK*QP,(unsigned)__builtin_amdgcn_readfirstlane(vdst+(slot)))
  const int vb0=(int)(lds0+LDS_V)+((lane>>4)&1)*32+(lane&3)*8+(4*hi+((lane&15)>>2))*64;
  const char*Kbase=shm+LDS_K; bf16x8 kf[8];
  const lds_cptr shm3=(lds_cptr)shm; const lds_cptr kp0=shm3+LDS_K+hi*1024+r32*16; const lds_cptr vp0=shm3+LDS_V+((lane>>4)&1)*32+(lane&3)*8+(4*hi+((lane&15)>>2))*64;
  DMA_K(0,0);DMA_V(0,0);DMA_K(1,SLOTB);
  bf16x8 qr[4];
  #pragma unroll
  for(int d0=0;d0<4;++d0)qr[d0]=*reinterpret_cast<const bf16x8*>(&Qw[(long)r32*QP+d0*16+hi*8]);
  typedef __attribute__((address_space(3))) const float* lds_fptr; typedef __attribute__((address_space(3))) const unsigned* lds_uptr; typedef __attribute__((address_space(3))) const f32x4_t* lds_f4ptr;
  const int myrow=wid*QBLK+r32; const lds_fptr aux_tab=(lds_fptr)(aux+AUX_TAB);
  float mhat=((lds_fptr)(aux+AUX_R0))[myrow],l_reg=0.f; const unsigned rinfo=((lds_uptr)(aux+AUX_INFO))[myrow];
  f32x16 o[2];o[0]=f32x16{};o[1]=f32x16{};f32x16 negm=f32x16{};
  #define NEGM_SET(tn) do{ if(KIND==1){ const int bn_=(tile0+(tn))>>2; const float nv_=(bn_<qb&&!((rinfo>>bn_)&1u))?-INFINITY:-mhat; _Pragma("unroll") for(int r=0;r<16;++r)negm[r]=nv_; asm volatile("":"+v"(negm)); } }while(0)
  NEGM_SET(0);
  const float NEGI=-INFINITY;
  #define CFENCE() asm volatile("":::"memory")
  #define POST(C0,C1,t) do{ \
    if(KIND==0){ const float nm_=-mhat; asm volatile("s_nop 15\n\ts_nop 7":"+v"(C0),"+v"(C1));   \
      const lds_f4ptr cp_=(lds_f4ptr)(aux_tab+((tile0+(t))*64+4*hi)); \
      _Pragma("unroll") for(int g_=0;g_<4;++g_){ const f32x4_t a_=cp_[2*g_],b_=cp_[8+2*g_]; \
        _Pragma("unroll") for(int i_=0;i_<4;++i_){ C0[4*g_+i_]=fadd_s(C0[4*g_+i_],fsub_s(nm_,a_[i_])); C1[4*g_+i_]=fadd_s(C1[4*g_+i_],fsub_s(nm_,b_[i_])); } if(g_==1)CFENCE(); } } \
    else { const int blk_=(tile0+(t))>>2; \
      const int dw_=(q0+wid*QBLK)-(tile0+(t))*64;     \
      if(blk_>=qb-1&&dw_<176&&dw_>-32){ asm volatile("s_nop 15\n\ts_nop 7":"+v"(C0),"+v"(C1)); const int db_=(q0+myrow)-((tile0+(t))*64+4*hi); \
        _Pragma("unroll") for(int r=0;r<16;++r){ const int d_=db_-((r&3)+8*(r>>2)); const int i0_=d_<0?0:(d_>128?128:d_), e_=d_-32, i1_=e_<0?0:(e_>128?128:e_); C0[r]=fadd_s(C0[r],aux_tab[i0_]); C1[r]=fadd_s(C1[r],aux_tab[i1_]); if((r&3)==3)CFENCE(); } } } \
  }while(0)
  const int qrel=wid*QBLK+r32;
  #define CMASK(P0,P1,t) do{int jb_=(t)-(NT-4); if(jb_>=0)cmask(P0,P1,jb_,qrel,hi);}while(0)
  bool resc=false;
  #define START(P0,P1) do{ const float rm=rowmax(P0,P1); resc=false; \
    { const float dl=max2f(rm,0.f); mhat=fadd_s(mhat,dl); \
      _Pragma("unroll") for(int r=0;r<16;++r){P0[r]=fsub_s(P0[r],dl);P1[r]=fsub_s(P1[r],dl);} \
      NEGM_SET(1); } \
    _Pragma("unroll") for(int r=0;r<16;++r)P0[r]=__builtin_amdgcn_exp2f(P0[r]); }while(0)
  #define RESC() do{ if(resc){ asm volatile("s_waitcnt lgkmcnt(0)":::"memory"); \
      _Pragma("unroll") for(int d_=0;d_<2;++d_) _Pragma("unroll") for(int r=0;r<16;++r)o[d_][r]*=wsf[crow(r,hi)]; } }while(0)
  f32x16 pA0,pA1,pB0,pB1;
  int sl_prev=0,sl_cur=0,sl_next=SLOTB;
  #define ROT() do{sl_prev=sl_cur;sl_cur=sl_next;sl_next=(sl_next==(NSLOT-1)*SLOTB)?0:sl_next+SLOTB;}while(0)
  DMA_K(2,2*SLOTB);
  WAIT_BAR(3);
  qkt(pA0,pA1,Kbase,qr,negm,r32,hi);asm volatile("s_nop 15\n\ts_nop 7":"+v"(pA0),"+v"(pA1));CMASK(pA0,pA1,0);POST(pA0,pA1,0);
  START(pA0,pA1);
  _Pragma("unroll") for(int r=0;r<16;++r)pA1[r]=__builtin_amdgcn_exp2f(pA1[r]);
  WAIT_BAR(0);
  DMA_K(3,0);DMA_V(1,SLOTB);
  ROT();
  kload8(kf,kp0+sl_cur);
  WAIT_BAR(2);
  s16x4 vlo[8],vhi[8]; u32x4 pw0,pw1,pw2,pw3;
  #define PKW(P,B) cvtpk_s(P[B],P[B+1])
  #define PAF(k) __builtin_bit_cast(bf16x8,pw##k)
  #define VFR(i) (bf16x8){vlo[i][0],vlo[i][1],vlo[i][2],vlo[i][3],vhi[i][0],vhi[i][1],vhi[i][2],vhi[i][3]}
  #define PIN(x) asm volatile("":"+v"(x))
  #define MX3(a,b,c) __builtin_fmaxf(__builtin_fmaxf((a),(b)),(c))
  #define GAPA(MF,A0,A1,A2,A3,W0,W1,PW) do{ MF; sacc+=A0; sacc+=A1; sacc+=A2; sacc+=A3; PIN(sacc); W0; W1; PIN(PW); SBAR(); }while(0)
  #define EX(v) __builtin_amdgcn_exp2f(v)
  #define GAPB(MF,X,B) do{ MF; X[B]=EX(X[B]); X[B+1]=EX(X[B+1]); X[B+2]=EX(X[B+2]); X[B+3]=EX(X[B+3]); PIN(X); SBAR(); }while(0)
  #define VRD(i) do{ vlo[i]=vtr(vp_+(((i)>>2)*4096+((i)&3)*1024)); vhi[i]=vtr(vp_+(((i)>>2)*4096+((i)&3)*1024+512)); }while(0)
  #define KRD(G,j) do{ if(G){ kload2(kf,kp0+sl_next,j); SBAR(); } }while(0)
  #define STEP(C0,C1,P0,P1,t,GK,GV,GL) do{ SBAR(); \
    const lds_cptr vp_=vp0+sl_prev; \
    VRD(0); SBAR(); float sacc=(P0[0]+P0[1]); \
    GAPA(C0=__builtin_amdgcn_mfma_f32_32x32x16_bf16(kf[0],qr[0],negm,0,0,0), P0[2],P0[3],P0[4],P0[5],     pw0[0]=PKW(P0,0), pw0[1]=PKW(P0,2), pw0); \
    VRD(4); SBAR(); GAPA(C1=__builtin_amdgcn_mfma_f32_32x32x16_bf16(kf[1],qr[0],negm,0,0,0), P0[6],P0[7],P0[8],P0[9],     pw0[2]=PKW(P0,4), pw0[3]=PKW(P0,6), pw0); \
    VRD(1); SBAR(); GAPA(C0=__builtin_amdgcn_mfma_f32_32x32x16_bf16(kf[2],qr[1],C0,0,0,0),   P0[10],P0[11],P0[12],P0[13], pw1[0]=PKW(P0,8), pw1[1]=PKW(P0,10), pw1); \
    VRD(5); SBAR(); GAPA(C1=__builtin_amdgcn_mfma_f32_32x32x16_bf16(kf[3],qr[1],C1,0,0,0),   P0[14],P0[15],P1[0],P1[1],   pw1[2]=PKW(P0,12),pw1[3]=PKW(P0,14), pw1); \
    VRD(2); SBAR(); GAPA(C0=__builtin_amdgcn_mfma_f32_32x32x16_bf16(kf[4],qr[2],C0,0,0,0),   P1[2],P1[3],P1[4],P1[5],     pw2[0]=PKW(P1,0), pw2[1]=PKW(P1,2), pw2); \
    VRD(6); SBAR(); GAPA(C1=__builtin_amdgcn_mfma_f32_32x32x16_bf16(kf[5],qr[2],C1,0,0,0),   P1[6],P1[7],P1[8],P1[9],     pw2[2]=PKW(P1,4), pw2[3]=PKW(P1,6), pw2); \
    VRD(3); SBAR(); GAPA(C0=__builtin_amdgcn_mfma_f32_32x32x16_bf16(kf[6],qr[3],C0,0,0,0),   P1[10],P1[11],P1[12],P1[13], pw3[0]=PKW(P1,8), pw3[1]=PKW(P1,10), pw3); \
    VRD(7); SBAR(); GAPA(C1=__builtin_amdgcn_mfma_f32_32x32x16_bf16(kf[7],qr[3],C1,0,0,0),   P1[14],P1[15],0.f,0.f,       pw3[2]=PKW(P1,12),pw3[3]=PKW(P1,14), pw3); \
    l_reg+=sacc; \
    if(GK){DMA_K((t)+3,sl_cur);} if(GV){DMA_V((t)+1,sl_next);} \
    CMASK(C0,C1,t); POST(C0,C1,t); \
    { float a=MX3(C0[0],C0[1],C1[0]),b=MX3(C0[2],C0[3],C1[1]); a=MX3(a,C1[2],C1[3]); \
      _Pragma("unroll") for(int r=4;r<16;r+=4){a=MX3(a,C0[r],C0[r+1]);b=MX3(b,C0[r+2],C0[r+3]);a=MX3(a,C1[r],C1[r+1]);b=MX3(b,C1[r+2],C1[r+3]);} \
      float rm=__builtin_fmaxf(a,b); { auto rr=__builtin_amdgcn_permlane32_swap(__float_as_uint(rm),__float_as_uint(rm),false,false); rm=__builtin_fmaxf(__uint_as_float(rr[0]),__uint_as_float(rr[1])); } \
      resc=false; \
      if(__builtin_expect(__any(rm>(float)THRL),0)){ const float dl=__builtin_fmaxf(rm,0.f); mhat+=dl; \
        _Pragma("unroll") for(int r=0;r<16;++r){C0[r]-=dl;C1[r]-=dl;} \
        const float f=__builtin_amdgcn_exp2f(-dl); l_reg*=f; if(hi==0)wsf[r32]=f; resc=true; } \
      if(KIND==1&&(resc||((tile0+(t)+1)&3)==0)) NEGM_SET((t)+1); } \
    SBAR(); \
    GAPB(o[0]=__builtin_amdgcn_mfma_f32_32x32x16_bf16(PAF(0),VFR(0),o[0],0,0,0), C0,0); \
    GAPB(o[1]=__builtin_amdgcn_mfma_f32_32x32x16_bf16(PAF(0),VFR(4),o[1],0,0,0), C0,4); \
    KRD(GL,0); GAPB(o[0]=__builtin_amdgcn_mfma_f32_32x32x16_bf16(PAF(1),VFR(1),o[0],0,0,0), C0,8); \
    KRD(GL,1); GAPB(o[1]=__builtin_amdgcn_mfma_f32_32x32x16_bf16(PAF(1),VFR(5),o[1],0,0,0), C0,12); \
    KRD(GL,2); GAPB(o[0]=__builtin_amdgcn_mfma_f32_32x32x16_bf16(PAF(2),VFR(2),o[0],0,0,0), C1,0); \
    KRD(GL,3); GAPB(o[1]=__builtin_amdgcn_mfma_f32_32x32x16_bf16(PAF(2),VFR(6),o[1],0,0,0), C1,4); \
    GAPB(o[0]=__builtin_amdgcn_mfma_f32_32x32x16_bf16(PAF(3),VFR(3),o[0],0,0,0), C1,8); \
    GAPB(o[1]=__builtin_amdgcn_mfma_f32_32x32x16_bf16(PAF(3),VFR(7),o[1],0,0,0), C1,12); \
    }while(0)
  int t=1;
  #undef CMASK
  #define CMASK(P0,P1,t) do{}while(0)
  for(;t+5<NT;t+=2){
    STEP(pB0,pB1,pA0,pA1,t,true,true,true);     WAIT_BAR(2); RESC(); ROT();
    STEP(pA0,pA1,pB0,pB1,t+1,true,true,true);   WAIT_BAR(2); RESC(); ROT();
  }
  #undef CMASK
  #define CMASK(P0,P1,t) do{int jb_=(t)-(NT-4); if(jb_>=0)cmask(P0,P1,jb_,qrel,hi);}while(0)
  #define ENDW(tt) do{ if((tt)+3<NT){WAIT_BAR(2);} else if((tt)+2<NT){WAIT_BAR(1);} else {WAIT_BAR(0);} }while(0)
  for(;t+1<NT;t+=2){
    STEP(pB0,pB1,pA0,pA1,t,(t+3<NT),(t+1<NT),(t+1<NT));       ENDW(t);   RESC(); ROT();
    STEP(pA0,pA1,pB0,pB1,t+1,(t+4<NT),(t+2<NT),(t+2<NT));     ENDW(t+1); RESC(); ROT();
  }
  STEP(pB0,pB1,pA0,pA1,NT-1,false,false,false); RESC();
  { float sacc=pB0[0]+pB0[1]; _Pragma("unroll") for(int r=2;r<16;++r)sacc+=pB0[r]; _Pragma("unroll") for(int r=0;r<16;++r)sacc+=pB1[r]; l_reg+=sacc;
    pw0=(u32x4){PKW(pB0,0),PKW(pB0,2),PKW(pB0,4),PKW(pB0,6)};pw1=(u32x4){PKW(pB0,8),PKW(pB0,10),PKW(pB0,12),PKW(pB0,14)};pw2=(u32x4){PKW(pB1,0),PKW(pB1,2),PKW(pB1,4),PKW(pB1,6)};pw3=(u32x4){PKW(pB1,8),PKW(pB1,10),PKW(pB1,12),PKW(pB1,14)};
    SBAR(); pv(o,vb0+sl_cur,PAF(0),PAF(1),PAF(2),PAF(3)); }
  #undef PKW
  #undef PAF
  #undef VFR
  #undef PIN
  #undef MX3
  #undef GAPA
  #undef GAPB
  #undef EX
  #undef VRD
  #undef KRD
  #undef STEP
  #undef ENDW
  {auto rr=__builtin_amdgcn_permlane32_swap(__float_as_uint(l_reg),__float_as_uint(l_reg),false,false);l_reg=__uint_as_float(rr[0])+__uint_as_float(rr[1]);}
  if(hi==0)wsf[32+r32]=l_reg;asm volatile("s_waitcnt lgkmcnt(0)":::"memory");
  float rli[16];
  #pragma unroll
  for(int r=0;r<16;++r)rli[r]=__builtin_amdgcn_rcpf(wsf[32+crow(r,hi)]);
  bf16*Ow=Og+(long)(wid*QBLK)*OPITCH;
  { bf16*stg=(bf16*)(shm+LDS_OST)+wid*2048;
    #pragma unroll
    for(int r=0;r<16;++r){const int orow=crow(r,hi);
      #pragma unroll
      for(int d0=0;d0<2;++d0)stg[orow*64+d0*32+r32]=__float2bfloat16(o[d0][r]*rli[r]);}
    asm volatile("s_waitcnt lgkmcnt(0)":::"memory");
    #pragma unroll
    for(int i=0;i<4;++i){const int row=i*8+(lane>>3),ch=lane&7; const u32x4 v=*(const u32x4*)(stg+row*64+ch*8); ATTN_STORE16(Ow+(long)row*OPITCH+ch*8,v);} }
  asm volatile("s_waitcnt lgkmcnt(0)\n\ts_barrier":::"memory");
  #undef DMA_K
  #undef DMA_V
  #undef CMASK
  #undef START
  #undef RESC
  #undef ROT
  #undef POST
  #undef NEGM_SET
  #undef CFENCE
}
constexpr int ATTN_LDS_BYTES=LDS_BYTES;
#undef SBAR
#undef WAIT_BAR
}

#define GAS __attribute__((address_space(1)))
#define LAS __attribute__((address_space(3)))
typedef unsigned short bf16;
typedef unsigned v4u __attribute__((ext_vector_type(4)));
typedef float f32x4 __attribute__((ext_vector_type(4)));
typedef short bf16x8 __attribute__((ext_vector_type(8)));
typedef GAS unsigned gu32;
typedef GAS unsigned long long gu64;
#define RLX_AGENT __ATOMIC_RELAXED, __HIP_MEMORY_SCOPE_AGENT
#define LDS_WAIT() asm volatile("s_waitcnt lgkmcnt(0)" ::: "memory")
#define VM_WAIT() asm volatile("s_waitcnt vmcnt(0)" ::: "memory")
__device__ __forceinline__ unsigned long long rt() { return __builtin_amdgcn_s_memrealtime(); }

#define XB_TMO      128
#define XB_XCNT(j)  (256  + 64 * (j))
#define XB_XSUB(j)  (1280 + 64 * (j))
#define XB_XGEN(j)  (2304 + 64 * (j))
#define XB_TOP      3328
#define XB_TOPGEN   3392
#define XCD_BAR_WORDS 3456
#define XB_SPIN_CAP (1u << 18)

__device__ __forceinline__ unsigned xb_ld(unsigned* p)              { return __hip_atomic_load(p, __ATOMIC_RELAXED, __HIP_MEMORY_SCOPE_AGENT); }
__device__ __forceinline__ unsigned xb_add(unsigned* p, unsigned v) { return __hip_atomic_fetch_add(p, v, __ATOMIC_RELAXED, __HIP_MEMORY_SCOPE_AGENT); }
__device__ __forceinline__ unsigned xb_xcc_id() { return (unsigned)__builtin_amdgcn_s_getreg((3 << 11) | 20) & 0xFu; }
#define XB_SPIN(cond, bar) do { unsigned _sp = 0; while (cond) { __builtin_amdgcn_s_sleep(1); \
    if ((++_sp & 255u) == 0u) { if (xb_ld(&(bar)[XB_TMO])) break; if (_sp > XB_SPIN_CAP) { atomicAdd(&(bar)[XB_TMO], 1u); break; } } } } while (0)

struct XcdBarrier {
    unsigned* bar; unsigned x;
    volatile LAS unsigned* st;
};

__device__ __forceinline__ XcdBarrier xcd_barrier_post(unsigned* bar, volatile LAS unsigned* st) {
    XcdBarrier b; b.bar = bar; b.x = xb_xcc_id(); b.st = st;
    if (threadIdx.x == 0) (void)xb_add(&bar[XB_XCNT(b.x)], 1u);
    return b;
}
__device__ __forceinline__ void xcd_barrier_complete(unsigned* bar, unsigned x, unsigned& nloc, unsigned& nx) {
    const unsigned G = gridDim.x * gridDim.y * gridDim.z;
    unsigned sum, cnt, mine, sp = 0u;
    for (;;) {
        sum = 0u; cnt = 0u; mine = 0u;
#pragma unroll
        for (unsigned j = 0; j < 16; ++j) { const unsigned c = xb_ld(&bar[XB_XCNT(j)]); sum += c; cnt += (c > 0u) ? 1u : 0u; mine = (j == x) ? c : mine; }
        if (sum == G) break;
        __builtin_amdgcn_s_sleep(1);
        if ((++sp & 255u) == 0u) { if (xb_ld(&bar[XB_TMO])) break; if (sp > XB_SPIN_CAP) { atomicAdd(&bar[XB_TMO], 1u); break; } }
    }
    nloc = mine > 0u ? mine : 1u; nx = cnt > 0u ? cnt : 1u;
}

__device__ __forceinline__ void xcd_barrier(const XcdBarrier& b) {
    asm volatile("s_waitcnt vmcnt(0)" ::: "memory");
    __syncthreads();
    if (threadIdx.x == 0) {
        unsigned* bar = b.bar;
        __builtin_amdgcn_s_waitcnt(0);
        unsigned nloc = b.st[0], nx = b.st[1];
        if (nloc == 0u) { xcd_barrier_complete(bar, b.x, nloc, nx); b.st[0] = nloc; b.st[1] = nx; }
        const unsigned old = xb_add(&bar[XB_XSUB(b.x)], 1u);
        const unsigned gen = old / nloc;
        if (old + 1u == (gen + 1u) * nloc) {
            __builtin_amdgcn_fence(__ATOMIC_RELEASE, "agent");
            asm volatile("s_waitcnt vmcnt(0)" ::: "memory");
            const unsigned og = xb_add(&bar[XB_TOP], 1u);
            const unsigned tg = og / nx;
            if (og + 1u == (tg + 1u) * nx) xb_add(&bar[XB_TOPGEN], 1u);
            else XB_SPIN(xb_ld(&bar[XB_TOPGEN]) == tg, bar);
            __builtin_amdgcn_fence(__ATOMIC_ACQUIRE, "agent");
            xb_add(&bar[XB_XGEN(b.x)], 1u);
            asm volatile("s_waitcnt vmcnt(0)" ::: "memory");
        } else {
            XB_SPIN(xb_ld(&bar[XB_XGEN(b.x)]) == gen, bar);
            __builtin_amdgcn_fence(__ATOMIC_ACQUIRE, "agent");
            asm volatile("s_waitcnt vmcnt(0)" ::: "memory");
        }
    }
    __syncthreads();
}

constexpr int NWAVES = 8;
constexpr int RING_OFF = 0, RING_BYTES = 131072;
constexpr int LDSCTL_OFF = RING_BYTES, MISC_OFF = LDSCTL_OFF + 320;
constexpr int LDS_BYTES = 147456;
constexpr int CW_TMO = 0, CW_CODE = 1, CW_Q = 1024, CW_BAR = 4096;
constexpr float PRUNE_TH = 36.f;
constexpr int AUX_OFF = 86016;
constexpr size_t CTL_ZERO_BYTES = 2 * MiB;
constexpr size_t WS_KM = 1 * MiB, KM_LAYER = 256 * 1024;
constexpr int NPH_LAYER = 7, NPH = 1 + DEPTH * NPH_LAYER;

__device__ __forceinline__ void transpose_item(const float* W, int ldsrc, int k0, int srccol0, float scale, const float* gk, bf16* dst, int ldd, LAS float* scr, int lane) {
    float t[32];
#pragma unroll
    for (int i = 0; i < 32; ++i) { const int kk = 2 * i + (lane >> 5); t[i] = W[(size_t)(k0 + kk) * ldsrc + srccol0 + (lane & 31)]; }
#pragma unroll
    for (int i = 0; i < 32; ++i) { const int kk = 2 * i + (lane >> 5); scr[kk * 33 + (lane & 31)] = t[i] * (gk ? scale * gk[k0 + kk] : scale); }
    LDS_WAIT(); asm volatile("" ::: "memory");
    const int c = lane & 7;
#pragma unroll
    for (int j = 0; j < 4; ++j) { const int n = (lane >> 3) + 8 * j; const LAS float* s = scr + (8 * c) * 33 + n;
        v4u o; o.x = pk2(s[0 * 33], s[1 * 33]); o.y = pk2(s[2 * 33], s[3 * 33]); o.z = pk2(s[4 * 33], s[5 * 33]); o.w = pk2(s[6 * 33], s[7 * 33]);
        *(GAS v4u*)(dst + (size_t)n * ldd + k0 + 8 * c) = o; }
    LDS_WAIT(); asm volatile("" ::: "memory");
}

__device__ __forceinline__ float u2f(const unsigned u) { return __builtin_bit_cast(float, u); }
__device__ __forceinline__ void unpack8(const u32x4 w, float* f) {
    f[0] = __builtin_bit_cast(float, w.x << 16); f[1] = __builtin_bit_cast(float, w.x & 0xffff0000u); f[2] = __builtin_bit_cast(float, w.y << 16); f[3] = __builtin_bit_cast(float, w.y & 0xffff0000u);
    f[4] = __builtin_bit_cast(float, w.z << 16); f[5] = __builtin_bit_cast(float, w.z & 0xffff0000u); f[6] = __builtin_bit_cast(float, w.w << 16); f[7] = __builtin_bit_cast(float, w.w & 0xffff0000u);
}
__device__ __forceinline__ u32x4 pack8(const float* f) { u32x4 w; w.x = pk2(f[0], f[1]); w.y = pk2(f[2], f[3]); w.z = pk2(f[4], f[5]); w.w = pk2(f[6], f[7]); return w; }
__device__ __forceinline__ f32x4 ld4(const float* p) { return *(const f32x4*)p; }
__device__ __forceinline__ f32x4 ld4(const LAS float* p) { return *(const LAS f32x4*)p; }
template <bool RF32, bool XF32, class WFP>
__device__ __forceinline__ void rows_compute(const u32x4 (&cr)[4], const u32x4 (&cy)[2], const float rin, const int m, const int lane, const bool has_y, const float (&gp)[16], void* xout, const bool norm_out, float* rs, WFP WF, const bool has_wf, const float bfl, float* logf) {
    float v[16];
    if (RF32) {
#pragma unroll
        for (int q = 0; q < 4; ++q) { v[4 * q] = u2f(cr[q].x); v[4 * q + 1] = u2f(cr[q].y); v[4 * q + 2] = u2f(cr[q].z); v[4 * q + 3] = u2f(cr[q].w); }
    } else { unpack8(cr[0], v); unpack8(cr[1], v + 8); }
#pragma unroll
    for (int i = 0; i < 16; ++i) v[i] *= rin;
    if (has_y) { float yv[16]; unpack8(cy[0], yv); unpack8(cy[1], yv + 8); float ss = 0.f;
#pragma unroll
        for (int i = 0; i < 16; ++i) ss += yv[i] * yv[i];
        const float r = 1.0f / sqrtf(wave_sum(ss) * (1.f / DM) + RMS_EPS);
#pragma unroll
        for (int i = 0; i < 16; ++i) v[i] += yv[i] * r * gp[i]; }
    float r = 1.f;
    if (norm_out || has_wf) { float ss = 0.f;
#pragma unroll
        for (int i = 0; i < 16; ++i) ss += v[i] * v[i];
        const float ms = wave_sum(ss) * (1.f / DM) + RMS_EPS; r = 1.0f / sqrtf(ms);
        if (rs && lane == 0) rs[m] = sqrtf(ms); }
    if (xout) {
        float w[16];
#pragma unroll
        for (int i = 0; i < 16; ++i) w[i] = norm_out ? v[i] * r : v[i];
        if (XF32) { f32x4* o = (f32x4*)((float*)xout + (size_t)m * DM + 8 * lane); o[0] = (f32x4){w[0], w[1], w[2], w[3]}; o[1] = (f32x4){w[4], w[5], w[6], w[7]}; o[128] = (f32x4){w[8], w[9], w[10], w[11]}; o[129] = (f32x4){w[12], w[13], w[14], w[15]}; }
        else { u32x4* o = (u32x4*)((bf16*)xout + (size_t)m * DM + 8 * lane); o[0] = pack8(w); o[64] = pack8(w + 8); } }
    {
        if (has_wf) {
            float d[8];
#pragma unroll
            for (int h = 0; h < 8; ++h) { d[h] = 0.f;
                if (h < NH) {
#pragma unroll
                    for (int q = 0; q < 4; ++q) { const f32x4 w = ld4(WF + ((h * 4 + q) * 64 + lane) * 4); d[h] += (v[4 * q] * w.x + v[4 * q + 1] * w.y) + (v[4 * q + 2] * w.z + v[4 * q + 3] * w.w); } } }
            const bool b0 = lane & 1, b1 = lane & 2, b2 = lane & 4;
            float e4[4], e2[2];
#pragma unroll
            for (int j = 0; j < 4; ++j) { const float snd = b0 ? d[j] : d[j + 4], kp = b0 ? d[j + 4] : d[j]; e4[j] = kp + __shfl_xor(snd, 1); }
#pragma unroll
            for (int j = 0; j < 2; ++j) { const float snd = b1 ? e4[j] : e4[j + 2], kp = b1 ? e4[j + 2] : e4[j]; e2[j] = kp + __shfl_xor(snd, 2); }
            float e = (b2 ? e2[1] : e2[0]) + __shfl_xor(b2 ? e2[0] : e2[1], 4);
            e += __shfl_xor(e, 8); e += __shfl_xor(e, 16); e += __shfl_xor(e, 32);
            const int hh = 4 * (lane & 1) + 2 * ((lane >> 1) & 1) + ((lane >> 2) & 1);
            if (lane < 8 && hh < NH) logf[(size_t)m * NH + hh] = e * r + bfl; } }
}
template <bool RF32, bool XF32, class WFP>
__device__ __forceinline__ void rows_phase(const int gw, const int NGW, const int MEND, const int lane,     const void* resid, const float* rs_in, const bf16* y, const float* gpost, void* xout, const bool norm_out, float* rs, WFP WF, const bool has_wf, const float* bfv, float* logf) {
    float gp[16];
#pragma unroll
    for (int j = 0; j < 2; ++j)
#pragma unroll
        for (int c = 0; c < 2; ++c) { const int e = 8 * lane + 512 * j + 4 * c;
            const f32x4 a = y ? *(const f32x4*)(gpost + e) : (f32x4){0.f, 0.f, 0.f, 0.f};
#pragma unroll
            for (int i = 0; i < 4; ++i) gp[8 * j + 4 * c + i] = a[i]; }
    const int hh_ = 4 * (lane & 1) + 2 * ((lane >> 1) & 1) + ((lane >> 2) & 1);
    const float bfl = (has_wf && lane < 8 && hh_ < NH) ? bfv[hh_] : 0.f;
    const bool has_y = (y != nullptr);
    u32x4 r0[4], y0[2], r1[4], y1[2], r2[4], y2[2], r3[4], y3[2], r4[4], y4[2]; float s0 = 1.f, s1 = 1.f, s2 = 1.f, s3 = 1.f, s4 = 1.f;
#define ROWS_LOAD(R, Y, SC, m_) do { if (rs_in) SC = rs_in[(m_)]; \
        if (RF32) { const u32x4* p_ = (const u32x4*)((const float*)resid + (size_t)(m_) * DM + 8 * lane); R[0] = p_[0]; R[1] = p_[1]; R[2] = p_[128]; R[3] = p_[129]; } \
        else { const u32x4* p_ = (const u32x4*)((const bf16*)resid + (size_t)(m_) * DM + 8 * lane); R[0] = p_[0]; R[1] = p_[64]; } \
        if (has_y) { const u32x4* q_ = (const u32x4*)(y + (size_t)(m_) * DM + 8 * lane); Y[0] = q_[0]; Y[1] = q_[64]; } } while (0)
#define ROWS_DO(R, Y, SC, m_) rows_compute<RF32, XF32, WFP>(R, Y, SC, (m_), lane, has_y, gp, xout, norm_out, rs, WF, has_wf, bfl, logf)
#define RFENCE() asm volatile("" ::: "memory")
    int m = gw;
    if (m + 3 * NGW < MEND) {
        ROWS_LOAD(r0, y0, s0, m); ROWS_LOAD(r1, y1, s1, m + NGW); ROWS_LOAD(r2, y2, s2, m + 2 * NGW); ROWS_LOAD(r3, y3, s3, m + 3 * NGW); RFENCE();
        for (; m + 8 * NGW < MEND; m += 5 * NGW) {
            ROWS_LOAD(r4, y4, s4, m + 4 * NGW); RFENCE(); ROWS_DO(r0, y0, s0, m); RFENCE();
            ROWS_LOAD(r0, y0, s0, m + 5 * NGW); RFENCE(); ROWS_DO(r1, y1, s1, m + NGW); RFENCE();
            ROWS_LOAD(r1, y1, s1, m + 6 * NGW); RFENCE(); ROWS_DO(r2, y2, s2, m + 2 * NGW); RFENCE();
            ROWS_LOAD(r2, y2, s2, m + 7 * NGW); RFENCE(); ROWS_DO(r3, y3, s3, m + 3 * NGW); RFENCE();
            ROWS_LOAD(r3, y3, s3, m + 8 * NGW); RFENCE(); ROWS_DO(r4, y4, s4, m + 4 * NGW); RFENCE();
        }
        if (m + 4 * NGW < MEND) ROWS_LOAD(r4, y4, s4, m + 4 * NGW);
        RFENCE(); ROWS_DO(r0, y0, s0, m); RFENCE();
        if (m + 5 * NGW < MEND) ROWS_LOAD(r0, y0, s0, m + 5 * NGW);
        RFENCE(); ROWS_DO(r1, y1, s1, m + NGW); RFENCE();
        if (m + 6 * NGW < MEND) ROWS_LOAD(r1, y1, s1, m + 6 * NGW);
        RFENCE(); ROWS_DO(r2, y2, s2, m + 2 * NGW); RFENCE();
        if (m + 7 * NGW < MEND) ROWS_LOAD(r2, y2, s2, m + 7 * NGW);
        RFENCE(); ROWS_DO(r3, y3, s3, m + 3 * NGW); RFENCE();
        if (m + 4 * NGW < MEND) ROWS_DO(r4, y4, s4, m + 4 * NGW);
        if (m + 5 * NGW < MEND) ROWS_DO(r0, y0, s0, m + 5 * NGW);
        if (m + 6 * NGW < MEND) ROWS_DO(r1, y1, s1, m + 6 * NGW);
        if (m + 7 * NGW < MEND) ROWS_DO(r2, y2, s2, m + 7 * NGW);
        m = MEND;
    }
    for (; m < MEND; m += NGW) { ROWS_LOAD(r0, y0, s0, m); ROWS_DO(r0, y0, s0, m); }
#undef ROWS_LOAD
#undef ROWS_DO
#undef RFENCE
}

struct Args { const float* in[13]; float* out; unsigned char* ws; int ph_lo, ph_hi, li, pad; };

__global__ void __launch_bounds__(NWAVES * 64, 2) mk_fwd(Args args) {
    extern __shared__ __attribute__((aligned(16))) unsigned char lds[];
    LAS unsigned char* L = (LAS unsigned char*)lds;
    volatile LAS unsigned* MISC = (volatile LAS unsigned*)(L + MISC_OFF);
    const int G = gridDim.x; const int bx = blockIdx.x; const int vcu = (G % 8 == 0) ? (bx % 8) * (G / 8) + bx / 8 : bx;
    const int NGW = G * NWAVES;
#define PHASE_IDS() int tid_ = threadIdx.x; asm volatile("" : "+v"(tid_)); const int tid = tid_, lane = tid & 63, wave = __builtin_amdgcn_readfirstlane(tid >> 6), gw = vcu * NWAVES + wave; (void)tid; (void)lane; (void)gw
#define ROWMAP() int mfirst = gw, mstride = NGW, mend = M; if (G == 256) { const int xcd_ = gw >> 8; mfirst = xcd_ * SEQ + (gw & 255); mstride = 256; mend = (xcd_ + 1) * SEQ; }
    unsigned char* ws = args.ws;
    gu32* ctl = (gu32*)(ws + WS_CTL);
    for (int u = threadIdx.x; u < (LDS_BYTES - LDSCTL_OFF) / 4; u += NWAVES * 64) ((LAS unsigned*)(L + LDSCTL_OFF))[u] = 0u;
    __syncthreads();
    XcdBarrier bar = xcd_barrier_post((unsigned*)(ctl + CW_BAR) + args.li * XCD_BAR_WORDS, MISC + 8);
    const int lo = args.ph_lo, hi = args.ph_hi;
#define IN(k) (lo <= (k) && (k) < hi)
#define SEAM(k) do { if (IN(k) && IN((k) + 1)) xcd_barrier(bar); } while (0)
    const float* x = args.in[0]; const float* w_in = args.in[1]; const float* b_f = args.in[2]; const float* conv_w = args.in[3];
    const float* w_out = args.in[4]; const float* rel_bias = args.in[5]; const float* g_pre_mix = args.in[6]; const float* g_post_mix = args.in[7];
    const float* g_pre_ffn = args.in[8]; const float* g_post_ffn = args.in[9]; const float* w_gate = args.in[10]; const float* w_up = args.in[11]; const float* w_down = args.in[12];
    float* out = args.out;
    float* LOGF = (float*)(ws + WS_LOGF); float* RS = (float*)(ws + WS_KMEAN); float* KNP = (float*)(ws + WS_CUM);
    bf16* XN = (bf16*)(ws + WS_XN); bf16* MIXIN = (bf16*)(ws + WS_MIXIN); bf16* XA = (bf16*)(ws + WS_XA); bf16* Y = (bf16*)(ws + WS_XA + 64 * MiB); bf16* P = (bf16*)(ws + WS_P); bf16* H = (bf16*)(ws + WS_H);

    if (IN(0)) { PHASE_IDS();
        LAS float* scr = (LAS float*)(L + RING_OFF + wave * 16384);
        constexpr int I_IN = (PW / 32) * (DM / 64), I_OUT = (DM / 32) * (DM / 64), I_GU = (NGU / 32) * (DM / 64), I_D = (DM / 32) * (DFF / 64), I_L = I_IN + I_OUT + I_GU + I_D;
        for (int it = gw; it < DEPTH * I_L; it += NGW) {
            const int l = it / I_L; int r = it % I_L;
            unsigned char* wl = ws + WS_W + (size_t)l * W_LAYER;
            if (r < I_IN) { const int kb = r / (PW / 32), pb = r % (PW / 32), p0 = pb * 32; const int src = p0 < 2304 ? p0 : p0 + 6;
                const float sc = (p0 < 384 || (p0 >= 1152 && p0 < 1536)) ? C2 : 1.f;
                transpose_item(w_in + (size_t)l * DM * INW, INW, kb * 64, src, sc, g_pre_mix + (size_t)l * DM, (bf16*)(wl + WO_IN) + (size_t)p0 * DM, DM, scr, lane); continue; }
            r -= I_IN;
            if (r < I_OUT) { const int kb = r / (DM / 32), pb = r % (DM / 32);
                transpose_item(w_out + (size_t)l * DM * DM, DM, kb * 64, pb * 32, 1.f, nullptr, (bf16*)(wl + WO_OUT) + (size_t)pb * 32 * DM, DM, scr, lane); continue; }
            r -= I_OUT;
            if (r < I_GU) { const int kb = r / (NGU / 32), pb = r % (NGU / 32), r0 = pb * 32; const int pn = r0 >> 8, bj = (r0 >> 7) & 1, j = r0 & 127;
                transpose_item((bj ? w_up : w_gate) + (size_t)l * DM * DFF, DFF, kb * 64, pn * 128 + j, 1.f, g_pre_ffn + (size_t)l * DM, (bf16*)(wl + WO_GU) + (size_t)r0 * DM, DM, scr, lane); continue; }
            r -= I_GU;
            { const int kb = r / (DM / 32), pb = r % (DM / 32);
                transpose_item(w_down + (size_t)l * DFF * DM, DM, kb * 64, pb * 32, 1.f, nullptr, (bf16*)(wl + WO_D) + (size_t)pb * 32 * DFF, DFF, scr, lane); }
        }
        for (int i = gw * 64 + lane; i < DEPTH * NH * DM; i += NGW * 64) { const int l = i / (NH * DM), r = i % (NH * DM), h = r / DM, q = (r >> 8) & 3, ln = (r >> 2) & 63, k = 8 * ln + 512 * (q >> 1) + 4 * (q & 1) + (r & 3);
            ((float*)(ws + WS_W + (size_t)l * W_LAYER + WO_F))[r] = w_in[(size_t)l * DM * INW + (size_t)k * INW + 2304 + h] * g_pre_mix[(size_t)l * DM + k]; }
        __syncthreads();
        { LAS float* wfl = (LAS float*)(L + RING_OFF + 4096);
          for (int i = tid; i < NH * DM; i += NWAVES * 64) { const int k = i / NH, h = i % NH, ln = (k & 511) >> 3, q = 2 * (k >> 9) + ((k >> 2) & 1); wfl[((h * 4 + q) * 64 + ln) * 4 + (k & 3)] = w_in[(size_t)k * INW + 2304 + h] * g_pre_mix[k]; }
          __syncthreads();
          ROWMAP(); rows_phase<true, false, const LAS float*>(mfirst, mstride, mend, lane, x, nullptr, nullptr, nullptr, XN, true, nullptr, (const LAS float*)wfl, true, b_f, LOGF); }
    }
    SEAM(0);
    for (int l = 0; l < DEPTH; ++l) {
        const int pb = 1 + l * NPH_LAYER;
        unsigned char* wl = ws + WS_W + (size_t)l * W_LAYER;
        const bf16* Win_t = (const bf16*)(wl + WO_IN); const bf16* Wout_t = (const bf16*)(wl + WO_OUT); const bf16* Wgu_t = (const bf16*)(wl + WO_GU); const bf16* Wd_t = (const bf16*)(wl + WO_D);
        const bool last = (l == DEPTH - 1);
        float* KM = (float*)(ws + WS_CTL + WS_KM + (size_t)l * KM_LAYER);
        if (IN(pb + 0)) { PHASE_IDS();
            for (int e = vcu * (NWAVES * 64) + tid; e < M * NH; e += G * NWAVES * 64) LOGF[e] = log_sigmoid(LOGF[e]);
            pg8::Gemm g{l == 0 ? XN : XA, Win_t, M, PW, DM}; pg8::StaticOrder S; S.init(M, PW, G, bx);
            pg8::EpiInProj E{P, PW, KM, KNP};
            pg8::gemm_phase<pg8::EpiInProj, pg8::StaticOrder, true, true>(L + RING_OFF, g, S, E);
        }
        SEAM(pb + 0);
        if (IN(pb + 1)) { PHASE_IDS();
            constexpr int NATT = 2 * BATCH * NH * NBLK, NCONV = M / 128, NUNITS = NATT + NCONV;
            char* shm = (char*)lds + RING_OFF;
            attn_body::lds_cptr aux = (attn_body::lds_cptr)(L + AUX_OFF);
            LAS float* auxR0 = (LAS float*)(L + AUX_OFF + attn_body::AUX_R0); LAS unsigned* auxInfo = (LAS unsigned*)(L + AUX_OFF + attn_body::AUX_INFO); LAS float* auxTab = (LAS float*)(L + AUX_OFF + attn_body::AUX_TAB);
            LAS float* wtot = (LAS float*)(L + AUX_OFF + attn_body::AUX_TAB + 16384);
            const float* cw = conv_w + (size_t)l * 3 * CCH;
            const bool aff = (G == 256); const int xq = aff ? (bx & 7) : 0, Gq = aff ? 32 : G, NUq = aff ? NUNITS / 8 : NUNITS;
            int li = aff ? (bx >> 3) : bx, iter = 0; unsigned nA = (unsigned)(li + Gq);
            while (li < NUq) {
                if (tid == 0) { MISC[16 + ((iter + 1) & 1)] = nA; nA = __hip_atomic_fetch_add(ctl + CW_Q + 64 * (l * 8 + xq), 1u, RLX_AGENT) + 2u * (unsigned)Gq; }
                const int idx = !aff ? li : (li < 96 ? (li / 6) * (BATCH * NH) + xq * NH + li % 6 : (li < 192 ? NATT / 2 + ((li - 96) / 6) * (BATCH * NH) + xq * NH + (li - 96) % 6 : NATT + xq * 32 + (li - 192)));
                int tq = threadIdx.x; asm volatile("" : "+v"(tq));
                if (idx < NATT) {
                const int kind = idx < NATT / 2 ? 1 : 0, ia = idx - (kind ? 0 : NATT / 2), qb = (NBLK - 1) - ia / (BATCH * NH), bh = ia % (BATCH * NH), b = bh / NH, h = bh % NH;
                const int q0 = qb * MBLK; const size_t row0 = (size_t)b * SEQ;
                const int prow = tq >> 1, half = tq & 1;
                const int cq = kind == 0 ? P_FQ : P_MQ, ck = kind == 0 ? P_FK : P_MK, cv = kind == 0 ? P_FV : P_MV;
                const bf16* Qg = P + (row0 + q0) * PW + cq + h * HD; const bf16* Kb = P + row0 * PW + ck + h * HD; const bf16* Vb = P + row0 * PW + cv + h * HD;
                bf16* Og = MIXIN + (row0 + q0) * DM + (kind == 0 ? 384 : 0) + h * HD;
                int tile0 = 0;
                if (kind == 0) {
                    const int k0 = tile0 * 64, kend = q0 + MBLK, kb = k0 + 8 * tq;
                    float loc[8]; float run = 0.f;
#pragma unroll
                    for (int i = 0; i < 8; ++i) { const int key = kb + i; const float v = key < kend ? LOGF[(row0 + key) * NH + h] : 0.f; run += v; loc[i] = run; }
                    float incl = run;
#pragma unroll
                    for (int o = 1; o < 64; o <<= 1) { const float t = __shfl_up(incl, o); if ((tq & 63) >= o) incl += t; }
                    if ((tq & 63) == 63) wtot[tq >> 6] = incl;
                    __syncthreads();
                    float off = incl - run; for (int w = 0; w < (tq >> 6); ++w) off += wtot[w];
#pragma unroll
                    for (int i = 0; i < 8; ++i) { const int key = kb + i; if (key < kend) auxTab[key] = (off + loc[i]) * LOG2E; }
                } else {
                    const float bfar = rel_bias[31 * NH + h];
                    if (tq <= 128) auxTab[tq] = (rel_bias[c_bucket[tq] * NH + h] - bfar) * LOG2E;
                    for (int i = tq; i < qb * HD; i += NWAVES * 64) auxTab[256 + i] = KM[(size_t)bh * NBLK * HD + i];
                }
                __syncthreads();
                if (kind == 0) {
                    const bf16* qp = Qg + (size_t)prow * PW + half * 32; const bf16* kp = Kb + (size_t)(q0 + prow) * PW + half * 32; float d = 0.f, qq = 0.f;
#pragma unroll
                    for (int c = 0; c < 4; ++c) { const bf16x8 qv = *(const bf16x8*)(qp + 8 * c), kv = *(const bf16x8*)(kp + 8 * c);
#pragma unroll
                        for (int j = 0; j < 8; ++j) { const float qf = bf2f((unsigned short)qv[j]); d += qf * bf2f((unsigned short)kv[j]); qq += qf * qf; } }
                    d += __shfl_xor(d, 1); qq += __shfl_xor(qq, 1);
                    float u2 = (auxTab[q0 + prow] - auxTab[q0]) - d;
#pragma unroll
                    for (int o = 2; o < 64; o <<= 1) { qq = fmaxf(qq, __shfl_xor(qq, o)); u2 = fmaxf(u2, __shfl_xor(u2, o)); }
                    if ((tq & 63) == 0) { wtot[8 + (tq >> 6)] = qq; wtot[16 + (tq >> 6)] = u2; }
                    if (tq == 0) ((LAS unsigned*)wtot)[24] = (unsigned)(4 * qb);
                    __syncthreads();
                    float U1 = wtot[8], U2 = wtot[16];
#pragma unroll
                    for (int w = 1; w < 8; ++w) { U1 = fmaxf(U1, wtot[8 + w]); U2 = fmaxf(U2, wtot[16 + w]); }
                    U1 = sqrtf(U1) * 1.0001f;
                    if (tq < 4 * qb) { const float* kn = KNP + ((size_t)bh * 64 + tq) * 2; const float bound = U1 * sqrtf(kn[0] + kn[1]) + U2 + (auxTab[q0] - auxTab[64 * tq + 63]);
                        if (!(bound <= -PRUNE_TH)) __hip_atomic_fetch_min((LAS unsigned*)wtot + 24, (unsigned)tq, __ATOMIC_RELAXED, __HIP_MEMORY_SCOPE_WORKGROUP); }
                    __syncthreads();
                    tile0 = (int)(((LAS unsigned*)wtot)[24] & ~1u);
                }
                {   const bf16* qp = Qg + (size_t)prow * PW + half * 32; const bf16* kp = Kb + (size_t)(q0 + prow) * PW + half * 32; float q[32]; float d = 0.f;
#pragma unroll
                    for (int c = 0; c < 4; ++c) { const bf16x8 qv = *(const bf16x8*)(qp + 8 * c), kv = *(const bf16x8*)(kp + 8 * c);
#pragma unroll
                        for (int j = 0; j < 8; ++j) { q[8 * c + j] = bf2f((unsigned short)qv[j]); d += q[8 * c + j] * bf2f((unsigned short)kv[j]); } }
                    d += __shfl_xor(d, 1);
                    if (kind == 0) { if (half == 0) { auxR0[prow] = d - auxTab[q0 + prow]; auxInfo[prow] = 0u; } }
                    else {
                        int s0 = -1, s1 = -1, s2 = -1; float g0 = -INFINITY, g1 = -INFINITY, g2 = -INFINITY;
                        for (int n = 0; n < qb; ++n) { const LAS f32x4* km = (const LAS f32x4*)(auxTab + 256 + n * HD + half * 32); float g = 0.f;
#pragma unroll
                            for (int j = 0; j < 8; ++j) { const f32x4 kk = km[j]; g += (q[4 * j] * kk.x + q[4 * j + 1] * kk.y) + (q[4 * j + 2] * kk.z + q[4 * j + 3] * kk.w); }
                            g += __shfl_xor(g, 1);
                            if (g > g0) { g2 = g1; s2 = s1; g1 = g0; s1 = s0; g0 = g; s0 = n; } else if (g > g1) { g2 = g1; s2 = s1; g1 = g; s1 = n; } else if (g > g2) { g2 = g; s2 = n; } }
                        unsigned msk = 0u; if (s0 >= 0) msk |= 1u << s0; if (s1 >= 0) msk |= 1u << s1; if (s2 >= 0) msk |= 1u << s2;
                        if (half == 0) { auxR0[prow] = d + auxTab[0]; auxInfo[prow] = msk; }
                    }
                }
                __syncthreads();
                if (kind == 0) attn_body::attn_unit<0, 8>((const attn_body::bf16*)Qg, (const attn_body::bf16*)(Kb + (size_t)tile0 * 64 * PW), (const attn_body::bf16*)(Vb + (size_t)tile0 * 64 * PW), (attn_body::bf16*)Og, 4 * (qb + 1) - tile0, tile0, q0, qb, shm, aux);
                else attn_body::attn_unit<1, 8>((const attn_body::bf16*)Qg, (const attn_body::bf16*)Kb, (const attn_body::bf16*)Vb, (attn_body::bf16*)Og, 4 * (qb + 1), 0, q0, qb, shm, aux);
                } else {
                    const int cg = tq & 31, rg = tq >> 5; const size_t r0 = (size_t)(idx - NATT) * 128 + rg * 8; const int c0 = cg * 8;
                    float w0[8], w1[8], w2[8], u2[8], u1[8];
#pragma unroll
                    for (int j = 0; j < 8; ++j) { w0[j] = cw[c0 + j]; w1[j] = cw[CCH + c0 + j]; w2[j] = cw[2 * CCH + c0 + j]; u2[j] = 0.f; u1[j] = 0.f; }
                    if ((r0 % SEQ) != 0) {
                        const bf16x8 a2 = *(const bf16x8*)(P + (r0 - 2) * PW + P_CC + c0), h2 = *(const bf16x8*)(P + (r0 - 2) * PW + P_CH + c0);
                        const bf16x8 a1 = *(const bf16x8*)(P + (r0 - 1) * PW + P_CC + c0), h1 = *(const bf16x8*)(P + (r0 - 1) * PW + P_CH + c0);
#pragma unroll
                        for (int j = 0; j < 8; ++j) { u2[j] = bf2f((unsigned short)a2[j]) * bf2f((unsigned short)h2[j]); u1[j] = bf2f((unsigned short)a1[j]) * bf2f((unsigned short)h1[j]); }
                    }
#pragma unroll
                    for (int rr = 0; rr < 8; ++rr) { const size_t m = r0 + rr;
                        const bf16x8 a = *(const bf16x8*)(P + m * PW + P_CC + c0), hh = *(const bf16x8*)(P + m * PW + P_CH + c0), bb = *(const bf16x8*)(P + m * PW + P_CB + c0);
                        float o8[8];
#pragma unroll
                        for (int j = 0; j < 8; ++j) { const float u0 = bf2f((unsigned short)a[j]) * bf2f((unsigned short)hh[j]); o8[j] = bf2f((unsigned short)bb[j]) * (w0[j] * u2[j] + w1[j] * u1[j] + w2[j] * u0); u2[j] = u1[j]; u1[j] = u0; }
                        u32x4 w; w.x = pk2(o8[0], o8[1]); w.y = pk2(o8[2], o8[3]); w.z = pk2(o8[4], o8[5]); w.w = pk2(o8[6], o8[7]);
                        *(u32x4*)(MIXIN + m * DM + 768 + c0) = w; }
                    __syncthreads();
                }
                li = (int)MISC[16 + ((iter + 1) & 1)]; ++iter;
            }
        }
        SEAM(pb + 1);
        if (IN(pb + 2)) { PHASE_IDS();
            pg8::Gemm g{MIXIN, Wout_t, M, DM, DM}; pg8::StaticOrder S; S.init(M, DM, G, bx);
            pg8::EpiStoreBf16 E{Y, DM};
            pg8::gemm_phase<pg8::EpiStoreBf16, pg8::StaticOrder, true, true>(L + RING_OFF, g, S, E);
        }
        SEAM(pb + 2);
        if (IN(pb + 3)) { PHASE_IDS(); ROWMAP();
            if (l == 0) rows_phase<true, false, const float*>(mfirst, mstride, mend, lane, x, nullptr, Y, g_post_mix + (size_t)l * DM, XA, true, RS, (const float*)nullptr, false, nullptr, nullptr);
            else rows_phase<false, false, const float*>(mfirst, mstride, mend, lane, XA, RS, Y, g_post_mix + (size_t)l * DM, XA, true, RS, (const float*)nullptr, false, nullptr, nullptr);
        }
        SEAM(pb + 3);
        if (IN(pb + 4)) { PHASE_IDS();
            pg8::Gemm g{XA, Wgu_t, M, NGU, DM}; pg8::StaticOrder S; S.init(M, NGU, G, bx);
            pg8::EpiSwiGLU E{H, DFF};
            pg8::gemm_phase<pg8::EpiSwiGLU, pg8::StaticOrder, true, true>(L + RING_OFF, g, S, E);
        }
        SEAM(pb + 4);
        if (IN(pb + 5)) { PHASE_IDS();
            pg8::Gemm g{H, Wd_t, M, DM, DFF}; pg8::StaticOrder S; S.init(M, DM, G, bx);
            pg8::EpiStoreBf16 E{Y, DM};
            pg8::gemm_phase<pg8::EpiStoreBf16, pg8::StaticOrder, true, true>(L + RING_OFF, g, S, E);
        }
        SEAM(pb + 5);
        if (IN(pb + 6)) { PHASE_IDS(); ROWMAP();
            if (!last) { const float* WFn = (const float*)(ws + WS_W + (size_t)(l + 1) * W_LAYER + WO_F);
                rows_phase<false, false, const float*>(mfirst, mstride, mend, lane, XA, RS, Y, g_post_ffn + (size_t)l * DM, XA, true, RS, WFn, true, b_f + (size_t)(l + 1) * NH, LOGF); }
            else rows_phase<false, true, const float*>(mfirst, mstride, mend, lane, XA, RS, Y, g_post_ffn + (size_t)l * DM, out, false, nullptr, (const float*)nullptr, false, nullptr, nullptr);
        }
        SEAM(pb + 6);
    }
#undef IN
#undef SEAM
}

#ifndef MK_MODE
#define MK_MODE 2
#endif
extern "C" void kernel_launch(void* const* d_in, const int* in_sizes, int n_in, void* d_out, int out_size, void* d_ws, size_t ws_size, hipStream_t stream) {
    if (n_in != 13 || in_sizes[0] != M * DM || out_size != M * DM || ws_size < WS_END) { fprintf(stderr, "kernel_launch: unexpected shapes (n_in %d, in0 %d, out %d, ws %zu)\n", n_in, n_in > 0 ? in_sizes[0] : -1, out_size, ws_size); return; }
    static int grid = 0;
    if (grid == 0) {
        int dev = 0, cus = 0, per_cu = 0;
        if (hipGetDevice(&dev) != hipSuccess || hipDeviceGetAttribute(&cus, hipDeviceAttributeMultiprocessorCount, dev) != hipSuccess) { fprintf(stderr, "kernel_launch: device query failed\n"); grid = -1; return; }
        if (hipFuncSetAttribute((const void*)mk_fwd, hipFuncAttributeMaxDynamicSharedMemorySize, LDS_BYTES) != hipSuccess) { fprintf(stderr, "kernel_launch: hipFuncSetAttribute failed\n"); grid = -1; return; }
        if (hipOccupancyMaxActiveBlocksPerMultiprocessor(&per_cu, (const void*)mk_fwd, NWAVES * 64, LDS_BYTES) != hipSuccess || per_cu < 1) fprintf(stderr, "kernel_launch: occupancy query reports %d\n", per_cu);
        (void)hipGetLastError();
        grid = cus;
    }
    if (grid < 0) return;
    if (hipMemsetAsync((char*)d_ws + WS_CTL, 0, CTL_ZERO_BYTES, stream) != hipSuccess) { fprintf(stderr, "kernel_launch: hipMemsetAsync of the control words failed; nothing launched\n"); return; }
    Args a{};
    for (int i = 0; i < 13; ++i) a.in[i] = (const float*)d_in[i];
    a.out = (float*)d_out; a.ws = (unsigned char*)d_ws;
#if MK_MODE == 2
    a.ph_lo = 0; a.ph_hi = NPH; a.li = 0;
    hipLaunchKernelGGL(mk_fwd, dim3(grid), dim3(NWAVES * 64), LDS_BYTES, stream, a);
#else
    for (int p = 0; p < NPH; ++p) { a.ph_lo = p; a.ph_hi = p + 1; a.li = p; hipLaunchKernelGGL(mk_fwd, dim3(grid), dim3(NWAVES * 64), LDS_BYTES, stream, a); }
#endif
}
```

```cpp
#include <hip/hip_runtime.h>
#include <cstdio>
#include <cstdint>

typedef unsigned short bf16;
typedef short bf16x8 __attribute__((ext_vector_type(8)));
typedef float f32x4 __attribute__((ext_vector_type(4)));
typedef unsigned u32x4 __attribute__((ext_vector_type(4)));
typedef unsigned u32x2 __attribute__((ext_vector_type(2)));

constexpr int DM = 1024, BATCH = 8, SEQ = 4096, DEPTH = 2, HD = 64, NH = 6, CCH = 256;
constexpr int M = BATCH * SEQ;
constexpr int INW = 3078, PW = 3072, DFF = 2816, NGU = 2 * DFF;
constexpr int MBLK = 256, NBLK = SEQ / MBLK;
constexpr float RMS_EPS = 1e-6f;
constexpr float LOG2E = 1.4426950408889634f;
constexpr float C2 = 0.125f * LOG2E;
constexpr int P_MQ = 0, P_MK = 384, P_MV = 768, P_FQ = 1152, P_FK = 1536, P_FV = 1920, P_CB = 2304, P_CC = 2560, P_CH = 2816;
constexpr size_t MiB = 1u << 20;
constexpr size_t WS_CTL = 0;
constexpr size_t WS_W = 2 * MiB, W_LAYER = 25 * MiB;
constexpr size_t WO_IN = 0, WO_OUT = 6 * MiB, WO_GU = 8 * MiB, WO_D = 19 * MiB, WO_F = 24 * MiB + 512 * 1024;
constexpr size_t WS_LOGF = 52 * MiB, WS_CUM = 53 * MiB, WS_KMEAN = 54 * MiB;
constexpr size_t WS_XN = 56 * MiB, WS_MIXIN = 120 * MiB, WS_XA = 184 * MiB, WS_P = 312 * MiB, WS_H = WS_P, WS_END = 504 * MiB;

__constant__ int c_bucket[129] = {0, 1, 2, 3, 4, 5, 6, 7, 8, 9, 10, 11, 12, 13, 14, 15, 16, 16, 16, 17, 17, 18, 18, 18, 19, 19, 19, 20, 20, 20, 20, 21, 21, 21, 21, 22, 22, 22, 22, 22, 23, 23, 23, 23, 23, 23, 24, 24, 24, 24, 24, 24, 25, 25, 25, 25, 25, 25, 25, 26, 26, 26, 26, 26, 26, 26, 26, 27, 27, 27, 27, 27, 27, 27, 27, 27, 27, 28, 28, 28, 28, 28, 28, 28, 28, 28, 28, 29, 29, 29, 29, 29, 29, 29, 29, 29, 29, 29, 29, 30, 30, 30, 30, 30, 30, 30, 30, 30, 30, 30, 30, 30, 30, 31, 31, 31, 31, 31, 31, 31, 31, 31, 31, 31, 31, 31, 31, 31, 31};

__device__ __forceinline__ unsigned f2bf(float f) { unsigned u = __builtin_bit_cast(unsigned, f); return (u + 0x7fffu + ((u >> 16) & 1u)) >> 16; }
__device__ __forceinline__ unsigned pk2(float lo, float hi) { return f2bf(lo) | (f2bf(hi) << 16); }
__device__ __forceinline__ float bf2f(unsigned short b) { return __builtin_bit_cast(float, (unsigned)b << 16); }
__device__ __forceinline__ float wave_sum(float v) {
#pragma unroll
    for (int o = 1; o < 64; o <<= 1) v += __shfl_xor(v, o);
    return v;
}

__device__ __forceinline__ float log_sigmoid(float z) { return z < 0.f ? z - log1pf(expf(z)) : -log1pf(expf(-z)); }
namespace pg8 {
#define PG8_LAS __attribute__((address_space(3)))
typedef unsigned short bf16_t;
typedef short bf16x8 __attribute__((ext_vector_type(8)));
typedef float f32x4 __attribute__((ext_vector_type(4)));
typedef unsigned u32x4 __attribute__((ext_vector_type(4)));
constexpr int BM = 256, BK = 64, HALF = 128, HTB = HALF * BK * 2  , STAGE_BYTES = 8 * HTB, NXCD = 8, WGM = 8;

__host__ __device__ __forceinline__ int lds_byte(int r, int c) { const int st = (r >> 4) * 2 + (c >> 5), rr = r & 15, cc = c & 31, ob = rr * 64 + cc * 2; return st * 1024 + (ob ^ (((ob >> 9) & 1) << 5)); }
__host__ __device__ __forceinline__ void stage_rc(int b, int& R, int& C) { const int st = b / 1024, sb = b % 1024, swz = sb ^ (((sb >> 9) & 1) << 5); R = (st >> 1) * 16 + swz / 64; C = (st & 1) * 32 + (swz % 64) / 2; }
__host__ __device__ __forceinline__ int perm32(int rho) { const int n = rho >> 4, i = rho & 15; return 8 * (i >> 2) + 4 * n + (i & 3); }

struct Unit { int pm, pn; };
struct Gemm { const bf16_t* A; const bf16_t* Bt; int M, N, K; };

struct StaticOrder {
    int nM, nN, nwg, G, c;
    __host__ __device__ void init(int M, int N, int G_, int c_) { nM = M / BM; nN = N / BM; nwg = nM * nN; G = G_; c = c_; }
    __host__ __device__ bool next(int i, Unit& u) const {
        const long L = (long)i * G + c; if (L >= nwg) return false;
        int wgid = (int)L; { const int q = nwg / NXCD, r = nwg % NXCD, xcd = wgid % NXCD, off = wgid / NXCD; wgid = (xcd < r ? xcd * (q + 1) : r * (q + 1) + (xcd - r) * q) + off; }
        const int nig = WGM * nN, gid = wgid / nig, fm = gid * WGM, gsz = (nM - fm) < WGM ? (nM - fm) : WGM;
        u.pm = fm + ((wgid % nig) % gsz); u.pn = (wgid % nig) / gsz; return true;
    }
    __device__ __forceinline__ void a_ready(const Unit&) const {}
    __device__ __forceinline__ void done(const Unit&) const {}
};
__device__ __forceinline__ unsigned cvt_pk_bf16(float lo, float hi) { unsigned r; asm volatile("v_cvt_pk_bf16_f32 %0, %1, %2" : "=v"(r) : "v"(lo), "v"(hi)); return r; }
typedef float f32x2 __attribute__((ext_vector_type(2)));
struct EpiStoreBf16 {
    static constexpr bool PERM = true, AFTER_DRAIN = false;
    bf16_t* O; int ldc;
    __device__ __forceinline__ void operator()(const f32x4 (&acc)[2][2][4][2], const Unit& u, int wr, int wc, int fr, int fq) const {
        const int row0 = u.pm * BM + wr * 64 + fr, col0 = u.pn * BM + wc * 32 + 8 * fq;
#pragma unroll
        for (int ai = 0; ai < 2; ++ai)
#pragma unroll
            for (int m = 0; m < 4; ++m) { bf16_t* rowp = O + (size_t)(row0 + ai * HALF + m * 16) * ldc + col0;
#pragma unroll
                for (int bj = 0; bj < 2; ++bj) { const f32x4 v0 = acc[ai][bj][m][0], v1 = acc[ai][bj][m][1];
                    u32x4 w; w.x = cvt_pk_bf16(v0[0], v0[1]); w.y = cvt_pk_bf16(v0[2], v0[3]); w.z = cvt_pk_bf16(v1[0], v1[1]); w.w = cvt_pk_bf16(v1[2], v1[3]);
                    *(u32x4*)(rowp + bj * HALF) = w; } }
    }
};
struct EpiStoreF32 {
    static constexpr bool PERM = false, AFTER_DRAIN = false;
    float* C; int ldc;
    __device__ __forceinline__ void operator()(const f32x4 (&acc)[2][2][4][2], const Unit& u, int wr, int wc, int fr, int fq) const {
        const int row0 = u.pm * BM + wr * 64 + fr, col0 = u.pn * BM + wc * 32 + 4 * fq;
#pragma unroll
        for (int ai = 0; ai < 2; ++ai)
#pragma unroll
            for (int m = 0; m < 4; ++m) { float* rowp = C + (size_t)(row0 + ai * HALF + m * 16) * ldc + col0;
#pragma unroll
                for (int bj = 0; bj < 2; ++bj)
#pragma unroll
                    for (int n = 0; n < 2; ++n) *(f32x4*)(rowp + bj * HALF + n * 16) = acc[ai][bj][m][n]; }
    }
};
__device__ __forceinline__ float silu_mul(float g, float u) { return g * __builtin_amdgcn_rcpf(1.0f + __builtin_amdgcn_exp2f(g * -1.4426950408889634f)) * u; }
struct EpiSwiGLU {
    static constexpr bool PERM = true, AFTER_DRAIN = false;
    bf16_t* O; int ldc;
    __device__ __forceinline__ void operator()(f32x4 (&acc)[2][2][4][2], const Unit& u, int wr, int wc, int fr, int fq) const {
        const int row0 = u.pm * BM + wr * 64 + fr, col0 = u.pn * HALF + wc * 32 + 8 * fq;
#pragma unroll
        for (int ai = 0; ai < 2; ++ai)
#pragma unroll
            for (int m = 0; m < 4; ++m) { bf16_t* rowp = O + (size_t)(row0 + ai * HALF + m * 16) * ldc + col0;
                const f32x4 g0 = acc[ai][0][m][0], g1 = acc[ai][0][m][1], u0 = acc[ai][1][m][0], u1 = acc[ai][1][m][1];
                u32x4 w; w.x = cvt_pk_bf16(silu_mul(g0[0], u0[0]), silu_mul(g0[1], u0[1])); w.y = cvt_pk_bf16(silu_mul(g0[2], u0[2]), silu_mul(g0[3], u0[3]));
                w.z = cvt_pk_bf16(silu_mul(g1[0], u1[0]), silu_mul(g1[1], u1[1])); w.w = cvt_pk_bf16(silu_mul(g1[2], u1[2]), silu_mul(g1[3], u1[3]));
                *(u32x4*)rowp = w; }
    }
};
struct EpiInProj {
    static constexpr bool PERM = true, AFTER_DRAIN = false;
    bf16_t* O; int ldc; float* kmean; float* knp;
    __device__ __forceinline__ void operator()(f32x4 (&acc)[2][2][4][2], const Unit& u, int wr, int wc, int fr, int fq) const {
        const int row0 = u.pm * BM + wr * 64 + fr, col0 = u.pn * BM + wc * 32 + 8 * fq;
#pragma unroll
        for (int ai = 0; ai < 2; ++ai)
#pragma unroll
            for (int m = 0; m < 4; ++m) { bf16_t* rowp = O + (size_t)(row0 + ai * HALF + m * 16) * ldc + col0;
#pragma unroll
                for (int bj = 0; bj < 2; ++bj) { const f32x4 v0 = acc[ai][bj][m][0], v1 = acc[ai][bj][m][1];
                    u32x4 w; w.x = cvt_pk_bf16(v0[0], v0[1]); w.y = cvt_pk_bf16(v0[2], v0[3]); w.z = cvt_pk_bf16(v1[0], v1[1]); w.w = cvt_pk_bf16(v1[2], v1[3]);
                    *(u32x4*)(rowp + bj * HALF) = w; } }
        if (u.pn == 6 || u.pn == 7) {
#pragma unroll
            for (int bj = 0; bj < 2; ++bj) {
                if (u.pn == 7 && bj == 1) continue;
                const int head = 4 * (u.pn - 6) + 2 * bj + (wc >> 1);
#pragma unroll
                for (int ai = 0; ai < 2; ++ai) { float mx = 0.f;
#pragma unroll
                    for (int m = 0; m < 4; ++m) { const f32x4 v0 = acc[ai][bj][m][0], v1 = acc[ai][bj][m][1];
                        float ss = (v0[0] * v0[0] + v0[1] * v0[1]) + (v0[2] * v0[2] + v0[3] * v0[3]) + (v1[0] * v1[0] + v1[1] * v1[1]) + (v1[2] * v1[2] + v1[3] * v1[3]);
                        ss += __shfl_xor(ss, 16); ss += __shfl_xor(ss, 32); mx = fmaxf(mx, ss); }
                    mx = fmaxf(mx, __shfl_xor(mx, 1)); mx = fmaxf(mx, __shfl_xor(mx, 2)); mx = fmaxf(mx, __shfl_xor(mx, 4)); mx = fmaxf(mx, __shfl_xor(mx, 8));
                    if (fr == 0 && fq == 0) knp[((size_t)((u.pm >> 4) * 6 + head) * 64 + ((u.pm & 15) * 4 + ai * 2 + wr)) * 2 + (wc & 1)] = mx * 1.02f; }
            }
        }
        if (u.pn == 1 || u.pn == 2) {
#pragma unroll
            for (int bj = 0; bj < 2; ++bj) {
                if (u.pn == 1 && bj == 0) continue;
                const int cp = u.pn * BM + bj * HALF + wc * 32 + 8 * fq - 384;
                float* dst = kmean + ((size_t)((u.pm >> 4) * 6 + (cp >> 6)) * 16 + (u.pm & 15)) * 64 + (cp & 63);
#pragma unroll
                for (int n = 0; n < 2; ++n)
#pragma unroll
                    for (int i = 0; i < 4; ++i) { float s = 0.f;
#pragma unroll
                        for (int ai = 0; ai < 2; ++ai)
#pragma unroll
                            for (int m = 0; m < 4; ++m) s += acc[ai][bj][m][n][i];
                        s += __shfl_xor(s, 1); s += __shfl_xor(s, 2); s += __shfl_xor(s, 4); s += __shfl_xor(s, 8);
                        if (fr == 0) atomicAdd(dst + 4 * n + i, s * (1.0f / 256.0f)); }
            }
        }
    }
};
template <class Epi, class Sched, bool ALIGN_EPI = false, bool SP2 = false>
__device__ __forceinline__ void gemm_phase(PG8_LAS unsigned char* lds, const Gemm g, const Sched& S, const Epi& E) {
    int tid_ = threadIdx.x; asm volatile("" : "+v"(tid_));
    const int tid = tid_, wid = __builtin_amdgcn_readfirstlane(tid >> 6), lane = tid & 63, wr = wid >> 2, wc = wid & 3, fr = lane & 15, fq = lane >> 4;
    const int K = g.K, nt = K / BK;
    unsigned voffA[2], voffB[2];
#pragma unroll
    for (int i = 0; i < 2; ++i) { int R, C; stage_rc(tid * 16 + i * 8192, R, C); const int Rb = Epi::PERM ? ((R & ~31) + perm32(R & 31)) : R;
        voffA[i] = (unsigned)(R * K + C) * 2u; voffB[i] = (unsigned)(Rb * K + C) * 2u; }
    const size_t kstep = (size_t)(BK * 2);
    const size_t hstep = (size_t)HALF * K * 2;
    const size_t tstep = 2 * hstep;
    const unsigned ldsw = (unsigned)wid * 1024u;
    const int aoff = lds_byte(wr * 64 + fr, fq * 8), boff = lds_byte(wc * 32 + fr, fq * 8);
#define PG8_SA(b, h) (((b) * 2 + (h)) * HTB)
#define PG8_SB(b, h) ((4 + (b) * 2 + (h)) * HTB)
#define PG8_STAGE(bufoff, gbase, voff) do { _Pragma("unroll") for (int _i = 0; _i < 2; ++_i) \
        __builtin_amdgcn_global_load_lds((const unsigned*)((const char*)(gbase) + (voff)[_i]), (PG8_LAS unsigned*)(lds + (bufoff) + ldsw + _i * 8192), 16, 0, 0); } while (0)
#define PG8_LDA(dst, b, h) do { _Pragma("unroll") for (int m = 0; m < 4; ++m) _Pragma("unroll") for (int k = 0; k < 2; ++k) dst[m][k] = *(const PG8_LAS bf16x8*)(lds + PG8_SA(b, h) + aoff + m * 2048 + k * 1024); } while (0)
#define PG8_LDB(dst, b, h) do { _Pragma("unroll") for (int n = 0; n < 2; ++n) _Pragma("unroll") for (int k = 0; k < 2; ++k) dst[n][k] = *(const PG8_LAS bf16x8*)(lds + PG8_SB(b, h) + boff + n * 2048 + k * 1024); } while (0)
#define PG8_MMA(ai, bj, At, Bt) do { __builtin_amdgcn_s_setprio(1); _Pragma("unroll") for (int m = 0; m < 4; ++m) _Pragma("unroll") for (int n = 0; n < 2; ++n) _Pragma("unroll") for (int k = 0; k < 2; ++k) \
        acc[ai][bj][m][n] = __builtin_amdgcn_mfma_f32_16x16x32_bf16(Bt[n][k], At[m][k], acc[ai][bj][m][n], 0, 0, 0); __builtin_amdgcn_s_setprio(0); } while (0)
#define PG8_WAIT_V(n) asm volatile("s_waitcnt vmcnt(" #n ")" ::: "memory")
#define PG8_WAIT_L(n) asm volatile("s_waitcnt lgkmcnt(" #n ")" ::: "memory")
#define PG8_BAR __builtin_amdgcn_s_barrier()
#define PG8_SCHED __builtin_amdgcn_sched_barrier(0)
    Unit cur, nxt; int ui = 0;
    if (!S.next(0, cur)) return;
    f32x4 acc[2][2][4][2];
#pragma unroll
    for (int a = 0; a < 2; ++a)
#pragma unroll
        for (int b = 0; b < 2; ++b)
#pragma unroll
            for (int m = 0; m < 4; ++m)
#pragma unroll
                for (int n = 0; n < 2; ++n) acc[a][b][m][n] = (f32x4){0.f, 0.f, 0.f, 0.f};
    bf16x8 At[4][2], B0[2][2], B1[2][2];
    const char* cA = (const char*)g.A + (size_t)cur.pm * tstep; const char* cB = (const char*)g.Bt + (size_t)cur.pn * tstep;
    S.a_ready(cur);
    if constexpr (SP2) {
        PG8_STAGE(PG8_SB(0, 0), cB, voffB); PG8_STAGE(PG8_SB(0, 1), cB + hstep, voffB); PG8_STAGE(PG8_SA(0, 0), cA, voffA); PG8_STAGE(PG8_SA(0, 1), cA + hstep, voffA);
        if (wr == 1) PG8_BAR;
        PG8_WAIT_V(2); PG8_BAR;
        PG8_STAGE(PG8_SB(1, 0), cB + kstep, voffB); PG8_STAGE(PG8_SA(1, 0), cA + kstep, voffA); PG8_STAGE(PG8_SB(1, 1), cB + hstep + kstep, voffB);
        PG8_WAIT_V(6); PG8_BAR;
    } else {
        PG8_STAGE(PG8_SB(0, 0), cB, voffB); PG8_STAGE(PG8_SA(0, 0), cA, voffA); PG8_STAGE(PG8_SB(0, 1), cB + hstep, voffB); PG8_STAGE(PG8_SA(0, 1), cA + hstep, voffA);
        if (wr == 1) PG8_BAR;
        PG8_WAIT_V(4); PG8_BAR;
        PG8_STAGE(PG8_SB(1, 0), cB + kstep, voffB); PG8_STAGE(PG8_SA(1, 0), cA + kstep, voffA); PG8_STAGE(PG8_SB(1, 1), cB + hstep + kstep, voffB);
        PG8_WAIT_V(6); PG8_BAR;
    }
    for (;;) {
        const bool has_next = S.next(ui + 1, nxt);
        const char* nA = has_next ? (const char*)g.A + (size_t)nxt.pm * tstep : cA; const char* nB = has_next ? (const char*)g.Bt + (size_t)nxt.pn * tstep : cB;
        for (int t = 0; t < nt; t += 2) {
            const bool last = (t == nt - 2);
            const char* a1 = cA + (size_t)(t + 1) * kstep;
            const char* a2 = last ? nA : cA + (size_t)(t + 2) * kstep; const char* b2 = last ? nB : cB + (size_t)(t + 2) * kstep;
            const char* a3 = a2 + kstep; const char* b3 = b2 + kstep;
            if (last && has_next) S.a_ready(nxt);
            if constexpr (SP2) {
            PG8_LDB(B0, 0, 0); PG8_LDB(B1, 0, 1); PG8_SCHED; PG8_LDA(At, 0, 0); PG8_STAGE(PG8_SA(1, 1), a1 + hstep, voffA);
            PG8_WAIT_V(8); PG8_WAIT_L(0); PG8_BAR; PG8_MMA(0, 0, At, B0); PG8_MMA(0, 1, At, B1); PG8_BAR; PG8_SCHED;
            PG8_LDA(At, 0, 1); PG8_STAGE(PG8_SB(0, 0), b2, voffB); PG8_STAGE(PG8_SB(0, 1), b2 + hstep, voffB); PG8_STAGE(PG8_SA(0, 0), a2, voffA);
            PG8_WAIT_V(8); PG8_WAIT_L(0); PG8_BAR; PG8_MMA(1, 0, At, B0); PG8_MMA(1, 1, At, B1); PG8_BAR; PG8_SCHED;
            PG8_LDB(B0, 1, 0); PG8_LDB(B1, 1, 1); PG8_SCHED; PG8_LDA(At, 1, 0); PG8_STAGE(PG8_SA(0, 1), a2 + hstep, voffA);
            PG8_WAIT_V(8); PG8_WAIT_L(0); PG8_BAR; PG8_MMA(0, 0, At, B0); PG8_MMA(0, 1, At, B1); PG8_BAR; PG8_SCHED;
            PG8_LDA(At, 1, 1); PG8_STAGE(PG8_SB(1, 0), b3, voffB); PG8_STAGE(PG8_SB(1, 1), b3 + hstep, voffB); PG8_STAGE(PG8_SA(1, 0), a3, voffA);
            PG8_WAIT_V(8); PG8_WAIT_L(0); PG8_BAR; PG8_MMA(1, 0, At, B0); PG8_MMA(1, 1, At, B1); PG8_BAR; PG8_SCHED;
            } else {
            PG8_LDB(B0, 0, 0); PG8_SCHED; PG8_LDA(At, 0, 0); PG8_STAGE(PG8_SA(1, 1), a1 + hstep, voffA);
            PG8_WAIT_L(8); PG8_BAR; PG8_WAIT_L(0); PG8_MMA(0, 0, At, B0); PG8_BAR; PG8_SCHED;
            PG8_LDB(B1, 0, 1); PG8_STAGE(PG8_SB(0, 0), b2, voffB);
            PG8_BAR; PG8_WAIT_L(0); PG8_MMA(0, 1, At, B1); PG8_BAR;
            PG8_LDA(At, 0, 1); PG8_STAGE(PG8_SA(0, 0), a2, voffA);
            PG8_BAR; PG8_WAIT_L(0); PG8_MMA(1, 0, At, B0); PG8_BAR; PG8_SCHED;
            PG8_STAGE(PG8_SB(0, 1), b2 + hstep, voffB);
            PG8_WAIT_V(6); PG8_BAR; PG8_MMA(1, 1, At, B1); PG8_BAR;
            PG8_LDB(B0, 1, 0); PG8_SCHED; PG8_LDA(At, 1, 0); PG8_STAGE(PG8_SA(0, 1), a2 + hstep, voffA);
            PG8_WAIT_L(8); PG8_BAR; PG8_WAIT_L(0); PG8_MMA(0, 0, At, B0); PG8_BAR; PG8_SCHED;
            PG8_LDB(B1, 1, 1); PG8_STAGE(PG8_SB(1, 0), b3, voffB);
            PG8_BAR; PG8_WAIT_L(0); PG8_MMA(0, 1, At, B1); PG8_BAR;
            PG8_LDA(At, 1, 1); PG8_STAGE(PG8_SA(1, 0), a3, voffA);
            PG8_BAR; PG8_WAIT_L(0); PG8_MMA(1, 0, At, B0); PG8_BAR; PG8_SCHED;
            PG8_STAGE(PG8_SB(1, 1), b3 + hstep, voffB);
            PG8_WAIT_V(6); PG8_BAR; PG8_MMA(1, 1, At, B1); PG8_BAR;
            }
        }
        if constexpr (ALIGN_EPI) { if (wr == 0) PG8_BAR; }
        if constexpr (!Epi::AFTER_DRAIN) { E(acc, cur, wr, wc, fr, fq); S.done(cur); }
        if (!has_next) break;
#pragma unroll
        for (int a = 0; a < 2; ++a)
#pragma unroll
            for (int b = 0; b < 2; ++b)
#pragma unroll
                for (int m = 0; m < 4; ++m)
#pragma unroll
                    for (int n = 0; n < 2; ++n) acc[a][b][m][n] = (f32x4){0.f, 0.f, 0.f, 0.f};
        cur = nxt; cA = nA; cB = nB; ++ui;
        if constexpr (ALIGN_EPI) { if (wr == 1) PG8_BAR; }
    }
    PG8_WAIT_V(0);
    if constexpr (!ALIGN_EPI) { if (wr == 0) PG8_BAR; }
    PG8_BAR;
    if constexpr (Epi::AFTER_DRAIN) { E.fused(acc, cur, wr, wc, fr, fq, lds, wid, lane); S.done(cur); }
#undef PG8_SA
#undef PG8_SB
#undef PG8_STAGE
#undef PG8_LDA
#undef PG8_LDB
#undef PG8_MMA
#undef PG8_WAIT_V
#undef PG8_WAIT_L
#undef PG8_BAR
#undef PG8_SCHED
}
}

#include <hip/hip_bf16.h>
#include <cmath>
namespace attn_body {
using bf16=__hip_bfloat16;
using bf16x8=__attribute__((ext_vector_type(8)))short;
using s16x4=__attribute__((ext_vector_type(4)))short;
using f32x16=__attribute__((ext_vector_type(16)))float;
using u32x4=__attribute__((ext_vector_type(4)))unsigned;
using f32x4_t=__attribute__((ext_vector_type(4)))float;
constexpr int D=64;
constexpr int NW=8,QBLK=32,QB=QBLK*NW,KVBLK=64;
constexpr int QP=3072, OPITCH=1024;
constexpr int AUX_R0=0, AUX_INFO=1024, AUX_TAB=2048, AUX_BYTES=2048+16384+1024;
__device__ __forceinline__ int crow(int r,int hi){return (r&3)+8*(r>>2)+4*hi;}
#define SBAR() __builtin_amdgcn_sched_barrier(0)
__device__ __forceinline__ void cmask(f32x16&p0,f32x16&p1,int jb,int qrel,int hi){
  const float NEG=-INFINITY; int kb=64*jb+4*hi;
  #pragma unroll
  for(int r=0;r<16;++r){int kv=kb+(r&3)+8*(r>>2); if(kv>qrel)p0[r]=NEG; if(kv+32>qrel)p1[r]=NEG;}
}

constexpr int NSLOT=3, SLOTB=8192;
constexpr int LDS_K=0, LDS_V=NSLOT*SLOTB, LDS_WS=2*NSLOT*SLOTB, LDS_OST=LDS_WS+NW*64*4, LDS_BYTES=LDS_OST+NW*4096;
constexpr float C2=0.125f*1.4426950408889634f;
__device__ __forceinline__ void glds16(const void*gsrc,unsigned lds_dst){unsigned keep;
  asm volatile("s_mov_b32 %0, m0\n\ts_mov_b32 m0, %2\n\ts_nop 0\n\tglobal_load_lds_dwordx4 %1, off\n\ts_mov_b32 m0, %0":"=&s"(keep):"v"(gsrc),"s"(lds_dst):"memory");}
__device__ __forceinline__ float max3f(float a,float b,float c){float r;asm("v_max3_f32 %0, %1, %2, %3":"=v"(r):"v"(a),"v"(b),"v"(c));return r;}
__device__ __forceinline__ float max2f(float a,float b){float r;asm("v_max_f32_e32 %0, %1, %2":"=v"(r):"v"(a),"v"(b));return r;}
__device__ __forceinline__ float fadd_s(float a,float b){float r;asm("v_add_f32_e32 %0, %1, %2":"=v"(r):"v"(a),"v"(b));return r;}
__device__ __forceinline__ float fsub_s(float a,float b){float r;asm("v_sub_f32_e32 %0, %1, %2":"=v"(r):"v"(a),"v"(b));return r;}
typedef float f32x2_t __attribute__((ext_vector_type(2))); typedef __bf16 bf16x2_t __attribute__((ext_vector_type(2)));
__device__ __forceinline__ unsigned cvtpk_s(float lo,float hi){f32x2_t v={lo,hi};bf16x2_t b=__builtin_convertvector(v,bf16x2_t);return __builtin_bit_cast(unsigned,b);}
#define WAIT_BAR(N) asm volatile("s_waitcnt vmcnt(" #N ") lgkmcnt(0)\n\ts_barrier":::"memory")

__device__ __forceinline__ void qkt(f32x16&p0,f32x16&p1,const char*Kslot,const bf16x8*qr,const f32x16&negm,int r32,int hi){
  const char*kb=Kslot+hi*1024+r32*16;
  #pragma unroll
  for(int d0=0;d0<4;++d0){
    const bf16x8 b0=*reinterpret_cast<const bf16x8*>(kb+d0*2048);
    const bf16x8 b1=*reinterpret_cast<const bf16x8*>(kb+d0*2048+512);
    if(d0==0){p0=__builtin_amdgcn_mfma_f32_32x32x16_bf16(b0,qr[0],negm,0,0,0);p1=__builtin_amdgcn_mfma_f32_32x32x16_bf16(b1,qr[0],negm,0,0,0);}
    else{p0=__builtin_amdgcn_mfma_f32_32x32x16_bf16(b0,qr[d0],p0,0,0,0);p1=__builtin_amdgcn_mfma_f32_32x32x16_bf16(b1,qr[d0],p1,0,0,0);}}
}
typedef __attribute__((address_space(3))) const char* lds_cptr;
typedef short v4i16_t __attribute__((ext_vector_type(4)));
__device__ __forceinline__ void kload8(bf16x8*kf,lds_cptr kp){
  kf[0]=*(const __attribute__((address_space(3))) bf16x8*)(kp);      kf[1]=*(const __attribute__((address_space(3))) bf16x8*)(kp+512);
  kf[2]=*(const __attribute__((address_space(3))) bf16x8*)(kp+2048); kf[3]=*(const __attribute__((address_space(3))) bf16x8*)(kp+2560);
  kf[4]=*(const __attribute__((address_space(3))) bf16x8*)(kp+4096); kf[5]=*(const __attribute__((address_space(3))) bf16x8*)(kp+4608);
  kf[6]=*(const __attribute__((address_space(3))) bf16x8*)(kp+6144); kf[7]=*(const __attribute__((address_space(3))) bf16x8*)(kp+6656);
}
__device__ __forceinline__ void kload2(bf16x8*kf,lds_cptr kp,int j){ kf[2*j]=*(const __attribute__((address_space(3))) bf16x8*)(kp+j*2048); kf[2*j+1]=*(const __attribute__((address_space(3))) bf16x8*)(kp+j*2048+512); }
__device__ __forceinline__ s16x4 vtr(lds_cptr p){ return __builtin_bit_cast(s16x4,__builtin_amdgcn_ds_read_tr16_b64_v4i16((__attribute__((address_space(3))) v4i16_t*)p)); }
__device__ __forceinline__ float rowmax(const f32x16&p0,const f32x16&p1){
  float a=max3f(p0[0],p0[1],p1[0]),b=max3f(p0[2],p0[3],p1[1]);a=max3f(a,p1[2],p1[3]);
  #pragma unroll
  for(int r=4;r<16;r+=4){a=max3f(a,p0[r],p0[r+1]);b=max3f(b,p0[r+2],p0[r+3]);a=max3f(a,p1[r],p1[r+1]);b=max3f(b,p1[r+2],p1[r+3]);}
  const float m=max2f(a,b);
  auto rr=__builtin_amdgcn_permlane32_swap(__float_as_uint(m),__float_as_uint(m),false,false);
  return max2f(__uint_as_float(rr[0]),__uint_as_float(rr[1]));
}
__device__ __forceinline__ void pv(f32x16*o,int vb,bf16x8 pa0,bf16x8 pa1,bf16x8 pa2,bf16x8 pa3){
  #pragma unroll
  for(int d0=0;d0<2;++d0){s16x4 lo[4],hi[4];
    #pragma unroll
    for(int ks=0;ks<4;++ks){
      asm volatile("ds_read_b64_tr_b16 %0,%1 offset:%c2":"=&v"(lo[ks]):"v"(vb),"i"(d0*4096+ks*1024):"memory");
      asm volatile("ds_read_b64_tr_b16 %0,%1 offset:%c2":"=&v"(hi[ks]):"v"(vb),"i"(d0*4096+ks*1024+512):"memory");}
    asm volatile("s_waitcnt lgkmcnt(0)":::"memory");SBAR();
    #define PK(k) (bf16x8){lo[k][0],lo[k][1],lo[k][2],lo[k][3],hi[k][0],hi[k][1],hi[k][2],hi[k][3]}
    o[d0]=__builtin_amdgcn_mfma_f32_32x32x16_bf16(pa0,PK(0),o[d0],0,0,0);
    o[d0]=__builtin_amdgcn_mfma_f32_32x32x16_bf16(pa1,PK(1),o[d0],0,0,0);
    o[d0]=__builtin_amdgcn_mfma_f32_32x32x16_bf16(pa2,PK(2),o[d0],0,0,0);
    o[d0]=__builtin_amdgcn_mfma_f32_32x32x16_bf16(pa3,PK(3),o[d0],0,0,0);
    #undef PK
  }
}

#ifndef ATTN_STORE16
#define ATTN_STORE16(p,v) (*(u32x4*)(p)=(v))
#endif
template<int KIND,int THRL> __device__ __forceinline__ void attn_unit(const bf16*Qg,const bf16*__restrict__ Kg,const bf16*__restrict__ Vg,bf16*Og,const int NT,const int tile0,const int q0,const int qb,char*shm,lds_cptr aux){
  int tid_=threadIdx.x; asm volatile("":"+v"(tid_));
  const int tid=tid_,lane=tid&63,r32=lane&31,hi=lane>>5; const int wid=__builtin_amdgcn_readfirstlane(tid>>6);
  const bf16*Qw=Qg+(long)(wid*QBLK)*QP;
  const bf16*Kh=Kg,*Vh=Vg;
  const unsigned lds0=(unsigned)(uintptr_t)shm;
  float*wsf=(float*)(shm+LDS_WS)+wid*64;
  const bf16*ksrc=Kh+(long)lane*QP+wid*8;
  const bf16*vsrc=Vh+(long)(16*(wid&3)+(lane>>2))*QP+(wid>>2)*32+(lane&3)*8;
  const unsigned kdst=lds0+LDS_K+wid*1024, vdst=lds0+LDS_V+wid*1024;
  #define DMA_K(t,slot) glds16(ksrc+(long)(t)*KVBLK*QP,(unsigned)__builtin_amdgcn_readfirstlane(kdst+(slot)))
  #define DMA_V(t,slot) glds16(vsrc+(long)(t)*KVBLK*QP,(unsigned)__builtin_amdgcn_readfirstlane(vdst+(slot)))
  const int vb0=(int)(lds0+LDS_V)+((lane>>4)&1)*32+(lane&3)*8+(4*hi+((lane&15)>>2))*64;
  const char*Kbase=shm+LDS_K; bf16x8 kf[8];
  const lds_cptr shm3=(lds_cptr)shm; const lds_cptr kp0=shm3+LDS_K+hi*1024+r32*16; const lds_cptr vp0=shm3+LDS_V+((lane>>4)&1)*32+(lane&3)*8+(4*hi+((lane&15)>>2))*64;
  DMA_K(0,0);DMA_V(0,0);DMA_K(1,SLOTB);
  bf16x8 qr[4];
  #pragma unroll
  for(int d0=0;d0<4;++d0)qr[d0]=*reinterpret_cast<const bf16x8*>(&Qw[(long)r32*QP+d0*16+hi*8]);
  typedef __attribute__((address_space(3))) const float* lds_fptr; typedef __attribute__((address_space(3))) const unsigned* lds_uptr; typedef __attribute__((address_space(3))) const f32x4_t* lds_f4ptr;
  const int myrow=wid*QBLK+r32; const lds_fptr aux_tab=(lds_fptr)(aux+AUX_TAB);
  float mhat=((lds_fptr)(aux+AUX_R0))[myrow],l_reg=0.f; const unsigned rinfo=((lds_uptr)(aux+AUX_INFO))[myrow];
  f32x16 o[2];o[0]=f32x16{};o[1]=f32x16{};f32x16 negm=f32x16{};
  #define NEGM_SET(tn) do{ if(KIND==1){ const int bn_=(tile0+(tn))>>2; const float nv_=(bn_<qb&&!((rinfo>>bn_)&1u))?-INFINITY:-mhat; _Pragma("unroll") for(int r=0;r<16;++r)negm[r]=nv_; asm volatile("":"+v"(negm)); } }while(0)
  NEGM_SET(0);
  const float NEGI=-INFINITY;
  #define CFENCE() asm volatile("":::"memory")
  #define POST(C0,C1,t) do{ \
    if(KIND==0){ const float nm_=-mhat; asm volatile("s_nop 15\n\ts_nop 7":"+v"(C0),"+v"(C1));   \
      const lds_f4ptr cp_=(lds_f4ptr)(aux_tab+((tile0+(t))*64+4*hi)); \
      _Pragma("unroll") for(int g_=0;g_<4;++g_){ const f32x4_t a_=cp_[2*g_],b_=cp_[8+2*g_]; \
        _Pragma("unroll") for(int i_=0;i_<4;++i_){ C0[4*g_+i_]=fadd_s(C0[4*g_+i_],fsub_s(nm_,a_[i_])); C1[4*g_+i_]=fadd_s(C1[4*g_+i_],fsub_s(nm_,b_[i_])); } if(g_==1)CFENCE(); } } \
    else { const int blk_=(tile0+(t))>>2; \
      const int dw_=(q0+wid*QBLK)-(tile0+(t))*64;     \
      if(blk_>=qb-1&&dw_<176&&dw_>-32){ asm volatile("s_nop 15\n\ts_nop 7":"+v"(C0),"+v"(C1)); const int db_=(q0+myrow)-((tile0+(t))*64+4*hi); \
        _Pragma("unroll") for(int r=0;r<16;++r){ const int d_=db_-((r&3)+8*(r>>2)); const int i0_=d_<0?0:(d_>128?128:d_), e_=d_-32, i1_=e_<0?0:(e_>128?128:e_); C0[r]=fadd_s(C0[r],aux_tab[i0_]); C1[r]=fadd_s(C1[r],aux_tab[i1_]); if((r&3)==3)CFENCE(); } } } \
  }while(0)
  const int qrel=wid*QBLK+r32;
  #define CMASK(P0,P1,t) do{int jb_=(t)-(NT-4); if(jb_>=0)cmask(P0,P1,jb_,qrel,hi);}while(0)
  bool resc=false;
  #define START(P0,P1) do{ const float rm=rowmax(P0,P1); resc=false; \
    { const float dl=max2f(rm,0.f); mhat=fadd_s(mhat,dl); \
      _Pragma("unroll") for(int r=0;r<16;++r){P0[r]=fsub_s(P0[r],dl);P1[r]=fsub_s(P1[r],dl);} \
      NEGM_SET(1); } \
    _Pragma("unroll") for(int r=0;r<16;++r)P0[r]=__builtin_amdgcn_exp2f(P0[r]); }while(0)
  #define RESC() do{ if(resc){ asm volatile("s_waitcnt lgkmcnt(0)":::"memory"); \
      _Pragma("unroll") for(int d_=0;d_<2;++d_) _Pragma("unroll") for(int r=0;r<16;++r)o[d_][r]*=wsf[crow(r,hi)]; } }while(0)
  f32x16 pA0,pA1,pB0,pB1;
  int sl_prev=0,sl_cur=0,sl_next=SLOTB;
  #define ROT() do{sl_prev=sl_cur;sl_cur=sl_next;sl_next=(sl_next==(NSLOT-1)*SLOTB)?0:sl_next+SLOTB;}while(0)
  DMA_K(2,2*SLOTB);
  WAIT_BAR(3);
  qkt(pA0,pA1,Kbase,qr,negm,r32,hi);asm volatile("s_nop 15\n\ts_nop 7":"+v"(pA0),"+v"(pA1));CMASK(pA0,pA1,0);POST(pA0,pA1,0);
  START(pA0,pA1);
  _Pragma("unroll") for(int r=0;r<16;++r)pA1[r]=__builtin_amdgcn_exp2f(pA1[r]);
  WAIT_BAR(0);
  DMA_K(3,0);DMA_V(1,SLOTB);
  ROT();
  kload8(kf,kp0+sl_cur);
  WAIT_BAR(2);
  s16x4 vlo[8],vhi[8]; u32x4 pw0,pw1,pw2,pw3;
  #define PKW(P,B) cvtpk_s(P[B],P[B+1])
  #define PAF(k) __builtin_bit_cast(bf16x8,pw##k)
  #define VFR(i) (bf16x8){vlo[i][0],vlo[i][1],vlo[i][2],vlo[i][3],vhi[i][0],vhi[i][1],vhi[i][2],vhi[i][3]}
  #define PIN(x) asm volatile("":"+v"(x))
  #define MX3(a,b,c) __builtin_fmaxf(__builtin_fmaxf((a),(b)),(c))
  #define GAPA(MF,A0,A1,A2,A3,W0,W1,PW) do{ MF; sacc+=A0; sacc+=A1; sacc+=A2; sacc+=A3; PIN(sacc); W0; W1; PIN(PW); SBAR(); }while(0)
  #define EX(v) __builtin_amdgcn_exp2f(v)
  #define GAPB(MF,X,B) do{ MF; X[B]=EX(X[B]); X[B+1]=EX(X[B+1]); X[B+2]=EX(X[B+2]); X[B+3]=EX(X[B+3]); PIN(X); SBAR(); }while(0)
  #define VRD(i) do{ vlo[i]=vtr(vp_+(((i)>>2)*4096+((i)&3)*1024)); vhi[i]=vtr(vp_+(((i)>>2)*4096+((i)&3)*1024+512)); }while(0)
  #define KRD(G,j) do{ if(G){ kload2(kf,kp0+sl_next,j); SBAR(); } }while(0)
  #define STEP(C0,C1,P0,P1,t,GK,GV,GL) do{ SBAR(); \
    const lds_cptr vp_=vp0+sl_prev; \
    VRD(0); SBAR(); float sacc=(P0[0]+P0[1]); \
    GAPA(C0=__builtin_amdgcn_mfma_f32_32x32x16_bf16(kf[0],qr[0],negm,0,0,0), P0[2],P0[3],P0[4],P0[5],     pw0[0]=PKW(P0,0), pw0[1]=PKW(P0,2), pw0); \
    VRD(4); SBAR(); GAPA(C1=__builtin_amdgcn_mfma_f32_32x32x16_bf16(kf[1],qr[0],negm,0,0,0), P0[6],P0[7],P0[8],P0[9],     pw0[2]=PKW(P0,4), pw0[3]=PKW(P0,6), pw0); \
    VRD(1); SBAR(); GAPA(C0=__builtin_amdgcn_mfma_f32_32x32x16_bf16(kf[2],qr[1],C0,0,0,0),   P0[10],P0[11],P0[12],P0[13], pw1[0]=PKW(P0,8), pw1[1]=PKW(P0,10), pw1); \
    VRD(5); SBAR(); GAPA(C1=__builtin_amdgcn_mfma_f32_32x32x16_bf16(kf[3],qr[1],C1,0,0,0),   P0[14],P0[15],P1[0],P1[1],   pw1[2]=PKW(P0,12),pw1[3]=PKW(P0,14), pw1); \
    VRD(2); SBAR(); GAPA(C0=__builtin_amdgcn_mfma_f32_32x32x16_bf16(kf[4],qr[2],C0,0,0,0),   P1[2],P1[3],P1[4],P1[5],     pw2[0]=PKW(P1,0), pw2[1]=PKW(P1,2), pw2); \
    VRD(6); SBAR(); GAPA(C1=__builtin_amdgcn_mfma_f32_32x32x16_bf16(kf[5],qr[2],C1,0,0,0),   P1[6],P1[7],P1[8],P1[9],     pw2[2]=PKW(P1,4), pw2[3]=PKW(P1,6), pw2); \
    VRD(3); SBAR(); GAPA(C0=__builtin_amdgcn_mfma_f32_32x32x16_bf16(kf[6],qr[3],C0,0,0,0),   P1[10],P1[11],P1[12],P1[13], pw3[0]=PKW(P1,8), pw3[1]=PKW(P1,10), pw3); \
    VRD(7); SBAR(); GAPA(C1=__builtin_amdgcn_mfma_f32_32x32x16_bf16(kf[7],qr[3],C1,0,0,0),   P1[14],P1[15],0.f,0.f,       pw3[2]=PKW(P1,12),pw3[3]=PKW(P1,14), pw3); \
    l_reg+=sacc; \
    if(GK){DMA_K((t)+3,sl_cur);} if(GV){DMA_V((t)+1,sl_next);} \
    CMASK(C0,C1,t); POST(C0,C1,t); \
    { float a=MX3(C0[0],C0[1],C1[0]),b=MX3(C0[2],C0[3],C1[1]); a=MX3(a,C1[2],C1[3]); \
      _Pragma("unroll") for(int r=4;r<16;r+=4){a=MX3(a,C0[r],C0[r+1]);b=MX3(b,C0[r+2],C0[r+3]);a=MX3(a,C1[r],C1[r+1]);b=MX3(b,C1[r+2],C1[r+3]);} \
      float rm=__builtin_fmaxf(a,b); { auto rr=__builtin_amdgcn_permlane32_swap(__float_as_uint(rm),__float_as_uint(rm),false,false); rm=__builtin_fmaxf(__uint_as_float(rr[0]),__uint_as_float(rr[1])); } \
      resc=false; \
      if(__builtin_expect(__any(rm>(float)THRL),0)){ const float dl=__builtin_fmaxf(rm,0.f); mhat+=dl; \
        _Pragma("unroll") for(int r=0;r<16;++r){C0[r]-=dl;C1[r]-=dl;} \
        const float f=__builtin_amdgcn_exp2f(-dl); l_reg*=f; if(hi==0)wsf[r32]=f; resc=true; } \
      if(KIND==1&&(resc||((tile0+(t)+1)&3)==0)) NEGM_SET((t)+1); } \
    SBAR(); \
    GAPB(o[0]=__builtin_amdgcn_mfma_f32_32x32x16_bf16(PAF(0),VFR(0),o[0],0,0,0), C0,0); \
    GAPB(o[1]=__builtin_amdgcn_mfma_f32_32x32x16_bf16(PAF(0),VFR(4),o[1],0,0,0), C0,4); \
    KRD(GL,0); GAPB(o[0]=__builtin_amdgcn_mfma_f32_32x32x16_bf16(PAF(1),VFR(1),o[0],0,0,0), C0,8); \
    KRD(GL,1); GAPB(o[1]=__builtin_amdgcn_mfma_f32_32x32x16_bf16(PAF(1),VFR(5),o[1],0,0,0), C0,12); \
    KRD(GL,2); GAPB(o[0]=__builtin_amdgcn_mfma_f32_32x32x16_bf16(PAF(2),VFR(2),o[0],0,0,0), C1,0); \
    KRD(GL,3); GAPB(o[1]=__builtin_amdgcn_mfma_f32_32x32x16_bf16(PAF(2),VFR(6),o[1],0,0,0), C1,4); \
    GAPB(o[0]=__builtin_amdgcn_mfma_f32_32x32x16_bf16(PAF(3),VFR(3),o[0],0,0,0), C1,8); \
    GAPB(o[1]=__builtin_amdgcn_mfma_f32_32x32x16_bf16(PAF(3),VFR(7),o[1],0,0,0), C1,12); \
    }while(0)
  int t=1;
  #undef CMASK
  #define CMASK(P0,P1,t) do{}while(0)
  for(;t+5<NT;t+=2){
    STEP(pB0,pB1,pA0,pA1,t,true,true,true);     WAIT_BAR(2); RESC(); ROT();
    STEP(pA0,pA1,pB0,pB1,t+1,true,true,true);   WAIT_BAR(2); RESC(); ROT();
  }
  #undef CMASK
  #define CMASK(P0,P1,t) do{int jb_=(t)-(NT-4); if(jb_>=0)cmask(P0,P1,jb_,qrel,hi);}while(0)
  #define ENDW(tt) do{ if((tt)+3<NT){WAIT_BAR(2);} else if((tt)+2<NT){WAIT_BAR(1);} else {WAIT_BAR(0);} }while(0)
  for(;t+1<NT;t+=2){
    STEP(pB0,pB1,pA0,pA1,t,(t+3<NT),(t+1<NT),(t+1<NT));       ENDW(t);   RESC(); ROT();
    STEP(pA0,pA1,pB0,pB1,t+1,(t+4<NT),(t+2<NT),(t+2<NT));     ENDW(t+1); RESC(); ROT();
  }
  STEP(pB0,pB1,pA0,pA1,NT-1,false,false,false); RESC();
  { float sacc=pB0[0]+pB0[1]; _Pragma("unroll") for(int r=2;r<16;++r)sacc+=pB0[r]; _Pragma("unroll") for(int r=0;r<16;++r)sacc+=pB1[r]; l_reg+=sacc;
    pw0=(u32x4){PKW(pB0,0),PKW(pB0,2),PKW(pB0,4),PKW(pB0,6)};pw1=(u32x4){PKW(pB0,8),PKW(pB0,10),PKW(pB0,12),PKW(pB0,14)};pw2=(u32x4){PKW(pB1,0),PKW(pB1,2),PKW(pB1,4),PKW(pB1,6)};pw3=(u32x4){PKW(pB1,8),PKW(pB1,10),PKW(pB1,12),PKW(pB1,14)};
    SBAR(); pv(o,vb0+sl_cur,PAF(0),PAF(1),PAF(2),PAF(3)); }
  #undef PKW
  #undef PAF
  #undef VFR
  #undef PIN
  #undef MX3
  #undef GAPA
  #undef GAPB
  #undef EX
  #undef VRD
  #undef KRD
  #undef STEP
  #undef ENDW
  {auto rr=__builtin_amdgcn_permlane32_swap(__float_as_uint(l_reg),__float_as_uint(l_reg),false,false);l_reg=__uint_as_float(rr[0])+__uint_as_float(rr[1]);}
  if(hi==0)wsf[32+r32]=l_reg;asm volatile("s_waitcnt lgkmcnt(0)":::"memory");
  float rli[16];
  #pragma unroll
  for(int r=0;r<16;++r)rli[r]=__builtin_amdgcn_rcpf(wsf[32+crow(r,hi)]);
  bf16*Ow=Og+(long)(wid*QBLK)*OPITCH;
  { bf16*stg=(bf16*)(shm+LDS_OST)+wid*2048;
    #pragma unroll
    for(int r=0;r<16;++r){const int orow=crow(r,hi);
      #pragma unroll
      for(int d0=0;d0<2;++d0)stg[orow*64+d0*32+r32]=__float2bfloat16(o[d0][r]*rli[r]);}
    asm volatile("s_waitcnt lgkmcnt(0)":::"memory");
    #pragma unroll
    for(int i=0;i<4;++i){const int row=i*8+(lane>>3),ch=lane&7; const u32x4 v=*(const u32x4*)(stg+row*64+ch*8); ATTN_STORE16(Ow+(long)row*OPITCH+ch*8,v);} }
  asm volatile("s_waitcnt lgkmcnt(0)\n\ts_barrier":::"memory");
  #undef DMA_K
  #undef DMA_V
  #undef CMASK
  #undef START
  #undef RESC
  #undef ROT
  #undef POST
  #undef NEGM_SET
  #undef CFENCE
}
constexpr int ATTN_LDS_BYTES=LDS_BYTES;
#undef SBAR
#undef WAIT_BAR
}

#define GAS __attribute__((address_space(1)))
#define LAS __attribute__((address_space(3)))
typedef unsigned short bf16;
typedef unsigned v4u __attribute__((ext_vector_type(4)));
typedef float f32x4 __attribute__((ext_vector_type(4)));
typedef short bf16x8 __attribute__((ext_vector_type(8)));
typedef GAS unsigned gu32;
typedef GAS unsigned long long gu64;
#define RLX_AGENT __ATOMIC_RELAXED, __HIP_MEMORY_SCOPE_AGENT
#define LDS_WAIT() asm volatile("s_waitcnt lgkmcnt(0)" ::: "memory")
#define VM_WAIT() asm volatile("s_waitcnt vmcnt(0)" ::: "memory")
__device__ __forceinline__ unsigned long long rt() { return __builtin_amdgcn_s_memrealtime(); }

#define XB_TMO      128
#define XB_XCNT(j)  (256  + 64 * (j))
#define XB_XSUB(j)  (1280 + 64 * (j))
#define XB_XGEN(j)  (2304 + 64 * (j))
#define XB_TOP      3328
#define XB_TOPGEN   3392
#define XCD_BAR_WORDS 3456
#define XB_SPIN_CAP (1u << 18)

__device__ __forceinline__ unsigned xb_ld(unsigned* p)              { return __hip_atomic_load(p, __ATOMIC_RELAXED, __HIP_MEMORY_SCOPE_AGENT); }
__device__ __forceinline__ unsigned xb_add(unsigned* p, unsigned v) { return __hip_atomic_fetch_add(p, v, __ATOMIC_RELAXED, __HIP_MEMORY_SCOPE_AGENT); }
__device__ __forceinline__ unsigned xb_xcc_id() { return (unsigned)__builtin_amdgcn_s_getreg((3 << 11) | 20) & 0xFu; }
#define XB_SPIN(cond, bar) do { unsigned _sp = 0; while (cond) { __builtin_amdgcn_s_sleep(1); \
    if ((++_sp & 255u) == 0u) { if (xb_ld(&(bar)[XB_TMO])) break; if (_sp > XB_SPIN_CAP) { atomicAdd(&(bar)[XB_TMO], 1u); break; } } } } while (0)

struct XcdBarrier {
    unsigned* bar; unsigned x;
    unsigned total;
    volatile LAS unsigned* st;
};

__device__ __forceinline__ XcdBarrier xcd_barrier_post(unsigned* bar, volatile LAS unsigned* st, unsigned total) {
    XcdBarrier b; b.bar = bar; b.x = xb_xcc_id(); b.st = st; b.total = total;
    if (threadIdx.x == 0) (void)xb_add(&bar[XB_XCNT(b.x)], 1u);
    return b;
}
__device__ __forceinline__ void xcd_barrier_complete(unsigned* bar, unsigned x, unsigned& nloc, unsigned& nx, const unsigned G) {
    unsigned sum, cnt, mine, sp = 0u;
    for (;;) {
        sum = 0u; cnt = 0u; mine = 0u;
#pragma unroll
        for (unsigned j = 0; j < 16; ++j) { const unsigned c = xb_ld(&bar[XB_XCNT(j)]); sum += c; cnt += (c > 0u) ? 1u : 0u; mine = (j == x) ? c : mine; }
        if (sum == G) break;
        __builtin_amdgcn_s_sleep(1);
        if ((++sp & 255u) == 0u) { if (xb_ld(&bar[XB_TMO])) break; if (sp > XB_SPIN_CAP) { atomicAdd(&bar[XB_TMO], 1u); break; } }
    }
    nloc = mine > 0u ? mine : 1u; nx = cnt > 0u ? cnt : 1u;
}

__device__ __forceinline__ void xcd_barrier(const XcdBarrier& b) {
    asm volatile("s_waitcnt vmcnt(0)" ::: "memory");
    __syncthreads();
    if (threadIdx.x == 0) {
        unsigned* bar = b.bar;
        __builtin_amdgcn_s_waitcnt(0);
        unsigned nloc = b.st[0], nx = b.st[1];
        if (nloc == 0u) { xcd_barrier_complete(bar, b.x, nloc, nx, b.total); b.st[0] = nloc; b.st[1] = nx; }
        const unsigned old = xb_add(&bar[XB_XSUB(b.x)], 1u);
        const unsigned gen = old / nloc;
        if (old + 1u == (gen + 1u) * nloc) {
            __builtin_amdgcn_fence(__ATOMIC_RELEASE, "agent");
            asm volatile("s_waitcnt vmcnt(0)" ::: "memory");
            const unsigned og = xb_add(&bar[XB_TOP], 1u);
            const unsigned tg = og / nx;
            if (og + 1u == (tg + 1u) * nx) xb_add(&bar[XB_TOPGEN], 1u);
            else XB_SPIN(xb_ld(&bar[XB_TOPGEN]) == tg, bar);
            __builtin_amdgcn_fence(__ATOMIC_ACQUIRE, "agent");
            xb_add(&bar[XB_XGEN(b.x)], 1u);
            asm volatile("s_waitcnt vmcnt(0)" ::: "memory");
        } else {
            XB_SPIN(xb_ld(&bar[XB_XGEN(b.x)]) == gen, bar);
            __builtin_amdgcn_fence(__ATOMIC_ACQUIRE, "agent");
            asm volatile("s_waitcnt vmcnt(0)" ::: "memory");
        }
    }
    __syncthreads();
}

constexpr int NWAVES = 8;
constexpr int RING_OFF = 0, RING_BYTES = 131072;
constexpr int LDSCTL_OFF = RING_BYTES, MISC_OFF = LDSCTL_OFF + 320;
constexpr int LDS_BYTES = 147456;
constexpr int CW_TMO = 0, CW_CODE = 1, CW_Q = 1024, CW_BAR = 4096;
constexpr float PRUNE_TH = 36.f;
constexpr int AUX_OFF = 86016;
constexpr size_t CTL_ZERO_BYTES = 2 * MiB;
constexpr size_t WS_KM = 1 * MiB, KM_LAYER = 256 * 1024;
constexpr int NPH_LAYER = 7, NPH = 1 + DEPTH * NPH_LAYER;

__device__ __forceinline__ void transpose_item(const float* W, int ldsrc, int k0, int srccol0, float scale, const float* gk, bf16* dst, int ldd, LAS float* scr, int lane) {
    float t[32];
#pragma unroll
    for (int i = 0; i < 32; ++i) { const int kk = 2 * i + (lane >> 5); t[i] = W[(size_t)(k0 + kk) * ldsrc + srccol0 + (lane & 31)]; }
#pragma unroll
    for (int i = 0; i < 32; ++i) { const int kk = 2 * i + (lane >> 5); scr[kk * 33 + (lane & 31)] = t[i] * (gk ? scale * gk[k0 + kk] : scale); }
    LDS_WAIT(); asm volatile("" ::: "memory");
    const int c = lane & 7;
#pragma unroll
    for (int j = 0; j < 4; ++j) { const int n = (lane >> 3) + 8 * j; const LAS float* s = scr + (8 * c) * 33 + n;
        v4u o; o.x = pk2(s[0 * 33], s[1 * 33]); o.y = pk2(s[2 * 33], s[3 * 33]); o.z = pk2(s[4 * 33], s[5 * 33]); o.w = pk2(s[6 * 33], s[7 * 33]);
        *(GAS v4u*)(dst + (size_t)n * ldd + k0 + 8 * c) = o; }
    LDS_WAIT(); asm volatile("" ::: "memory");
}

__device__ __forceinline__ float u2f(const unsigned u) { return __builtin_bit_cast(float, u); }
__device__ __forceinline__ void unpack8(const u32x4 w, float* f) {
    f[0] = __builtin_bit_cast(float, w.x << 16); f[1] = __builtin_bit_cast(float, w.x & 0xffff0000u); f[2] = __builtin_bit_cast(float, w.y << 16); f[3] = __builtin_bit_cast(float, w.y & 0xffff0000u);
    f[4] = __builtin_bit_cast(float, w.z << 16); f[5] = __builtin_bit_cast(float, w.z & 0xffff0000u); f[6] = __builtin_bit_cast(float, w.w << 16); f[7] = __builtin_bit_cast(float, w.w & 0xffff0000u);
}
__device__ __forceinline__ u32x4 pack8(const float* f) { u32x4 w; w.x = pk2(f[0], f[1]); w.y = pk2(f[2], f[3]); w.z = pk2(f[4], f[5]); w.w = pk2(f[6], f[7]); return w; }
__device__ __forceinline__ f32x4 ld4(const float* p) { return *(const f32x4*)p; }
__device__ __forceinline__ f32x4 ld4(const LAS float* p) { return *(const LAS f32x4*)p; }
template <bool RF32, bool XF32, class WFP>
__device__ __forceinline__ void rows_compute(const u32x4 (&cr)[4], const u32x4 (&cy)[2], const float rin, const int m, const int lane, const bool has_y, const float (&gp)[16], void* xout, const bool norm_out, float* rs, WFP WF, const bool has_wf, const float bfl, float* logf) {
    float v[16];
    if (RF32) {
#pragma unroll
        for (int q = 0; q < 4; ++q) { v[4 * q] = u2f(cr[q].x); v[4 * q + 1] = u2f(cr[q].y); v[4 * q + 2] = u2f(cr[q].z); v[4 * q + 3] = u2f(cr[q].w); }
    } else { unpack8(cr[0], v); unpack8(cr[1], v + 8); }
#pragma unroll
    for (int i = 0; i < 16; ++i) v[i] *= rin;
    if (has_y) { float yv[16]; unpack8(cy[0], yv); unpack8(cy[1], yv + 8); float ss = 0.f;
#pragma unroll
        for (int i = 0; i < 16; ++i) ss += yv[i] * yv[i];
        const float r = 1.0f / sqrtf(wave_sum(ss) * (1.f / DM) + RMS_EPS);
#pragma unroll
        for (int i = 0; i < 16; ++i) v[i] += yv[i] * r * gp[i]; }
    float r = 1.f;
    if (norm_out || has_wf) { float ss = 0.f;
#pragma unroll
        for (int i = 0; i < 16; ++i) ss += v[i] * v[i];
        const float ms = wave_sum(ss) * (1.f / DM) + RMS_EPS; r = 1.0f / sqrtf(ms);
        if (rs && lane == 0) rs[m] = sqrtf(ms); }
    if (xout) {
        float w[16];
#pragma unroll
        for (int i = 0; i < 16; ++i) w[i] = norm_out ? v[i] * r : v[i];
        if (XF32) { f32x4* o = (f32x4*)((float*)xout + (size_t)m * DM + 8 * lane); o[0] = (f32x4){w[0], w[1], w[2], w[3]}; o[1] = (f32x4){w[4], w[5], w[6], w[7]}; o[128] = (f32x4){w[8], w[9], w[10], w[11]}; o[129] = (f32x4){w[12], w[13], w[14], w[15]}; }
        else { u32x4* o = (u32x4*)((bf16*)xout + (size_t)m * DM + 8 * lane); o[0] = pack8(w); o[64] = pack8(w + 8); } }
    {
        if (has_wf) {
            float d[8];
#pragma unroll
            for (int h = 0; h < 8; ++h) { d[h] = 0.f;
                if (h < NH) {
#pragma unroll
                    for (int q = 0; q < 4; ++q) { const f32x4 w = ld4(WF + ((h * 4 + q) * 64 + lane) * 4); d[h] += (v[4 * q] * w.x + v[4 * q + 1] * w.y) + (v[4 * q + 2] * w.z + v[4 * q + 3] * w.w); } } }
            const bool b0 = lane & 1, b1 = lane & 2, b2 = lane & 4;
            float e4[4], e2[2];
#pragma unroll
            for (int j = 0; j < 4; ++j) { const float snd = b0 ? d[j] : d[j + 4], kp = b0 ? d[j + 4] : d[j]; e4[j] = kp + __shfl_xor(snd, 1); }
#pragma unroll
            for (int j = 0; j < 2; ++j) { const float snd = b1 ? e4[j] : e4[j + 2], kp = b1 ? e4[j + 2] : e4[j]; e2[j] = kp + __shfl_xor(snd, 2); }
            float e = (b2 ? e2[1] : e2[0]) + __shfl_xor(b2 ? e2[0] : e2[1], 4);
            e += __shfl_xor(e, 8); e += __shfl_xor(e, 16); e += __shfl_xor(e, 32);
            const int hh = 4 * (lane & 1) + 2 * ((lane >> 1) & 1) + ((lane >> 2) & 1);
            if (lane < 8 && hh < NH) logf[(size_t)m * NH + hh] = e * r + bfl; } }
}
template <bool RF32, bool XF32, class WFP>
__device__ __forceinline__ void rows_phase(const int gw, const int NGW, const int MEND, const int lane,     const void* resid, const float* rs_in, const bf16* y, const float* gpost, void* xout, const bool norm_out, float* rs, WFP WF, const bool has_wf, const float* bfv, float* logf) {
    float gp[16];
#pragma unroll
    for (int j = 0; j < 2; ++j)
#pragma unroll
        for (int c = 0; c < 2; ++c) { const int e = 8 * lane + 512 * j + 4 * c;
            const f32x4 a = y ? *(const f32x4*)(gpost + e) : (f32x4){0.f, 0.f, 0.f, 0.f};
#pragma unroll
            for (int i = 0; i < 4; ++i) gp[8 * j + 4 * c + i] = a[i]; }
    const int hh_ = 4 * (lane & 1) + 2 * ((lane >> 1) & 1) + ((lane >> 2) & 1);
    const float bfl = (has_wf && lane < 8 && hh_ < NH) ? bfv[hh_] : 0.f;
    const bool has_y = (y != nullptr);
    u32x4 r0[4], y0[2], r1[4], y1[2], r2[4], y2[2], r3[4], y3[2], r4[4], y4[2]; float s0 = 1.f, s1 = 1.f, s2 = 1.f, s3 = 1.f, s4 = 1.f;
#define ROWS_LOAD(R, Y, SC, m_) do { if (rs_in) SC = rs_in[(m_)]; \
        if (RF32) { const u32x4* p_ = (const u32x4*)((const float*)resid + (size_t)(m_) * DM + 8 * lane); R[0] = p_[0]; R[1] = p_[1]; R[2] = p_[128]; R[3] = p_[129]; } \
        else { const u32x4* p_ = (const u32x4*)((const bf16*)resid + (size_t)(m_) * DM + 8 * lane); R[0] = p_[0]; R[1] = p_[64]; } \
        if (has_y) { const u32x4* q_ = (const u32x4*)(y + (size_t)(m_) * DM + 8 * lane); Y[0] = q_[0]; Y[1] = q_[64]; } } while (0)
#define ROWS_DO(R, Y, SC, m_) rows_compute<RF32, XF32, WFP>(R, Y, SC, (m_), lane, has_y, gp, xout, norm_out, rs, WF, has_wf, bfl, logf)
#define RFENCE() asm volatile("" ::: "memory")
    int m = gw;
    if (m + 3 * NGW < MEND) {
        ROWS_LOAD(r0, y0, s0, m); ROWS_LOAD(r1, y1, s1, m + NGW); ROWS_LOAD(r2, y2, s2, m + 2 * NGW); ROWS_LOAD(r3, y3, s3, m + 3 * NGW); RFENCE();
        for (; m + 8 * NGW < MEND; m += 5 * NGW) {
            ROWS_LOAD(r4, y4, s4, m + 4 * NGW); RFENCE(); ROWS_DO(r0, y0, s0, m); RFENCE();
            ROWS_LOAD(r0, y0, s0, m + 5 * NGW); RFENCE(); ROWS_DO(r1, y1, s1, m + NGW); RFENCE();
            ROWS_LOAD(r1, y1, s1, m + 6 * NGW); RFENCE(); ROWS_DO(r2, y2, s2, m + 2 * NGW); RFENCE();
            ROWS_LOAD(r2, y2, s2, m + 7 * NGW); RFENCE(); ROWS_DO(r3, y3, s3, m + 3 * NGW); RFENCE();
            ROWS_LOAD(r3, y3, s3, m + 8 * NGW); RFENCE(); ROWS_DO(r4, y4, s4, m + 4 * NGW); RFENCE();
        }
        if (m + 4 * NGW < MEND) ROWS_LOAD(r4, y4, s4, m + 4 * NGW);
        RFENCE(); ROWS_DO(r0, y0, s0, m); RFENCE();
        if (m + 5 * NGW < MEND) ROWS_LOAD(r0, y0, s0, m + 5 * NGW);
        RFENCE(); ROWS_DO(r1, y1, s1, m + NGW); RFENCE();
        if (m + 6 * NGW < MEND) ROWS_LOAD(r1, y1, s1, m + 6 * NGW);
        RFENCE(); ROWS_DO(r2, y2, s2, m + 2 * NGW); RFENCE();
        if (m + 7 * NGW < MEND) ROWS_LOAD(r2, y2, s2, m + 7 * NGW);
        RFENCE(); ROWS_DO(r3, y3, s3, m + 3 * NGW); RFENCE();
        if (m + 4 * NGW < MEND) ROWS_DO(r4, y4, s4, m + 4 * NGW);
        if (m + 5 * NGW < MEND) ROWS_DO(r0, y0, s0, m + 5 * NGW);
        if (m + 6 * NGW < MEND) ROWS_DO(r1, y1, s1, m + 6 * NGW);
        if (m + 7 * NGW < MEND) ROWS_DO(r2, y2, s2, m + 7 * NGW);
        m = MEND;
    }
    for (; m < MEND; m += NGW) { ROWS_LOAD(r0, y0, s0, m); ROWS_DO(r0, y0, s0, m); }
#undef ROWS_LOAD
#undef ROWS_DO
#undef RFENCE
}

struct Args { const float* in[13]; float* out; unsigned char* ws; int ph_lo, ph_hi, li, pad; };

__global__ void __launch_bounds__(NWAVES * 64, 2) mk_fwd(Args args) {
    extern __shared__ __attribute__((aligned(16))) unsigned char lds[];
    LAS unsigned char* L = (LAS unsigned char*)lds;
    volatile LAS unsigned* MISC = (volatile LAS unsigned*)(L + MISC_OFF);
    constexpr int MH = M / 2, BH = BATCH / 2;
    const int GA = gridDim.x; const int bxa = blockIdx.x; const int half = (bxa >> 2) & 1;
    const int G = GA / 2, bx = (bxa & 3) + 4 * (bxa >> 3);
    const int vcu = (bx % 4) * (G / 4) + bx / 4;
    const int NGW = G * NWAVES;
#define PHASE_IDS() int tid_ = threadIdx.x; asm volatile("" : "+v"(tid_)); const int tid = tid_, lane = tid & 63, wave = __builtin_amdgcn_readfirstlane(tid >> 6), gw = vcu * NWAVES + wave; (void)tid; (void)lane; (void)gw
    unsigned char* ws = args.ws;
    gu32* ctl = (gu32*)(ws + WS_CTL);
    for (int u = threadIdx.x; u < (LDS_BYTES - LDSCTL_OFF) / 4; u += NWAVES * 64) ((LAS unsigned*)(L + LDSCTL_OFF))[u] = 0u;
    __syncthreads();
    XcdBarrier barF = xcd_barrier_post((unsigned*)(ctl + CW_BAR), MISC + 8, (unsigned)GA);
    XcdBarrier bar = xcd_barrier_post((unsigned*)(ctl + CW_BAR) + (1 + half) * XCD_BAR_WORDS, MISC + 10, (unsigned)G);
    const int lo = args.ph_lo, hi = args.ph_hi;
#define IN(k) (lo <= (k) && (k) < hi)
#define SEAM(k) do { if (IN(k) && IN((k) + 1)) xcd_barrier(bar); } while (0)
    const float* x = args.in[0]; const float* w_in = args.in[1]; const float* b_f = args.in[2]; const float* conv_w = args.in[3];
    const float* w_out = args.in[4]; const float* rel_bias = args.in[5]; const float* g_pre_mix = args.in[6]; const float* g_post_mix = args.in[7];
    const float* g_pre_ffn = args.in[8]; const float* g_post_ffn = args.in[9]; const float* w_gate = args.in[10]; const float* w_up = args.in[11]; const float* w_down = args.in[12];
    float* out = args.out + (size_t)half * MH * DM; x += (size_t)half * MH * DM;
    float* LOGF = (float*)(ws + WS_LOGF) + (size_t)half * MH * NH; float* RS = (float*)(ws + WS_KMEAN) + (size_t)half * MH; float* KNP = (float*)(ws + WS_CUM) + (size_t)half * BH * NH * 64 * 2;
    bf16* XN = (bf16*)(ws + WS_XN) + (size_t)half * MH * DM; bf16* MIXIN = (bf16*)(ws + WS_MIXIN) + (size_t)half * MH * DM; bf16* XA = (bf16*)(ws + WS_XA) + (size_t)half * MH * DM; bf16* Y = (bf16*)(ws + WS_XA + 64 * MiB) + (size_t)half * MH * DM;
    bf16* P = (bf16*)(ws + WS_P) + (size_t)half * MH * PW; bf16* H = (bf16*)(ws + WS_H) + (size_t)half * MH * DFF;

    if (IN(0)) { PHASE_IDS();
      if (half == 0) {
        LAS float* scr = (LAS float*)(L + RING_OFF + wave * 16384);
        constexpr int I_IN = (PW / 32) * (DM / 64), I_OUT = (DM / 32) * (DM / 64), I_GU = (NGU / 32) * (DM / 64), I_D = (DM / 32) * (DFF / 64), I_L = I_IN + I_OUT + I_GU + I_D;
        for (int it = gw; it < DEPTH * I_L; it += NGW) {
            const int l = it / I_L; int r = it % I_L;
            unsigned char* wl = ws + WS_W + (size_t)l * W_LAYER;
            if (r < I_IN) { const int kb = r / (PW / 32), pb = r % (PW / 32), p0 = pb * 32; const int src = p0 < 2304 ? p0 : p0 + 6;
                const float sc = (p0 < 384 || (p0 >= 1152 && p0 < 1536)) ? C2 : 1.f;
                transpose_item(w_in + (size_t)l * DM * INW, INW, kb * 64, src, sc, g_pre_mix + (size_t)l * DM, (bf16*)(wl + WO_IN) + (size_t)p0 * DM, DM, scr, lane); continue; }
            r -= I_IN;
            if (r < I_OUT) { const int kb = r / (DM / 32), pb = r % (DM / 32);
                transpose_item(w_out + (size_t)l * DM * DM, DM, kb * 64, pb * 32, 1.f, nullptr, (bf16*)(wl + WO_OUT) + (size_t)pb * 32 * DM, DM, scr, lane); continue; }
            r -= I_OUT;
            if (r < I_GU) { const int kb = r / (NGU / 32), pb = r % (NGU / 32), r0 = pb * 32; const int pn = r0 >> 8, bj = (r0 >> 7) & 1, j = r0 & 127;
                transpose_item((bj ? w_up : w_gate) + (size_t)l * DM * DFF, DFF, kb * 64, pn * 128 + j, 1.f, g_pre_ffn + (size_t)l * DM, (bf16*)(wl + WO_GU) + (size_t)r0 * DM, DM, scr, lane); continue; }
            r -= I_GU;
            { const int kb = r / (DM / 32), pb = r % (DM / 32);
                transpose_item(w_down + (size_t)l * DFF * DM, DM, kb * 64, pb * 32, 1.f, nullptr, (bf16*)(wl + WO_D) + (size_t)pb * 32 * DFF, DFF, scr, lane); }
        }
        for (int i = gw * 64 + lane; i < DEPTH * NH * DM; i += NGW * 64) { const int l = i / (NH * DM), r = i % (NH * DM), h = r / DM, q = (r >> 8) & 3, ln = (r >> 2) & 63, k = 8 * ln + 512 * (q >> 1) + 4 * (q & 1) + (r & 3);
            ((float*)(ws + WS_W + (size_t)l * W_LAYER + WO_F))[r] = w_in[(size_t)l * DM * INW + (size_t)k * INW + 2304 + h] * g_pre_mix[(size_t)l * DM + k]; }
      } else {
        __syncthreads();
        { LAS float* wfl = (LAS float*)(L + RING_OFF + 4096);
          for (int i = tid; i < NH * DM; i += NWAVES * 64) { const int k = i / NH, h = i % NH, ln = (k & 511) >> 3, q = 2 * (k >> 9) + ((k >> 2) & 1); wfl[((h * 4 + q) * 64 + ln) * 4 + (k & 3)] = w_in[(size_t)k * INW + 2304 + h] * g_pre_mix[k]; }
          __syncthreads();
          rows_phase<true, false, const LAS float*>(gw, NGW, MH, lane, x, nullptr, nullptr, nullptr, XN, true, nullptr, (const LAS float*)wfl, true, b_f, LOGF); }
      }
      xcd_barrier(barF);
      if (half == 0) {
        __syncthreads();
        { LAS float* wfl = (LAS float*)(L + RING_OFF + 4096);
          for (int i = tid; i < NH * DM; i += NWAVES * 64) { const int k = i / NH, h = i % NH, ln = (k & 511) >> 3, q = 2 * (k >> 9) + ((k >> 2) & 1); wfl[((h * 4 + q) * 64 + ln) * 4 + (k & 3)] = w_in[(size_t)k * INW + 2304 + h] * g_pre_mix[k]; }
          __syncthreads();
          rows_phase<true, false, const LAS float*>(gw, NGW, MH, lane, x, nullptr, nullptr, nullptr, XN, true, nullptr, (const LAS float*)wfl, true, b_f, LOGF); }
        xcd_barrier(bar);
      }
    }
    for (int l = 0; l < DEPTH; ++l) {
        const int pb = 1 + l * NPH_LAYER;
        unsigned char* wl = ws + WS_W + (size_t)l * W_LAYER;
        const bf16* Win_t = (const bf16*)(wl + WO_IN); const bf16* Wout_t = (const bf16*)(wl + WO_OUT); const bf16* Wgu_t = (const bf16*)(wl + WO_GU); const bf16* Wd_t = (const bf16*)(wl + WO_D);
        const bool last = (l == DEPTH - 1);
        float* KM = (float*)(ws + WS_CTL + WS_KM + (size_t)l * KM_LAYER) + (size_t)half * BH * NH * NBLK * HD;
        if (IN(pb + 0)) { PHASE_IDS();
            for (int e = vcu * (NWAVES * 64) + tid; e < MH * NH; e += G * NWAVES * 64) LOGF[e] = log_sigmoid(LOGF[e]);
            pg8::Gemm g{l == 0 ? XN : XA, Win_t, MH, PW, DM}; pg8::StaticOrder S; S.init(MH, PW, G, bx);
            pg8::EpiInProj E{P, PW, KM, KNP};
            pg8::gemm_phase<pg8::EpiInProj, pg8::StaticOrder, true, true>(L + RING_OFF, g, S, E);
        }
        SEAM(pb + 0);
        if (IN(pb + 1)) { PHASE_IDS();
            constexpr int NATT = 2 * BH * NH * NBLK, NCONV = MH / 128, NUNITS = NATT + NCONV;
            char* shm = (char*)lds + RING_OFF;
            attn_body::lds_cptr aux = (attn_body::lds_cptr)(L + AUX_OFF);
            LAS float* auxR0 = (LAS float*)(L + AUX_OFF + attn_body::AUX_R0); LAS unsigned* auxInfo = (LAS unsigned*)(L + AUX_OFF + attn_body::AUX_INFO); LAS float* auxTab = (LAS float*)(L + AUX_OFF + attn_body::AUX_TAB);
            LAS float* wtot = (LAS float*)(L + AUX_OFF + attn_body::AUX_TAB + 16384);
            const float* cw = conv_w + (size_t)l * 3 * CCH;
            int idx = bx, iter = 0; unsigned nA = (unsigned)(bx + G);
            while (idx < NUNITS) {
                if (tid == 0) { MISC[16 + ((iter + 1) & 1)] = nA; nA = __hip_atomic_fetch_add(ctl + CW_Q + 64 * (2 * l + half), 1u, RLX_AGENT) + 2u * (unsigned)G; }
                int tq = threadIdx.x; asm volatile("" : "+v"(tq));
                if (idx < NATT) {
                const int kind = idx < NATT / 2 ? 1 : 0, ia = idx - (kind ? 0 : NATT / 2), qb = (NBLK - 1) - ia / (BH * NH), bh = ia % (BH * NH), b = bh / NH, h = bh % NH;
                const int q0 = qb * MBLK; const size_t row0 = (size_t)b * SEQ;
                const int prow = tq >> 1, half = tq & 1;
                const int cq = kind == 0 ? P_FQ : P_MQ, ck = kind == 0 ? P_FK : P_MK, cv = kind == 0 ? P_FV : P_MV;
                const bf16* Qg = P + (row0 + q0) * PW + cq + h * HD; const bf16* Kb = P + row0 * PW + ck + h * HD; const bf16* Vb = P + row0 * PW + cv + h * HD;
                bf16* Og = MIXIN + (row0 + q0) * DM + (kind == 0 ? 384 : 0) + h * HD;
                int tile0 = 0;
                if (kind == 0) {
                    const int k0 = tile0 * 64, kend = q0 + MBLK, kb = k0 + 8 * tq;
                    float loc[8]; float run = 0.f;
#pragma unroll
                    for (int i = 0; i < 8; ++i) { const int key = kb + i; const float v = key < kend ? LOGF[(row0 + key) * NH + h] : 0.f; run += v; loc[i] = run; }
                    float incl = run;
#pragma unroll
                    for (int o = 1; o < 64; o <<= 1) { const float t = __shfl_up(incl, o); if ((tq & 63) >= o) incl += t; }
                    if ((tq & 63) == 63) wtot[tq >> 6] = incl;
                    __syncthreads();
                    float off = incl - run; for (int w = 0; w < (tq >> 6); ++w) off += wtot[w];
#pragma unroll
                    for (int i = 0; i < 8; ++i) { const int key = kb + i; if (key < kend) auxTab[key] = (off + loc[i]) * LOG2E; }
                } else {
                    const float bfar = rel_bias[31 * NH + h];
                    if (tq <= 128) auxTab[tq] = (rel_bias[c_bucket[tq] * NH + h] - bfar) * LOG2E;
                    for (int i = tq; i < qb * HD; i += NWAVES * 64) auxTab[256 + i] = KM[(size_t)bh * NBLK * HD + i];
                }
                __syncthreads();
                if (kind == 0) {
                    const bf16* qp = Qg + (size_t)prow * PW + half * 32; const bf16* kp = Kb + (size_t)(q0 + prow) * PW + half * 32; float d = 0.f, qq = 0.f;
#pragma unroll
                    for (int c = 0; c < 4; ++c) { const bf16x8 qv = *(const bf16x8*)(qp + 8 * c), kv = *(const bf16x8*)(kp + 8 * c);
#pragma unroll
                        for (int j = 0; j < 8; ++j) { const float qf = bf2f((unsigned short)qv[j]); d += qf * bf2f((unsigned short)kv[j]); qq += qf * qf; } }
                    d += __shfl_xor(d, 1); qq += __shfl_xor(qq, 1);
                    float u2 = (auxTab[q0 + prow] - auxTab[q0]) - d;
#pragma unroll
                    for (int o = 2; o < 64; o <<= 1) { qq = fmaxf(qq, __shfl_xor(qq, o)); u2 = fmaxf(u2, __shfl_xor(u2, o)); }
                    if ((tq & 63) == 0) { wtot[8 + (tq >> 6)] = qq; wtot[16 + (tq >> 6)] = u2; }
                    if (tq == 0) ((LAS unsigned*)wtot)[24] = (unsigned)(4 * qb);
                    __syncthreads();
                    float U1 = wtot[8], U2 = wtot[16];
#pragma unroll
                    for (int w = 1; w < 8; ++w) { U1 = fmaxf(U1, wtot[8 + w]); U2 = fmaxf(U2, wtot[16 + w]); }
                    U1 = sqrtf(U1) * 1.0001f;
                    if (tq < 4 * qb) { const float* kn = KNP + ((size_t)bh * 64 + tq) * 2; const float bound = U1 * sqrtf(kn[0] + kn[1]) + U2 + (auxTab[q0] - auxTab[64 * tq + 63]);
                        if (!(bound <= -PRUNE_TH)) __hip_atomic_fetch_min((LAS unsigned*)wtot + 24, (unsigned)tq, __ATOMIC_RELAXED, __HIP_MEMORY_SCOPE_WORKGROUP); }
                    __syncthreads();
                    tile0 = (int)(((LAS unsigned*)wtot)[24] & ~1u);
                }
                {   const bf16* qp = Qg + (size_t)prow * PW + half * 32; const bf16* kp = Kb + (size_t)(q0 + prow) * PW + half * 32; float q[32]; float d = 0.f;
#pragma unroll
                    for (int c = 0; c < 4; ++c) { const bf16x8 qv = *(const bf16x8*)(qp + 8 * c), kv = *(const bf16x8*)(kp + 8 * c);
#pragma unroll
                        for (int j = 0; j < 8; ++j) { q[8 * c + j] = bf2f((unsigned short)qv[j]); d += q[8 * c + j] * bf2f((unsigned short)kv[j]); } }
                    d += __shfl_xor(d, 1);
                    if (kind == 0) { if (half == 0) { auxR0[prow] = d - auxTab[q0 + prow]; auxInfo[prow] = 0u; } }
                    else {
                        int s0 = -1, s1 = -1, s2 = -1; float g0 = -INFINITY, g1 = -INFINITY, g2 = -INFINITY;
                        for (int n = 0; n < qb; ++n) { const LAS f32x4* km = (const LAS f32x4*)(auxTab + 256 + n * HD + half * 32); float g = 0.f;
#pragma unroll
                            for (int j = 0; j < 8; ++j) { const f32x4 kk = km[j]; g += (q[4 * j] * kk.x + q[4 * j + 1] * kk.y) + (q[4 * j + 2] * kk.z + q[4 * j + 3] * kk.w); }
                            g += __shfl_xor(g, 1);
                            if (g > g0) { g2 = g1; s2 = s1; g1 = g0; s1 = s0; g0 = g; s0 = n; } else if (g > g1) { g2 = g1; s2 = s1; g1 = g; s1 = n; } else if (g > g2) { g2 = g; s2 = n; } }
                        unsigned msk = 0u; if (s0 >= 0) msk |= 1u << s0; if (s1 >= 0) msk |= 1u << s1; if (s2 >= 0) msk |= 1u << s2;
                        if (half == 0) { auxR0[prow] = d + auxTab[0]; auxInfo[prow] = msk; }
                    }
                }
                __syncthreads();
                if (kind == 0) attn_body::attn_unit<0, 8>((const attn_body::bf16*)Qg, (const attn_body::bf16*)(Kb + (size_t)tile0 * 64 * PW), (const attn_body::bf16*)(Vb + (size_t)tile0 * 64 * PW), (attn_body::bf16*)Og, 4 * (qb + 1) - tile0, tile0, q0, qb, shm, aux);
                else attn_body::attn_unit<1, 8>((const attn_body::bf16*)Qg, (const attn_body::bf16*)Kb, (const attn_body::bf16*)Vb, (attn_body::bf16*)Og, 4 * (qb + 1), 0, q0, qb, shm, aux);
                } else {
                    const int cg = tq & 31, rg = tq >> 5; const size_t r0 = (size_t)(idx - NATT) * 128 + rg * 8; const int c0 = cg * 8;
                    float w0[8], w1[8], w2[8], u2[8], u1[8];
#pragma unroll
                    for (int j = 0; j < 8; ++j) { w0[j] = cw[c0 + j]; w1[j] = cw[CCH + c0 + j]; w2[j] = cw[2 * CCH + c0 + j]; u2[j] = 0.f; u1[j] = 0.f; }
                    if ((r0 % SEQ) != 0) {
                        const bf16x8 a2 = *(const bf16x8*)(P + (r0 - 2) * PW + P_CC + c0), h2 = *(const bf16x8*)(P + (r0 - 2) * PW + P_CH + c0);
                        const bf16x8 a1 = *(const bf16x8*)(P + (r0 - 1) * PW + P_CC + c0), h1 = *(const bf16x8*)(P + (r0 - 1) * PW + P_CH + c0);
#pragma unroll
                        for (int j = 0; j < 8; ++j) { u2[j] = bf2f((unsigned short)a2[j]) * bf2f((unsigned short)h2[j]); u1[j] = bf2f((unsigned short)a1[j]) * bf2f((unsigned short)h1[j]); }
                    }
#pragma unroll
                    for (int rr = 0; rr < 8; ++rr) { const size_t m = r0 + rr;
                        const bf16x8 a = *(const bf16x8*)(P + m * PW + P_CC + c0), hh = *(const bf16x8*)(P + m * PW + P_CH + c0), bb = *(const bf16x8*)(P + m * PW + P_CB + c0);
                        float o8[8];
#pragma unroll
                        for (int j = 0; j < 8; ++j) { const float u0 = bf2f((unsigned short)a[j]) * bf2f((unsigned short)hh[j]); o8[j] = bf2f((unsigned short)bb[j]) * (w0[j] * u2[j] + w1[j] * u1[j] + w2[j] * u0); u2[j] = u1[j]; u1[j] = u0; }
                        u32x4 w; w.x = pk2(o8[0], o8[1]); w.y = pk2(o8[2], o8[3]); w.z = pk2(o8[4], o8[5]); w.w = pk2(o8[6], o8[7]);
                        *(u32x4*)(MIXIN + m * DM + 768 + c0) = w; }
                    __syncthreads();
                }
                idx = (int)MISC[16 + ((iter + 1) & 1)]; ++iter;
            }
        }
        SEAM(pb + 1);
        if (IN(pb + 2)) { PHASE_IDS();
            pg8::Gemm g{MIXIN, Wout_t, MH, DM, DM}; pg8::StaticOrder S; S.init(MH, DM, G, bx);
            pg8::EpiStoreBf16 E{Y, DM};
            pg8::gemm_phase<pg8::EpiStoreBf16, pg8::StaticOrder, true, true>(L + RING_OFF, g, S, E);
        }
        SEAM(pb + 2);
        if (IN(pb + 3)) { PHASE_IDS();
            if (l == 0) rows_phase<true, false, const float*>(gw, NGW, MH, lane, x, nullptr, Y, g_post_mix + (size_t)l * DM, XA, true, RS, (const float*)nullptr, false, nullptr, nullptr);
            else rows_phase<false, false, const float*>(gw, NGW, MH, lane, XA, RS, Y, g_post_mix + (size_t)l * DM, XA, true, RS, (const float*)nullptr, false, nullptr, nullptr);
        }
        SEAM(pb + 3);
        if (IN(pb + 4)) { PHASE_IDS();
            pg8::Gemm g{XA, Wgu_t, MH, NGU, DM}; pg8::StaticOrder S; S.init(MH, NGU, G, bx);
            pg8::EpiSwiGLU E{H, DFF};
            pg8::gemm_phase<pg8::EpiSwiGLU, pg8::StaticOrder, true, true>(L + RING_OFF, g, S, E);
        }
        SEAM(pb + 4);
        if (IN(pb + 5)) { PHASE_IDS();
            pg8::Gemm g{H, Wd_t, MH, DM, DFF}; pg8::StaticOrder S; S.init(MH, DM, G, bx);
            pg8::EpiStoreBf16 E{Y, DM};
            pg8::gemm_phase<pg8::EpiStoreBf16, pg8::StaticOrder, true, true>(L + RING_OFF, g, S, E);
        }
        SEAM(pb + 5);
        if (IN(pb + 6)) { PHASE_IDS();
            if (!last) { const float* WFn = (const float*)(ws + WS_W + (size_t)(l + 1) * W_LAYER + WO_F);
                rows_phase<false, false, const float*>(gw, NGW, MH, lane, XA, RS, Y, g_post_ffn + (size_t)l * DM, XA, true, RS, WFn, true, b_f + (size_t)(l + 1) * NH, LOGF); }
            else rows_phase<false, true, const float*>(gw, NGW, MH, lane, XA, RS, Y, g_post_ffn + (size_t)l * DM, out, false, nullptr, (const float*)nullptr, false, nullptr, nullptr);
        }
        SEAM(pb + 6);
    }
#undef IN
#undef SEAM
}

extern "C" void kernel_launch(void* const* d_in, const int* in_sizes, int n_in, void* d_out, int out_size, void* d_ws, size_t ws_size, hipStream_t stream) {
    if (n_in != 13 || in_sizes[0] != M * DM || out_size != M * DM || ws_size < WS_END) { fprintf(stderr, "kernel_launch: unexpected shapes (n_in %d, in0 %d, out %d, ws %zu)\n", n_in, n_in > 0 ? in_sizes[0] : -1, out_size, ws_size); return; }
    static int grid = 0;
    if (grid == 0) {
        int dev = 0, cus = 0, per_cu = 0;
        if (hipGetDevice(&dev) != hipSuccess || hipDeviceGetAttribute(&cus, hipDeviceAttributeMultiprocessorCount, dev) != hipSuccess) { fprintf(stderr, "kernel_launch: device query failed\n"); grid = -1; return; }
        if (hipFuncSetAttribute((const void*)mk_fwd, hipFuncAttributeMaxDynamicSharedMemorySize, LDS_BYTES) != hipSuccess) { fprintf(stderr, "kernel_launch: hipFuncSetAttribute failed\n"); grid = -1; return; }
        if (hipOccupancyMaxActiveBlocksPerMultiprocessor(&per_cu, (const void*)mk_fwd, NWAVES * 64, LDS_BYTES) != hipSuccess || per_cu < 1) fprintf(stderr, "kernel_launch: occupancy query reports %d\n", per_cu);
        (void)hipGetLastError();
        if (cus % 16 != 0) { fprintf(stderr, "kernel_launch: %d CUs: the two half-batch streams need a multiple of 16; nothing launched\n", cus); grid = -1; return; }
        grid = cus;
    }
    if (grid < 0) return;
    if (hipMemsetAsync((char*)d_ws + WS_CTL, 0, CTL_ZERO_BYTES, stream) != hipSuccess) { fprintf(stderr, "kernel_launch: hipMemsetAsync of the control words failed; nothing launched\n"); return; }
    Args a{};
    for (int i = 0; i < 13; ++i) a.in[i] = (const float*)d_in[i];
    a.out = (float*)d_out; a.ws = (unsigned char*)d_ws;
    a.ph_lo = 0; a.ph_hi = NPH; a.li = 0;
    hipLaunchKernelGGL(mk_fwd, dim3(grid), dim3(NWAVES * 64), LDS_BYTES, stream, a);
}
```

```cpp
#include <hip/hip_runtime.h>
#include <cstdio>
#include <cstdint>

typedef unsigned short bf16;
typedef short bf16x8 __attribute__((ext_vector_type(8)));
typedef float f32x4 __attribute__((ext_vector_type(4)));
typedef unsigned u32x4 __attribute__((ext_vector_type(4)));
typedef unsigned u32x2 __attribute__((ext_vector_type(2)));

constexpr int DM = 1024, BATCH = 8, SEQ = 4096, DEPTH = 2, HD = 64, NH = 6, CCH = 256;
constexpr int M = BATCH * SEQ;
constexpr int INW = 3078, PW = 3072, DFF = 2816, NGU = 2 * DFF;
constexpr int MBLK = 256, NBLK = SEQ / MBLK;
constexpr float RMS_EPS = 1e-6f;
constexpr float LOG2E = 1.4426950408889634f;
constexpr float C2 = 0.125f * LOG2E;
constexpr int P_MQ = 0, P_MK = 384, P_MV = 768, P_FQ = 1152, P_FK = 1536, P_FV = 1920, P_CB = 2304, P_CC = 2560, P_CH = 2816;
constexpr size_t MiB = 1u << 20;
constexpr size_t WS_CTL = 0;
constexpr size_t WS_W = 2 * MiB, W_LAYER = 25 * MiB;
constexpr size_t WO_IN = 0, WO_OUT = 6 * MiB, WO_GU = 8 * MiB, WO_D = 19 * MiB, WO_F = 24 * MiB + 512 * 1024;
constexpr size_t WS_LOGF = 52 * MiB, WS_CUM = 53 * MiB, WS_KMEAN = 54 * MiB;
constexpr size_t WS_XN = 56 * MiB, WS_MIXIN = 120 * MiB, WS_XA = 184 * MiB, WS_P = 312 * MiB, WS_H = WS_P, WS_END = 504 * MiB;

__constant__ int c_bucket[129] = {0, 1, 2, 3, 4, 5, 6, 7, 8, 9, 10, 11, 12, 13, 14, 15, 16, 16, 16, 17, 17, 18, 18, 18, 19, 19, 19, 20, 20, 20, 20, 21, 21, 21, 21, 22, 22, 22, 22, 22, 23, 23, 23, 23, 23, 23, 24, 24, 24, 24, 24, 24, 25, 25, 25, 25, 25, 25, 25, 26, 26, 26, 26, 26, 26, 26, 26, 27, 27, 27, 27, 27, 27, 27, 27, 27, 27, 28, 28, 28, 28, 28, 28, 28, 28, 28, 28, 29, 29, 29, 29, 29, 29, 29, 29, 29, 29, 29, 29, 30, 30, 30, 30, 30, 30, 30, 30, 30, 30, 30, 30, 30, 30, 31, 31, 31, 31, 31, 31, 31, 31, 31, 31, 31, 31, 31, 31, 31, 31};

__device__ __forceinline__ unsigned f2bf(float f) { unsigned u = __builtin_bit_cast(unsigned, f); return (u + 0x7fffu + ((u >> 16) & 1u)) >> 16; }
typedef float f32x2v __attribute__((ext_vector_type(2))); typedef __bf16 bf16x2v __attribute__((ext_vector_type(2)));
__device__ __forceinline__ unsigned pk2(float lo, float hi) { const f32x2v v = {lo, hi}; const bf16x2v b = __builtin_convertvector(v, bf16x2v); return __builtin_bit_cast(unsigned, b); }
__device__ __forceinline__ float bf2f(unsigned short b) { return __builtin_bit_cast(float, (unsigned)b << 16); }
#define WS_DPP(v, ctrl, rm) (v) = (v) + __builtin_bit_cast(float, __builtin_amdgcn_update_dpp(0, __builtin_bit_cast(int, (v)), (ctrl), (rm), 0xf, false))
__device__ __forceinline__ float wave_sum(float v) {
    WS_DPP(v, 0xB1, 0xf); WS_DPP(v, 0x4E, 0xf); WS_DPP(v, 0x141, 0xf); WS_DPP(v, 0x140, 0xf); WS_DPP(v, 0x142, 0xa); WS_DPP(v, 0x143, 0xc);
    return __builtin_bit_cast(float, __builtin_amdgcn_readlane(__builtin_bit_cast(int, v), 63));
}

__device__ __forceinline__ float log_sigmoid(float z) { return z < 0.f ? z - log1pf(expf(z)) : -log1pf(expf(-z)); }
namespace pg8 {
#define PG8_LAS __attribute__((address_space(3)))
typedef unsigned short bf16_t;
typedef short bf16x8 __attribute__((ext_vector_type(8)));
typedef float f32x4 __attribute__((ext_vector_type(4)));
typedef unsigned u32x4 __attribute__((ext_vector_type(4)));
constexpr int BM = 256, BK = 64, HALF = 128, HTB = HALF * BK * 2  , STAGE_BYTES = 8 * HTB, NXCD = 8, WGM = 8;

__host__ __device__ __forceinline__ int lds_byte(int r, int c) { const int st = (r >> 4) * 2 + (c >> 5), rr = r & 15, cc = c & 31, ob = rr * 64 + cc * 2; return st * 1024 + (ob ^ (((ob >> 9) & 1) << 5)); }
__host__ __device__ __forceinline__ void stage_rc(int b, int& R, int& C) { const int st = b / 1024, sb = b % 1024, swz = sb ^ (((sb >> 9) & 1) << 5); R = (st >> 1) * 16 + swz / 64; C = (st & 1) * 32 + (swz % 64) / 2; }
__host__ __device__ __forceinline__ int perm32(int rho) { const int n = rho >> 4, i = rho & 15; return 8 * (i >> 2) + 4 * n + (i & 3); }

struct Unit { int pm, pn; };
struct Gemm { const bf16_t* A; const bf16_t* Bt; int M, N, K; };

struct StaticOrder {
    int nM, nN, nwg, G, c;
    __host__ __device__ void init(int M, int N, int G_, int c_) { nM = M / BM; nN = N / BM; nwg = nM * nN; G = G_; c = c_; }
    __host__ __device__ bool next(int i, Unit& u) const {
        const long L = (long)i * G + c; if (L >= nwg) return false;
        int wgid = (int)L; { const int q = nwg / NXCD, r = nwg % NXCD, xcd = wgid % NXCD, off = wgid / NXCD; wgid = (xcd < r ? xcd * (q + 1) : r * (q + 1) + (xcd - r) * q) + off; }
        const int nig = WGM * nN, gid = wgid / nig, fm = gid * WGM, gsz = (nM - fm) < WGM ? (nM - fm) : WGM;
        u.pm = fm + ((wgid % nig) % gsz); u.pn = (wgid % nig) / gsz; return true;
    }
    __device__ __forceinline__ void a_ready(const Unit&) const {}
    __device__ __forceinline__ void done(const Unit&) const {}
};
__device__ __forceinline__ unsigned cvt_pk_bf16(float lo, float hi) { unsigned r; asm volatile("v_cvt_pk_bf16_f32 %0, %1, %2" : "=v"(r) : "v"(lo), "v"(hi)); return r; }
typedef float f32x2 __attribute__((ext_vector_type(2)));
struct EpiStoreBf16 {
    static constexpr bool PERM = true, AFTER_DRAIN = false;
    bf16_t* O; int ldc;
    __device__ __forceinline__ void operator()(const f32x4 (&acc)[2][2][4][2], const Unit& u, int wr, int wc, int fr, int fq) const {
        const int row0 = u.pm * BM + wr * 64 + fr, col0 = u.pn * BM + wc * 32 + 8 * fq;
#pragma unroll
        for (int ai = 0; ai < 2; ++ai)
#pragma unroll
            for (int m = 0; m < 4; ++m) { bf16_t* rowp = O + (size_t)(row0 + ai * HALF + m * 16) * ldc + col0;
#pragma unroll
                for (int bj = 0; bj < 2; ++bj) { const f32x4 v0 = acc[ai][bj][m][0], v1 = acc[ai][bj][m][1];
                    u32x4 w; w.x = cvt_pk_bf16(v0[0], v0[1]); w.y = cvt_pk_bf16(v0[2], v0[3]); w.z = cvt_pk_bf16(v1[0], v1[1]); w.w = cvt_pk_bf16(v1[2], v1[3]);
                    *(u32x4*)(rowp + bj * HALF) = w; } }
    }
};
struct EpiStoreF32 {
    static constexpr bool PERM = false, AFTER_DRAIN = false;
    float* C; int ldc;
    __device__ __forceinline__ void operator()(const f32x4 (&acc)[2][2][4][2], const Unit& u, int wr, int wc, int fr, int fq) const {
        const int row0 = u.pm * BM + wr * 64 + fr, col0 = u.pn * BM + wc * 32 + 4 * fq;
#pragma unroll
        for (int ai = 0; ai < 2; ++ai)
#pragma unroll
            for (int m = 0; m < 4; ++m) { float* rowp = C + (size_t)(row0 + ai * HALF + m * 16) * ldc + col0;
#pragma unroll
                for (int bj = 0; bj < 2; ++bj)
#pragma unroll
                    for (int n = 0; n < 2; ++n) *(f32x4*)(rowp + bj * HALF + n * 16) = acc[ai][bj][m][n]; }
    }
};
__device__ __forceinline__ float silu_mul(float g, float u) { return g * __builtin_amdgcn_rcpf(1.0f + __builtin_amdgcn_exp2f(g * -1.4426950408889634f)) * u; }
struct EpiSwiGLU {
    static constexpr bool PERM = true, AFTER_DRAIN = false;
    bf16_t* O; int ldc;
    __device__ __forceinline__ void operator()(f32x4 (&acc)[2][2][4][2], const Unit& u, int wr, int wc, int fr, int fq) const {
        const int row0 = u.pm * BM + wr * 64 + fr, col0 = u.pn * HALF + wc * 32 + 8 * fq;
#pragma unroll
        for (int ai = 0; ai < 2; ++ai)
#pragma unroll
            for (int m = 0; m < 4; ++m) { bf16_t* rowp = O + (size_t)(row0 + ai * HALF + m * 16) * ldc + col0;
                const f32x4 g0 = acc[ai][0][m][0], g1 = acc[ai][0][m][1], u0 = acc[ai][1][m][0], u1 = acc[ai][1][m][1];
                u32x4 w; w.x = cvt_pk_bf16(silu_mul(g0[0], u0[0]), silu_mul(g0[1], u0[1])); w.y = cvt_pk_bf16(silu_mul(g0[2], u0[2]), silu_mul(g0[3], u0[3]));
                w.z = cvt_pk_bf16(silu_mul(g1[0], u1[0]), silu_mul(g1[1], u1[1])); w.w = cvt_pk_bf16(silu_mul(g1[2], u1[2]), silu_mul(g1[3], u1[3]));
                *(u32x4*)rowp = w; }
    }
};
struct EpiInProj {
    static constexpr bool PERM = true, AFTER_DRAIN = false;
    bf16_t* O; int ldc; float* kmean; float* knp;
    __device__ __forceinline__ void operator()(f32x4 (&acc)[2][2][4][2], const Unit& u, int wr, int wc, int fr, int fq) const {
        const int row0 = u.pm * BM + wr * 64 + fr, col0 = u.pn * BM + wc * 32 + 8 * fq;
#pragma unroll
        for (int ai = 0; ai < 2; ++ai)
#pragma unroll
            for (int m = 0; m < 4; ++m) { bf16_t* rowp = O + (size_t)(row0 + ai * HALF + m * 16) * ldc + col0;
#pragma unroll
                for (int bj = 0; bj < 2; ++bj) { const f32x4 v0 = acc[ai][bj][m][0], v1 = acc[ai][bj][m][1];
                    u32x4 w; w.x = cvt_pk_bf16(v0[0], v0[1]); w.y = cvt_pk_bf16(v0[2], v0[3]); w.z = cvt_pk_bf16(v1[0], v1[1]); w.w = cvt_pk_bf16(v1[2], v1[3]);
                    *(u32x4*)(rowp + bj * HALF) = w; } }
        if (u.pn == 6 || u.pn == 7) {
#pragma unroll
            for (int bj = 0; bj < 2; ++bj) {
                if (u.pn == 7 && bj == 1) continue;
                const int head = 4 * (u.pn - 6) + 2 * bj + (wc >> 1);
#pragma unroll
                for (int ai = 0; ai < 2; ++ai) { float mx = 0.f;
#pragma unroll
                    for (int m = 0; m < 4; ++m) { const f32x4 v0 = acc[ai][bj][m][0], v1 = acc[ai][bj][m][1];
                        float ss = (v0[0] * v0[0] + v0[1] * v0[1]) + (v0[2] * v0[2] + v0[3] * v0[3]) + (v1[0] * v1[0] + v1[1] * v1[1]) + (v1[2] * v1[2] + v1[3] * v1[3]);
                        ss += __shfl_xor(ss, 16); ss += __shfl_xor(ss, 32); mx = fmaxf(mx, ss); }
                    mx = fmaxf(mx, __shfl_xor(mx, 1)); mx = fmaxf(mx, __shfl_xor(mx, 2)); mx = fmaxf(mx, __shfl_xor(mx, 4)); mx = fmaxf(mx, __shfl_xor(mx, 8));
                    if (fr == 0 && fq == 0) knp[((size_t)((u.pm >> 4) * 6 + head) * 64 + ((u.pm & 15) * 4 + ai * 2 + wr)) * 2 + (wc & 1)] = mx * 1.02f; }
            }
        }
        if (u.pn == 1 || u.pn == 2) {
#pragma unroll
            for (int bj = 0; bj < 2; ++bj) {
                if (u.pn == 1 && bj == 0) continue;
                const int cp = u.pn * BM + bj * HALF + wc * 32 + 8 * fq - 384;
                float* dst = kmean + ((size_t)((u.pm >> 4) * 6 + (cp >> 6)) * 16 + (u.pm & 15)) * 64 + (cp & 63);
#pragma unroll
                for (int n = 0; n < 2; ++n)
#pragma unroll
                    for (int i = 0; i < 4; ++i) { float s = 0.f;
#pragma unroll
                        for (int ai = 0; ai < 2; ++ai)
#pragma unroll
                            for (int m = 0; m < 4; ++m) s += acc[ai][bj][m][n][i];
                        s += __shfl_xor(s, 1); s += __shfl_xor(s, 2); s += __shfl_xor(s, 4); s += __shfl_xor(s, 8);
                        if (fr == 0) atomicAdd(dst + 4 * n + i, s * (1.0f / 256.0f)); }
            }
        }
    }
};
template <class Epi, class Sched, bool ALIGN_EPI = false, bool SP2 = false>
__device__ __forceinline__ void gemm_phase(PG8_LAS unsigned char* lds, const Gemm g, const Sched& S, const Epi& E) {
    int tid_ = threadIdx.x; asm volatile("" : "+v"(tid_));
    const int tid = tid_, wid = __builtin_amdgcn_readfirstlane(tid >> 6), lane = tid & 63, wr = wid >> 2, wc = wid & 3, fr = lane & 15, fq = lane >> 4;
    const int K = g.K, nt = K / BK;
    unsigned voffA[2], voffB[2];
#pragma unroll
    for (int i = 0; i < 2; ++i) { int R, C; stage_rc(tid * 16 + i * 8192, R, C); const int Rb = Epi::PERM ? ((R & ~31) + perm32(R & 31)) : R;
        voffA[i] = (unsigned)(R * K + C) * 2u; voffB[i] = (unsigned)(Rb * K + C) * 2u; }
    const size_t kstep = (size_t)(BK * 2);
    const size_t hstep = (size_t)HALF * K * 2;
    const size_t tstep = 2 * hstep;
    const unsigned ldsw = (unsigned)wid * 1024u;
    const int aoff = lds_byte(wr * 64 + fr, fq * 8), boff = lds_byte(wc * 32 + fr, fq * 8);
#define PG8_SA(b, h) (((b) * 2 + (h)) * HTB)
#define PG8_SB(b, h) ((4 + (b) * 2 + (h)) * HTB)
#define PG8_STAGE(bufoff, gbase, voff) do { _Pragma("unroll") for (int _i = 0; _i < 2; ++_i) \
        __builtin_amdgcn_global_load_lds((const unsigned*)((const char*)(gbase) + (voff)[_i]), (PG8_LAS unsigned*)(lds + (bufoff) + ldsw + _i * 8192), 16, 0, 0); } while (0)
#define PG8_LDA(dst, b, h) do { _Pragma("unroll") for (int m = 0; m < 4; ++m) _Pragma("unroll") for (int k = 0; k < 2; ++k) dst[m][k] = *(const PG8_LAS bf16x8*)(lds + PG8_SA(b, h) + aoff + m * 2048 + k * 1024); } while (0)
#define PG8_LDB(dst, b, h) do { _Pragma("unroll") for (int n = 0; n < 2; ++n) _Pragma("unroll") for (int k = 0; k < 2; ++k) dst[n][k] = *(const PG8_LAS bf16x8*)(lds + PG8_SB(b, h) + boff + n * 2048 + k * 1024); } while (0)
#define PG8_MMA(ai, bj, At, Bt) do { __builtin_amdgcn_s_setprio(1); _Pragma("unroll") for (int m = 0; m < 4; ++m) _Pragma("unroll") for (int n = 0; n < 2; ++n) _Pragma("unroll") for (int k = 0; k < 2; ++k) \
        acc[ai][bj][m][n] = __builtin_amdgcn_mfma_f32_16x16x32_bf16(Bt[n][k], At[m][k], acc[ai][bj][m][n], 0, 0, 0); __builtin_amdgcn_s_setprio(0); } while (0)
#define PG8_WAIT_V(n) asm volatile("s_waitcnt vmcnt(" #n ")" ::: "memory")
#define PG8_WAIT_L(n) asm volatile("s_waitcnt lgkmcnt(" #n ")" ::: "memory")
#define PG8_BAR __builtin_amdgcn_s_barrier()
#define PG8_SCHED __builtin_amdgcn_sched_barrier(0)
    Unit cur, nxt; int ui = 0;
    if (!S.next(0, cur)) return;
    f32x4 acc[2][2][4][2];
#pragma unroll
    for (int a = 0; a < 2; ++a)
#pragma unroll
        for (int b = 0; b < 2; ++b)
#pragma unroll
            for (int m = 0; m < 4; ++m)
#pragma unroll
                for (int n = 0; n < 2; ++n) acc[a][b][m][n] = (f32x4){0.f, 0.f, 0.f, 0.f};
    bf16x8 At[4][2], B0[2][2], B1[2][2];
    const char* cA = (const char*)g.A + (size_t)cur.pm * tstep; const char* cB = (const char*)g.Bt + (size_t)cur.pn * tstep;
    S.a_ready(cur);
    if constexpr (SP2) {
        PG8_STAGE(PG8_SB(0, 0), cB, voffB); PG8_STAGE(PG8_SB(0, 1), cB + hstep, voffB); PG8_STAGE(PG8_SA(0, 0), cA, voffA); PG8_STAGE(PG8_SA(0, 1), cA + hstep, voffA);
        if (wr == 1) PG8_BAR;
        PG8_WAIT_V(2); PG8_BAR;
        PG8_STAGE(PG8_SB(1, 0), cB + kstep, voffB); PG8_STAGE(PG8_SA(1, 0), cA + kstep, voffA); PG8_STAGE(PG8_SB(1, 1), cB + hstep + kstep, voffB);
        PG8_WAIT_V(6); PG8_BAR;
    } else {
        PG8_STAGE(PG8_SB(0, 0), cB, voffB); PG8_STAGE(PG8_SA(0, 0), cA, voffA); PG8_STAGE(PG8_SB(0, 1), cB + hstep, voffB); PG8_STAGE(PG8_SA(0, 1), cA + hstep, voffA);
        if (wr == 1) PG8_BAR;
        PG8_WAIT_V(4); PG8_BAR;
        PG8_STAGE(PG8_SB(1, 0), cB + kstep, voffB); PG8_STAGE(PG8_SA(1, 0), cA + kstep, voffA); PG8_STAGE(PG8_SB(1, 1), cB + hstep + kstep, voffB);
        PG8_WAIT_V(6); PG8_BAR;
    }
    for (;;) {
        const bool has_next = S.next(ui + 1, nxt);
        const char* nA = has_next ? (const char*)g.A + (size_t)nxt.pm * tstep : cA; const char* nB = has_next ? (const char*)g.Bt + (size_t)nxt.pn * tstep : cB;
        for (int t = 0; t < nt; t += 2) {
            const bool last = (t == nt - 2);
            const char* a1 = cA + (size_t)(t + 1) * kstep;
            const char* a2 = last ? nA : cA + (size_t)(t + 2) * kstep; const char* b2 = last ? nB : cB + (size_t)(t + 2) * kstep;
            const char* a3 = a2 + kstep; const char* b3 = b2 + kstep;
            if (last && has_next) S.a_ready(nxt);
            if constexpr (SP2) {
            PG8_LDB(B0, 0, 0); PG8_LDB(B1, 0, 1); PG8_SCHED; PG8_LDA(At, 0, 0); PG8_STAGE(PG8_SA(1, 1), a1 + hstep, voffA);
            PG8_WAIT_V(8); PG8_WAIT_L(0); PG8_BAR; PG8_MMA(0, 0, At, B0); PG8_MMA(0, 1, At, B1); PG8_BAR; PG8_SCHED;
            PG8_LDA(At, 0, 1); PG8_STAGE(PG8_SB(0, 0), b2, voffB); PG8_STAGE(PG8_SB(0, 1), b2 + hstep, voffB); PG8_STAGE(PG8_SA(0, 0), a2, voffA);
            PG8_WAIT_V(8); PG8_WAIT_L(0); PG8_BAR; PG8_MMA(1, 0, At, B0); PG8_MMA(1, 1, At, B1); PG8_BAR; PG8_SCHED;
            PG8_LDB(B0, 1, 0); PG8_LDB(B1, 1, 1); PG8_SCHED; PG8_LDA(At, 1, 0); PG8_STAGE(PG8_SA(0, 1), a2 + hstep, voffA);
            PG8_WAIT_V(8); PG8_WAIT_L(0); PG8_BAR; PG8_MMA(0, 0, At, B0); PG8_MMA(0, 1, At, B1); PG8_BAR; PG8_SCHED;
            PG8_LDA(At, 1, 1); PG8_STAGE(PG8_SB(1, 0), b3, voffB); PG8_STAGE(PG8_SB(1, 1), b3 + hstep, voffB); PG8_STAGE(PG8_SA(1, 0), a3, voffA);
            PG8_WAIT_V(8); PG8_WAIT_L(0); PG8_BAR; PG8_MMA(1, 0, At, B0); PG8_MMA(1, 1, At, B1); PG8_BAR; PG8_SCHED;
            } else {
            PG8_LDB(B0, 0, 0); PG8_SCHED; PG8_LDA(At, 0, 0); PG8_STAGE(PG8_SA(1, 1), a1 + hstep, voffA);
            PG8_WAIT_L(8); PG8_BAR; PG8_WAIT_L(0); PG8_MMA(0, 0, At, B0); PG8_BAR; PG8_SCHED;
            PG8_LDB(B1, 0, 1); PG8_STAGE(PG8_SB(0, 0), b2, voffB);
            PG8_BAR; PG8_WAIT_L(0); PG8_MMA(0, 1, At, B1); PG8_BAR;
            PG8_LDA(At, 0, 1); PG8_STAGE(PG8_SA(0, 0), a2, voffA);
            PG8_BAR; PG8_WAIT_L(0); PG8_MMA(1, 0, At, B0); PG8_BAR; PG8_SCHED;
            PG8_STAGE(PG8_SB(0, 1), b2 + hstep, voffB);
            PG8_WAIT_V(6); PG8_BAR; PG8_MMA(1, 1, At, B1); PG8_BAR;
            PG8_LDB(B0, 1, 0); PG8_SCHED; PG8_LDA(At, 1, 0); PG8_STAGE(PG8_SA(0, 1), a2 + hstep, voffA);
            PG8_WAIT_L(8); PG8_BAR; PG8_WAIT_L(0); PG8_MMA(0, 0, At, B0); PG8_BAR; PG8_SCHED;
            PG8_LDB(B1, 1, 1); PG8_STAGE(PG8_SB(1, 0), b3, voffB);
            PG8_BAR; PG8_WAIT_L(0); PG8_MMA(0, 1, At, B1); PG8_BAR;
            PG8_LDA(At, 1, 1); PG8_STAGE(PG8_SA(1, 0), a3, voffA);
            PG8_BAR; PG8_WAIT_L(0); PG8_MMA(1, 0, At, B0); PG8_BAR; PG8_SCHED;
            PG8_STAGE(PG8_SB(1, 1), b3 + hstep, voffB);
            PG8_WAIT_V(6); PG8_BAR; PG8_MMA(1, 1, At, B1); PG8_BAR;
            }
        }
        if constexpr (ALIGN_EPI) { if (wr == 0) PG8_BAR; }
        if constexpr (!Epi::AFTER_DRAIN) { E(acc, cur, wr, wc, fr, fq); S.done(cur); }
        if (!has_next) break;
#pragma unroll
        for (int a = 0; a < 2; ++a)
#pragma unroll
            for (int b = 0; b < 2; ++b)
#pragma unroll
                for (int m = 0; m < 4; ++m)
#pragma unroll
                    for (int n = 0; n < 2; ++n) acc[a][b][m][n] = (f32x4){0.f, 0.f, 0.f, 0.f};
        cur = nxt; cA = nA; cB = nB; ++ui;
        if constexpr (ALIGN_EPI) { if (wr == 1) PG8_BAR; }
    }
    PG8_WAIT_V(0);
    if constexpr (!ALIGN_EPI) { if (wr == 0) PG8_BAR; }
    PG8_BAR;
    if constexpr (Epi::AFTER_DRAIN) { E.fused(acc, cur, wr, wc, fr, fq, lds, wid, lane); S.done(cur); }
#undef PG8_SA
#undef PG8_SB
#undef PG8_STAGE
#undef PG8_LDA
#undef PG8_LDB
#undef PG8_MMA
#undef PG8_WAIT_V
#undef PG8_WAIT_L
#undef PG8_BAR
#undef PG8_SCHED
}
}

#include <hip/hip_bf16.h>
#include <cmath>
namespace attn_body {
using bf16=__hip_bfloat16;
using bf16x8=__attribute__((ext_vector_type(8)))short;
using s16x4=__attribute__((ext_vector_type(4)))short;
using f32x16=__attribute__((ext_vector_type(16)))float;
using u32x4=__attribute__((ext_vector_type(4)))unsigned;
using f32x4_t=__attribute__((ext_vector_type(4)))float;
constexpr int D=64;
constexpr int NW=8,QBLK=32,QB=QBLK*NW,KVBLK=64;
constexpr int QP=3072, OPITCH=1024;
constexpr int AUX_R0=0, AUX_INFO=1024, AUX_TAB=2048, AUX_BYTES=2048+16384+1024;
__device__ __forceinline__ int crow(int r,int hi){return (r&3)+8*(r>>2)+4*hi;}
#define SBAR() __builtin_amdgcn_sched_barrier(0)
__device__ __forceinline__ void cmask(f32x16&p0,f32x16&p1,int jb,int qrel,int hi){
  const float NEG=-INFINITY; int kb=64*jb+4*hi;
  #pragma unroll
  for(int r=0;r<16;++r){int kv=kb+(r&3)+8*(r>>2); if(kv>qrel)p0[r]=NEG; if(kv+32>qrel)p1[r]=NEG;}
}

constexpr int NSLOT=3, SLOTB=8192;
constexpr int LDS_K=0, LDS_V=NSLOT*SLOTB, LDS_WS=2*NSLOT*SLOTB, LDS_OST=LDS_WS+NW*64*4, LDS_BYTES=LDS_OST+NW*4096;
constexpr float C2=0.125f*1.4426950408889634f;
__device__ __forceinline__ void glds16(const void*gsrc,unsigned lds_dst){unsigned keep;
  asm volatile("s_mov_b32 %0, m0\n\ts_mov_b32 m0, %2\n\ts_nop 0\n\tglobal_load_lds_dwordx4 %1, off\n\ts_mov_b32 m0, %0":"=&s"(keep):"v"(gsrc),"s"(lds_dst):"memory");}
__device__ __forceinline__ float max3f(float a,float b,float c){float r;asm("v_max3_f32 %0, %1, %2, %3":"=v"(r):"v"(a),"v"(b),"v"(c));return r;}
__device__ __forceinline__ float max2f(float a,float b){float r;asm("v_max_f32_e32 %0, %1, %2":"=v"(r):"v"(a),"v"(b));return r;}
__device__ __forceinline__ float fadd_s(float a,float b){float r;asm("v_add_f32_e32 %0, %1, %2":"=v"(r):"v"(a),"v"(b));return r;}
__device__ __forceinline__ float fsub_s(float a,float b){float r;asm("v_sub_f32_e32 %0, %1, %2":"=v"(r):"v"(a),"v"(b));return r;}
typedef float f32x2_t __attribute__((ext_vector_type(2))); typedef __bf16 bf16x2_t __attribute__((ext_vector_type(2)));
__device__ __forceinline__ unsigned cvtpk_s(float lo,float hi){f32x2_t v={lo,hi};bf16x2_t b=__builtin_convertvector(v,bf16x2_t);return __builtin_bit_cast(unsigned,b);}
#define WAIT_BAR(N) asm volatile("s_waitcnt vmcnt(" #N ") lgkmcnt(0)\n\ts_barrier":::"memory")

__device__ __forceinline__ void qkt(f32x16&p0,f32x16&p1,const char*Kslot,const bf16x8*qr,const f32x16&negm,int r32,int hi){
  const char*kb=Kslot+hi*1024+r32*16;
  #pragma unroll
  for(int d0=0;d0<4;++d0){
    const bf16x8 b0=*reinterpret_cast<const bf16x8*>(kb+d0*2048);
    const bf16x8 b1=*reinterpret_cast<const bf16x8*>(kb+d0*2048+512);
    if(d0==0){p0=__builtin_amdgcn_mfma_f32_32x32x16_bf16(b0,qr[0],negm,0,0,0);p1=__builtin_amdgcn_mfma_f32_32x32x16_bf16(b1,qr[0],negm,0,0,0);}
    else{p0=__builtin_amdgcn_mfma_f32_32x32x16_bf16(b0,qr[d0],p0,0,0,0);p1=__builtin_amdgcn_mfma_f32_32x32x16_bf16(b1,qr[d0],p1,0,0,0);}}
}
typedef __attribute__((address_space(3))) const char* lds_cptr;
typedef short v4i16_t __attribute__((ext_vector_type(4)));
__device__ __forceinline__ void kload8(bf16x8*kf,lds_cptr kp){
  kf[0]=*(const __attribute__((address_space(3))) bf16x8*)(kp);      kf[1]=*(const __attribute__((address_space(3))) bf16x8*)(kp+512);
  kf[2]=*(const __attribute__((address_space(3))) bf16x8*)(kp+2048); kf[3]=*(const __attribute__((address_space(3))) bf16x8*)(kp+2560);
  kf[4]=*(const __attribute__((address_space(3))) bf16x8*)(kp+4096); kf[5]=*(const __attribute__((address_space(3))) bf16x8*)(kp+4608);
  kf[6]=*(const __attribute__((address_space(3))) bf16x8*)(kp+6144); kf[7]=*(const __attribute__((address_space(3))) bf16x8*)(kp+6656);
}
__device__ __forceinline__ void kload2(bf16x8*kf,lds_cptr kp,int j){ kf[2*j]=*(const __attribute__((address_space(3))) bf16x8*)(kp+j*2048); kf[2*j+1]=*(const __attribute__((address_space(3))) bf16x8*)(kp+j*2048+512); }
__device__ __forceinline__ s16x4 vtr(lds_cptr p){ return __builtin_bit_cast(s16x4,__builtin_amdgcn_ds_read_tr16_b64_v4i16((__attribute__((address_space(3))) v4i16_t*)p)); }
__device__ __forceinline__ float rowmax(const f32x16&p0,const f32x16&p1){
  float a=max3f(p0[0],p0[1],p1[0]),b=max3f(p0[2],p0[3],p1[1]);a=max3f(a,p1[2],p1[3]);
  #pragma unroll
  for(int r=4;r<16;r+=4){a=max3f(a,p0[r],p0[r+1]);b=max3f(b,p0[r+2],p0[r+3]);a=max3f(a,p1[r],p1[r+1]);b=max3f(b,p1[r+2],p1[r+3]);}
  const float m=max2f(a,b);
  auto rr=__builtin_amdgcn_permlane32_swap(__float_as_uint(m),__float_as_uint(m),false,false);
  return max2f(__uint_as_float(rr[0]),__uint_as_float(rr[1]));
}
__device__ __forceinline__ void pv(f32x16*o,int vb,bf16x8 pa0,bf16x8 pa1,bf16x8 pa2,bf16x8 pa3){
  #pragma unroll
  for(int d0=0;d0<2;++d0){s16x4 lo[4],hi[4];
    #pragma unroll
    for(int ks=0;ks<4;++ks){
      asm volatile("ds_read_b64_tr_b16 %0,%1 offset:%c2":"=&v"(lo[ks]):"v"(vb),"i"(d0*4096+ks*1024):"memory");
      asm volatile("ds_read_b64_tr_b16 %0,%1 offset:%c2":"=&v"(hi[ks]):"v"(vb),"i"(d0*4096+ks*1024+512):"memory");}
    asm volatile("s_waitcnt lgkmcnt(0)":::"memory");SBAR();
    #define PK(k) (bf16x8){lo[k][0],lo[k][1],lo[k][2],lo[k][3],hi[k][0],hi[k][1],hi[k][2],hi[k][3]}
    o[d0]=__builtin_amdgcn_mfma_f32_32x32x16_bf16(pa0,PK(0),o[d0],0,0,0);
    o[d0]=__builtin_amdgcn_mfma_f32_32x32x16_bf16(pa1,PK(1),o[d0],0,0,0);
    o[d0]=__builtin_amdgcn_mfma_f32_32x32x16_bf16(pa2,PK(2),o[d0],0,0,0);
    o[d0]=__builtin_amdgcn_mfma_f32_32x32x16_bf16(pa3,PK(3),o[d0],0,0,0);
    #undef PK
  }
}

#ifndef ATTN_STORE16
#define ATTN_STORE16(p,v) (*(u32x4*)(p)=(v))
#endif
template<int KIND,int THRL> __device__ __forceinline__ void attn_unit(const bf16*Qg,const bf16*__restrict__ Kg,const bf16*__restrict__ Vg,bf16*Og,const int NT,const int tile0,const int q0,const int qb,char*shm,lds_cptr aux){
  int tid_=threadIdx.x; asm volatile("":"+v"(tid_));
  const int tid=tid_,lane=tid&63,r32=lane&31,hi=lane>>5; const int wid=__builtin_amdgcn_readfirstlane(tid>>6);
  const bf16*Qw=Qg+(long)(wid*QBLK)*QP;
  const bf16*Kh=Kg,*Vh=Vg;
  const unsigned lds0=(unsigned)(uintptr_t)shm;
  float*wsf=(float*)(shm+LDS_WS)+wid*64;
  const bf16*ksrc=Kh+(long)lane*QP+wid*8;
  const bf16*vsrc=Vh+(long)(16*(wid&3)+(lane>>2))*QP+(wid>>2)*32+(lane&3)*8;
  const unsigned kdst=lds0+LDS_K+wid*1024, vdst=lds0+LDS_V+wid*1024;
  #define DMA_K(t,slot) glds16(ksrc+(long)(t)*KVBLK*QP,(unsigned)__builtin_amdgcn_readfirstlane(kdst+(slot)))
  #define DMA_V(t,slot) glds16(vsrc+(long)(t)*KVBLK*QP,(unsigned)__builtin_amdgcn_readfirstlane(vdst+(slot)))
  const int vb0=(int)(lds0+LDS_V)+((lane>>4)&1)*32+(lane&3)*8+(4*hi+((lane&15)>>2))*64;
  const char*Kbase=shm+LDS_K; bf16x8 kf[8];
  const lds_cptr shm3=(lds_cptr)shm; const lds_cptr kp0=shm3+LDS_K+hi*1024+r32*16; const lds_cptr vp0=shm3+LDS_V+((lane>>4)&1)*32+(lane&3)*8+(4*hi+((lane&15)>>2))*64;
  DMA_K(0,0);DMA_V(0,0);DMA_K(1,SLOTB);
  bf16x8 qr[4];
  #pragma unroll
  for(int d0=0;d0<4;++d0)qr[d0]=*reinterpret_cast<const bf16x8*>(&Qw[(long)r32*QP+d0*16+hi*8]);
  typedef __attribute__((address_space(3))) const float* lds_fptr; typedef __attribute__((address_space(3))) const unsigned* lds_uptr; typedef __attribute__((address_space(3))) const f32x4_t* lds_f4ptr;
  const int myrow=wid*QBLK+r32; const lds_fptr aux_tab=(lds_fptr)(aux+AUX_TAB);
  float mhat=((lds_fptr)(aux+AUX_R0))[myrow],l_reg=0.f; const unsigned rinfo=((lds_uptr)(aux+AUX_INFO))[myrow];
  f32x16 o[2];o[0]=f32x16{};o[1]=f32x16{};f32x16 negm=f32x16{};
  #define NEGM_SET(tn) do{ if(KIND==1){ const int bn_=(tile0+(tn))>>2; const float nv_=(bn_<qb&&!((rinfo>>bn_)&1u))?-INFINITY:-mhat; _Pragma("unroll") for(int r=0;r<16;++r)negm[r]=nv_; asm volatile("":"+v"(negm)); } }while(0)
  NEGM_SET(0);
  const float NEGI=-INFINITY;
  #define CFENCE() asm volatile("":::"memory")
  #define POST(C0,C1,t) do{ \
    if(KIND==0){ const float nm_=-mhat; asm volatile("s_nop 15\n\ts_nop 7":"+v"(C0),"+v"(C1));   \
      const lds_f4ptr cp_=(lds_f4ptr)(aux_tab+((tile0+(t))*64+4*hi)); \
      _Pragma("unroll") for(int g_=0;g_<4;++g_){ const f32x4_t a_=cp_[2*g_],b_=cp_[8+2*g_]; \
        _Pragma("unroll") for(int i_=0;i_<4;++i_){ C0[4*g_+i_]=fadd_s(C0[4*g_+i_],fsub_s(nm_,a_[i_])); C1[4*g_+i_]=fadd_s(C1[4*g_+i_],fsub_s(nm_,b_[i_])); } if(g_==1)CFENCE(); } } \
    else { const int blk_=(tile0+(t))>>2; \
      const int dw_=(q0+wid*QBLK)-(tile0+(t))*64;     \
      if(blk_>=qb-1&&dw_<176&&dw_>-32){ asm volatile("s_nop 15\n\ts_nop 7":"+v"(C0),"+v"(C1)); const int db_=(q0+myrow)-((tile0+(t))*64+4*hi); \
        _Pragma("unroll") for(int r=0;r<16;++r){ const int d_=db_-((r&3)+8*(r>>2)); const int i0_=d_<0?0:(d_>128?128:d_), e_=d_-32, i1_=e_<0?0:(e_>128?128:e_); C0[r]=fadd_s(C0[r],aux_tab[i0_]); C1[r]=fadd_s(C1[r],aux_tab[i1_]); if((r&3)==3)CFENCE(); } } } \
  }while(0)
  const int qrel=wid*QBLK+r32;
  #define CMASK(P0,P1,t) do{int jb_=(t)-(NT-4); if(jb_>=0)cmask(P0,P1,jb_,qrel,hi);}while(0)
  bool resc=false;
  #define START(P0,P1) do{ const float rm=rowmax(P0,P1); resc=false; \
    { const float dl=max2f(rm,0.f); mhat=fadd_s(mhat,dl); \
      _Pragma("unroll") for(int r=0;r<16;++r){P0[r]=fsub_s(P0[r],dl);P1[r]=fsub_s(P1[r],dl);} \
      NEGM_SET(1); } \
    _Pragma("unroll") for(int r=0;r<16;++r)P0[r]=__builtin_amdgcn_exp2f(P0[r]); }while(0)
  #define RESC() do{ if(resc){ asm volatile("s_waitcnt lgkmcnt(0)":::"memory"); \
      _Pragma("unroll") for(int d_=0;d_<2;++d_) _Pragma("unroll") for(int r=0;r<16;++r)o[d_][r]*=wsf[crow(r,hi)]; } }while(0)
  f32x16 pA0,pA1,pB0,pB1;
  int sl_prev=0,sl_cur=0,sl_next=SLOTB;
  #define ROT() do{sl_prev=sl_cur;sl_cur=sl_next;sl_next=(sl_next==(NSLOT-1)*SLOTB)?0:sl_next+SLOTB;}while(0)
  DMA_K(2,2*SLOTB);
  WAIT_BAR(3);
  qkt(pA0,pA1,Kbase,qr,negm,r32,hi);asm volatile("s_nop 15\n\ts_nop 7":"+v"(pA0),"+v"(pA1));CMASK(pA0,pA1,0);POST(pA0,pA1,0);
  START(pA0,pA1);
  _Pragma("unroll") for(int r=0;r<16;++r)pA1[r]=__builtin_amdgcn_exp2f(pA1[r]);
  WAIT_BAR(0);
  DMA_K(3,0);DMA_V(1,SLOTB);
  ROT();
  kload8(kf,kp0+sl_cur);
  WAIT_BAR(2);
  s16x4 vlo[8],vhi[8]; u32x4 pw0,pw1,pw2,pw3;
  #define PKW(P,B) cvtpk_s(P[B],P[B+1])
  #define PAF(k) __builtin_bit_cast(bf16x8,pw##k)
  #define VFR(i) (bf16x8){vlo[i][0],vlo[i][1],vlo[i][2],vlo[i][3],vhi[i][0],vhi[i][1],vhi[i][2],vhi[i][3]}
  #define PIN(x) asm volatile("":"+v"(x))
  #define MX3(a,b,c) __builtin_fmaxf(__builtin_fmaxf((a),(b)),(c))
  #define GAPA(MF,A0,A1,A2,A3,W0,W1,PW) do{ MF; sacc+=A0; sacc+=A1; sacc+=A2; sacc+=A3; PIN(sacc); W0; W1; PIN(PW); SBAR(); }while(0)
  #define EX(v) __builtin_amdgcn_exp2f(v)
  #define GAPB(MF,X,B) do{ MF; X[B]=EX(X[B]); X[B+1]=EX(X[B+1]); X[B+2]=EX(X[B+2]); X[B+3]=EX(X[B+3]); PIN(X); SBAR(); }while(0)
  #define VRD(i) do{ vlo[i]=vtr(vp_+(((i)>>2)*4096+((i)&3)*1024)); vhi[i]=vtr(vp_+(((i)>>2)*4096+((i)&3)*1024+512)); }while(0)
  #define KRD(G,j) do{ if(G){ kload2(kf,kp0+sl_next,j); SBAR(); } }while(0)
  #define STEP(C0,C1,P0,P1,t,GK,GV,GL) do{ SBAR(); \
    const lds_cptr vp_=vp0+sl_prev; \
    VRD(0); SBAR(); float sacc=(P0[0]+P0[1]); \
    GAPA(C0=__builtin_amdgcn_mfma_f32_32x32x16_bf16(kf[0],qr[0],negm,0,0,0), P0[2],P0[3],P0[4],P0[5],     pw0[0]=PKW(P0,0), pw0[1]=PKW(P0,2), pw0); \
    VRD(4); SBAR(); GAPA(C1=__builtin_amdgcn_mfma_f32_32x32x16_bf16(kf[1],qr[0],negm,0,0,0), P0[6],P0[7],P0[8],P0[9],     pw0[2]=PKW(P0,4), pw0[3]=PKW(P0,6), pw0); \
    VRD(1); SBAR(); GAPA(C0=__builtin_amdgcn_mfma_f32_32x32x16_bf16(kf[2],qr[1],C0,0,0,0),   P0[10],P0[11],P0[12],P0[13], pw1[0]=PKW(P0,8), pw1[1]=PKW(P0,10), pw1); \
    VRD(5); SBAR(); GAPA(C1=__builtin_amdgcn_mfma_f32_32x32x16_bf16(kf[3],qr[1],C1,0,0,0),   P0[14],P0[15],P1[0],P1[1],   pw1[2]=PKW(P0,12),pw1[3]=PKW(P0,14), pw1); \
    VRD(2); SBAR(); GAPA(C0=__builtin_amdgcn_mfma_f32_32x32x16_bf16(kf[4],qr[2],C0,0,0,0),   P1[2],P1[3],P1[4],P1[5],     pw2[0]=PKW(P1,0), pw2[1]=PKW(P1,2), pw2); \
    VRD(6); SBAR(); GAPA(C1=__builtin_amdgcn_mfma_f32_32x32x16_bf16(kf[5],qr[2],C1,0,0,0),   P1[6],P1[7],P1[8],P1[9],     pw2[2]=PKW(P1,4), pw2[3]=PKW(P1,6), pw2); \
    VRD(3); SBAR(); GAPA(C0=__builtin_amdgcn_mfma_f32_32x32x16_bf16(kf[6],qr[3],C0,0,0,0),   P1[10],P1[11],P1[12],P1[13], pw3[0]=PKW(P1,8), pw3[1]=PKW(P1,10), pw3); \
    VRD(7); SBAR(); GAPA(C1=__builtin_amdgcn_mfma_f32_32x32x16_bf16(kf[7],qr[3],C1,0,0,0),   P1[14],P1[15],0.f,0.f,       pw3[2]=PKW(P1,12),pw3[3]=PKW(P1,14), pw3); \
    l_reg+=sacc; \
    if(GK){DMA_K((t)+3,sl_cur);} if(GV){DMA_V((t)+1,sl_next);} \
    CMASK(C0,C1,t); POST(C0,C1,t); \
    { float a=MX3(C0[0],C0[1],C1[0]),b=MX3(C0[2],C0[3],C1[1]); a=MX3(a,C1[2],C1[3]); \
      _Pragma("unroll") for(int r=4;r<16;r+=4){a=MX3(a,C0[r],C0[r+1]);b=MX3(b,C0[r+2],C0[r+3]);a=MX3(a,C1[r],C1[r+1]);b=MX3(b,C1[r+2],C1[r+3]);} \
      float rm=__builtin_fmaxf(a,b); { auto rr=__builtin_amdgcn_permlane32_swap(__float_as_uint(rm),__float_as_uint(rm),false,false); rm=__builtin_fmaxf(__uint_as_float(rr[0]),__uint_as_float(rr[1])); } \
      resc=false; \
      if(__builtin_expect(__any(rm>(float)THRL),0)){ const float dl=__builtin_fmaxf(rm,0.f); mhat+=dl; \
        _Pragma("unroll") for(int r=0;r<16;++r){C0[r]-=dl;C1[r]-=dl;} \
        const float f=__builtin_amdgcn_exp2f(-dl); l_reg*=f; if(hi==0)wsf[r32]=f; resc=true; } \
      if(KIND==1&&(resc||((tile0+(t)+1)&3)==0)) NEGM_SET((t)+1); } \
    SBAR(); \
    GAPB(o[0]=__builtin_amdgcn_mfma_f32_32x32x16_bf16(PAF(0),VFR(0),o[0],0,0,0), C0,0); \
    GAPB(o[1]=__builtin_amdgcn_mfma_f32_32x32x16_bf16(PAF(0),VFR(4),o[1],0,0,0), C0,4); \
    KRD(GL,0); GAPB(o[0]=__builtin_amdgcn_mfma_f32_32x32x16_bf16(PAF(1),VFR(1),o[0],0,0,0), C0,8); \
    KRD(GL,1); GAPB(o[1]=__builtin_amdgcn_mfma_f32_32x32x16_bf16(PAF(1),VFR(5),o[1],0,0,0), C0,12); \
    KRD(GL,2); GAPB(o[0]=__builtin_amdgcn_mfma_f32_32x32x16_bf16(PAF(2),VFR(2),o[0],0,0,0), C1,0); \
    KRD(GL,3); GAPB(o[1]=__builtin_amdgcn_mfma_f32_32x32x16_bf16(PAF(2),VFR(6),o[1],0,0,0), C1,4); \
    GAPB(o[0]=__builtin_amdgcn_mfma_f32_32x32x16_bf16(PAF(3),VFR(3),o[0],0,0,0), C1,8); \
    GAPB(o[1]=__builtin_amdgcn_mfma_f32_32x32x16_bf16(PAF(3),VFR(7),o[1],0,0,0), C1,12); \
    }while(0)
  int t=1;
  #undef CMASK
  #define CMASK(P0,P1,t) do{}while(0)
  for(;t+5<NT;t+=2){
    STEP(pB0,pB1,pA0,pA1,t,true,true,true);     WAIT_BAR(2); RESC(); ROT();
    STEP(pA0,pA1,pB0,pB1,t+1,true,true,true);   WAIT_BAR(2); RESC(); ROT();
  }
  #undef CMASK
  #define CMASK(P0,P1,t) do{int jb_=(t)-(NT-4); if(jb_>=0)cmask(P0,P1,jb_,qrel,hi);}while(0)
  #define ENDW(tt) do{ if((tt)+3<NT){WAIT_BAR(2);} else if((tt)+2<NT){WAIT_BAR(1);} else {WAIT_BAR(0);} }while(0)
  for(;t+1<NT;t+=2){
    STEP(pB0,pB1,pA0,pA1,t,(t+3<NT),(t+1<NT),(t+1<NT));       ENDW(t);   RESC(); ROT();
    STEP(pA0,pA1,pB0,pB1,t+1,(t+4<NT),(t+2<NT),(t+2<NT));     ENDW(t+1); RESC(); ROT();
  }
  STEP(pB0,pB1,pA0,pA1,NT-1,false,false,false); RESC();
  { float sacc=pB0[0]+pB0[1]; _Pragma("unroll") for(int r=2;r<16;++r)sacc+=pB0[r]; _Pragma("unroll") for(int r=0;r<16;++r)sacc+=pB1[r]; l_reg+=sacc;
    pw0=(u32x4){PKW(pB0,0),PKW(pB0,2),PKW(pB0,4),PKW(pB0,6)};pw1=(u32x4){PKW(pB0,8),PKW(pB0,10),PKW(pB0,12),PKW(pB0,14)};pw2=(u32x4){PKW(pB1,0),PKW(pB1,2),PKW(pB1,4),PKW(pB1,6)};pw3=(u32x4){PKW(pB1,8),PKW(pB1,10),PKW(pB1,12),PKW(pB1,14)};
    SBAR(); pv(o,vb0+sl_cur,PAF(0),PAF(1),PAF(2),PAF(3)); }
  #undef PKW
  #undef PAF
  #undef VFR
  #undef PIN
  #undef MX3
  #undef GAPA
  #undef GAPB
  #undef EX
  #undef VRD
  #undef KRD
  #undef STEP
  #undef ENDW
  {auto rr=__builtin_amdgcn_permlane32_swap(__float_as_uint(l_reg),__float_as_uint(l_reg),false,false);l_reg=__uint_as_float(rr[0])+__uint_as_float(rr[1]);}
  if(hi==0)wsf[32+r32]=l_reg;asm volatile("s_waitcnt lgkmcnt(0)":::"memory");
  float rli[16];
  #pragma unroll
  for(int r=0;r<16;++r)rli[r]=__builtin_amdgcn_rcpf(wsf[32+crow(r,hi)]);
  bf16*Ow=Og+(long)(wid*QBLK)*OPITCH;
  { bf16*stg=(bf16*)(shm+LDS_OST)+wid*2048;
    #pragma unroll
    for(int r=0;r<16;++r){const int orow=crow(r,hi);
      #pragma unroll
      for(int d0=0;d0<2;++d0)stg[orow*64+d0*32+r32]=__float2bfloat16(o[d0][r]*rli[r]);}
    asm volatile("s_waitcnt lgkmcnt(0)":::"memory");
    #pragma unroll
    for(int i=0;i<4;++i){const int row=i*8+(lane>>3),ch=lane&7; const u32x4 v=*(const u32x4*)(stg+row*64+ch*8); ATTN_STORE16(Ow+(long)row*OPITCH+ch*8,v);} }
  asm volatile("s_waitcnt lgkmcnt(0)\n\ts_barrier":::"memory");
  #undef DMA_K
  #undef DMA_V
  #undef CMASK
  #undef START
  #undef RESC
  #undef ROT
  #undef POST
  #undef NEGM_SET
  #undef CFENCE
}
constexpr int ATTN_LDS_BYTES=LDS_BYTES;
#undef SBAR
#undef WAIT_BAR
}

#define GAS __attribute__((address_space(1)))
#define LAS __attribute__((address_space(3)))
typedef unsigned short bf16;
typedef unsigned v4u __attribute__((ext_vector_type(4)));
typedef float f32x4 __attribute__((ext_vector_type(4)));
typedef short bf16x8 __attribute__((ext_vector_type(8)));
typedef GAS unsigned gu32;
typedef GAS unsigned long long gu64;
#define RLX_AGENT __ATOMIC_RELAXED, __HIP_MEMORY_SCOPE_AGENT
#define LDS_WAIT() asm volatile("s_waitcnt lgkmcnt(0)" ::: "memory")
#define VM_WAIT() asm volatile("s_waitcnt vmcnt(0)" ::: "memory")
__device__ __forceinline__ unsigned long long rt() { return __builtin_amdgcn_s_memrealtime(); }

#define XB_TMO      128
#define XB_XCNT(j)  (256  + 64 * (j))
#define XB_XSUB(j)  (1280 + 64 * (j))
#define XB_XGEN(j)  (2304 + 64 * (j))
#define XB_TOP      3328
#define XB_TOPGEN   3392
#define XCD_BAR_WORDS 3456
#define XB_SPIN_CAP (1u << 18)

__device__ __forceinline__ unsigned xb_ld(unsigned* p)              { return __hip_atomic_load(p, __ATOMIC_RELAXED, __HIP_MEMORY_SCOPE_AGENT); }
__device__ __forceinline__ unsigned xb_add(unsigned* p, unsigned v) { return __hip_atomic_fetch_add(p, v, __ATOMIC_RELAXED, __HIP_MEMORY_SCOPE_AGENT); }
__device__ __forceinline__ unsigned xb_xcc_id() { return (unsigned)__builtin_amdgcn_s_getreg((3 << 11) | 20) & 0xFu; }
#define XB_SPIN(cond, bar) do { unsigned _sp = 0; while (cond) { __builtin_amdgcn_s_sleep(1); \
    if ((++_sp & 255u) == 0u) { if (xb_ld(&(bar)[XB_TMO])) break; if (_sp > XB_SPIN_CAP) { atomicAdd(&(bar)[XB_TMO], 1u); break; } } } } while (0)

struct XcdBarrier {
    unsigned* bar; unsigned x;
    volatile LAS unsigned* st;
};

__device__ __forceinline__ XcdBarrier xcd_barrier_post(unsigned* bar, volatile LAS unsigned* st) {
    XcdBarrier b; b.bar = bar; b.x = xb_xcc_id(); b.st = st;
    if (threadIdx.x == 0) (void)xb_add(&bar[XB_XCNT(b.x)], 1u);
    return b;
}
__device__ __forceinline__ void xcd_barrier_complete(unsigned* bar, unsigned x, unsigned& nloc, unsigned& nx) {
    const unsigned G = gridDim.x * gridDim.y * gridDim.z;
    unsigned sum, cnt, mine, sp = 0u;
    for (;;) {
        sum = 0u; cnt = 0u; mine = 0u;
#pragma unroll
        for (unsigned j = 0; j < 16; ++j) { const unsigned c = xb_ld(&bar[XB_XCNT(j)]); sum += c; cnt += (c > 0u) ? 1u : 0u; mine = (j == x) ? c : mine; }
        if (sum == G) break;
        __builtin_amdgcn_s_sleep(1);
        if ((++sp & 255u) == 0u) { if (xb_ld(&bar[XB_TMO])) break; if (sp > XB_SPIN_CAP) { atomicAdd(&bar[XB_TMO], 1u); break; } }
    }
    nloc = mine > 0u ? mine : 1u; nx = cnt > 0u ? cnt : 1u;
}

__device__ __forceinline__ void xcd_barrier(const XcdBarrier& b) {
    asm volatile("s_waitcnt vmcnt(0)" ::: "memory");
    __syncthreads();
    if (threadIdx.x == 0) {
        unsigned* bar = b.bar;
        __builtin_amdgcn_s_waitcnt(0);
        unsigned nloc = b.st[0], nx = b.st[1];
        if (nloc == 0u) { xcd_barrier_complete(bar, b.x, nloc, nx); b.st[0] = nloc; b.st[1] = nx; }
        const unsigned old = xb_add(&bar[XB_XSUB(b.x)], 1u);
        const unsigned gen = old / nloc;
        if (old + 1u == (gen + 1u) * nloc) {
            __builtin_amdgcn_fence(__ATOMIC_RELEASE, "agent");
            asm volatile("s_waitcnt vmcnt(0)" ::: "memory");
            const unsigned og = xb_add(&bar[XB_TOP], 1u);
            const unsigned tg = og / nx;
            if (og + 1u == (tg + 1u) * nx) xb_add(&bar[XB_TOPGEN], 1u);
            else XB_SPIN(xb_ld(&bar[XB_TOPGEN]) == tg, bar);
            __builtin_amdgcn_fence(__ATOMIC_ACQUIRE, "agent");
            xb_add(&bar[XB_XGEN(b.x)], 1u);
            asm volatile("s_waitcnt vmcnt(0)" ::: "memory");
        } else {
            XB_SPIN(xb_ld(&bar[XB_XGEN(b.x)]) == gen, bar);
            __builtin_amdgcn_fence(__ATOMIC_ACQUIRE, "agent");
            asm volatile("s_waitcnt vmcnt(0)" ::: "memory");
        }
    }
    __syncthreads();
}

constexpr int NWAVES = 8;
constexpr int RING_OFF = 0, RING_BYTES = 131072;
constexpr int LDSCTL_OFF = RING_BYTES, MISC_OFF = LDSCTL_OFF + 320;
constexpr int LDS_BYTES = 147456;
constexpr int CW_TMO = 0, CW_CODE = 1, CW_Q = 1024, CW_BAR = 4096;
constexpr float PRUNE_TH = 36.f;
constexpr int AUX_OFF = 86016;
constexpr size_t CTL_ZERO_BYTES = 2 * MiB;
constexpr size_t WS_KM = 1 * MiB, KM_LAYER = 256 * 1024;
constexpr int NPH_LAYER = 7, NPH = 1 + DEPTH * NPH_LAYER;

__device__ __forceinline__ void transpose_item(const float* W, int ldsrc, int k0, int srccol0, float scale, const float* gk, bf16* dst, int ldd, LAS float* scr, int lane) {
    float t[32];
#pragma unroll
    for (int i = 0; i < 32; ++i) { const int kk = 2 * i + (lane >> 5); t[i] = W[(size_t)(k0 + kk) * ldsrc + srccol0 + (lane & 31)]; }
#pragma unroll
    for (int i = 0; i < 32; ++i) { const int kk = 2 * i + (lane >> 5); scr[kk * 33 + (lane & 31)] = t[i] * (gk ? scale * gk[k0 + kk] : scale); }
    LDS_WAIT(); asm volatile("" ::: "memory");
    const int c = lane & 7;
#pragma unroll
    for (int j = 0; j < 4; ++j) { const int n = (lane >> 3) + 8 * j; const LAS float* s = scr + (8 * c) * 33 + n;
        v4u o; o.x = pk2(s[0 * 33], s[1 * 33]); o.y = pk2(s[2 * 33], s[3 * 33]); o.z = pk2(s[4 * 33], s[5 * 33]); o.w = pk2(s[6 * 33], s[7 * 33]);
        *(GAS v4u*)(dst + (size_t)n * ldd + k0 + 8 * c) = o; }
    LDS_WAIT(); asm volatile("" ::: "memory");
}

__device__ __forceinline__ float u2f(const unsigned u) { return __builtin_bit_cast(float, u); }
__device__ __forceinline__ void unpack8(const u32x4 w, float* f) {
    f[0] = __builtin_bit_cast(float, w.x << 16); f[1] = __builtin_bit_cast(float, w.x & 0xffff0000u); f[2] = __builtin_bit_cast(float, w.y << 16); f[3] = __builtin_bit_cast(float, w.y & 0xffff0000u);
    f[4] = __builtin_bit_cast(float, w.z << 16); f[5] = __builtin_bit_cast(float, w.z & 0xffff0000u); f[6] = __builtin_bit_cast(float, w.w << 16); f[7] = __builtin_bit_cast(float, w.w & 0xffff0000u);
}
__device__ __forceinline__ u32x4 pack8(const float* f) { u32x4 w; w.x = pk2(f[0], f[1]); w.y = pk2(f[2], f[3]); w.z = pk2(f[4], f[5]); w.w = pk2(f[6], f[7]); return w; }
__device__ __forceinline__ f32x4 ld4(const float* p) { return *(const f32x4*)p; }
__device__ __forceinline__ f32x4 ld4(const LAS float* p) { return *(const LAS f32x4*)p; }
template <bool RF32, bool XF32, class WFP>
__device__ __forceinline__ void rows_compute(const u32x4 (&cr)[4], const u32x4 (&cy)[2], const float rin, const int m, const int lane, const bool has_y, const float (&gp)[16], void* xout, const bool norm_out, float* rs, WFP WF, const bool has_wf, const float bfl, float* logf) {
    float v[16];
    if (RF32) {
#pragma unroll
        for (int q = 0; q < 4; ++q) { v[4 * q] = u2f(cr[q].x); v[4 * q + 1] = u2f(cr[q].y); v[4 * q + 2] = u2f(cr[q].z); v[4 * q + 3] = u2f(cr[q].w); }
    } else { unpack8(cr[0], v); unpack8(cr[1], v + 8); }
#pragma unroll
    for (int i = 0; i < 16; ++i) v[i] *= rin;
    if (has_y) { float yv[16]; unpack8(cy[0], yv); unpack8(cy[1], yv + 8); float ss = 0.f;
#pragma unroll
        for (int i = 0; i < 16; ++i) ss += yv[i] * yv[i];
        const float r = __builtin_amdgcn_rsqf(wave_sum(ss) * (1.f / DM) + RMS_EPS);
#pragma unroll
        for (int i = 0; i < 16; ++i) v[i] += yv[i] * r * gp[i]; }
    float r = 1.f;
    if (norm_out || has_wf) { float ss = 0.f;
#pragma unroll
        for (int i = 0; i < 16; ++i) ss += v[i] * v[i];
        const float ms = wave_sum(ss) * (1.f / DM) + RMS_EPS; r = __builtin_amdgcn_rsqf(ms);
        if (rs && lane == 0) rs[m] = __builtin_amdgcn_sqrtf(ms); }
    if (xout) {
        float w[16];
#pragma unroll
        for (int i = 0; i < 16; ++i) w[i] = norm_out ? v[i] * r : v[i];
        if (XF32) { f32x4* o = (f32x4*)((float*)xout + (size_t)m * DM + 8 * lane); o[0] = (f32x4){w[0], w[1], w[2], w[3]}; o[1] = (f32x4){w[4], w[5], w[6], w[7]}; o[128] = (f32x4){w[8], w[9], w[10], w[11]}; o[129] = (f32x4){w[12], w[13], w[14], w[15]}; }
        else { u32x4* o = (u32x4*)((bf16*)xout + (size_t)m * DM + 8 * lane); o[0] = pack8(w); o[64] = pack8(w + 8); } }
    {
        if (has_wf) {
            float d[8];
#pragma unroll
            for (int h = 0; h < 8; ++h) { d[h] = 0.f;
                if (h < NH) {
#pragma unroll
                    for (int q = 0; q < 4; ++q) { const f32x4 w = ld4(WF + ((h * 4 + q) * 64 + lane) * 4); d[h] += (v[4 * q] * w.x + v[4 * q + 1] * w.y) + (v[4 * q + 2] * w.z + v[4 * q + 3] * w.w); } } }
            const bool b0 = lane & 1, b1 = lane & 2, b2 = lane & 4;
            float e4[4], e2[2];
#pragma unroll
            for (int j = 0; j < 4; ++j) { const float snd = b0 ? d[j] : d[j + 4], kp = b0 ? d[j + 4] : d[j]; e4[j] = kp + __shfl_xor(snd, 1); }
#pragma unroll
            for (int j = 0; j < 2; ++j) { const float snd = b1 ? e4[j] : e4[j + 2], kp = b1 ? e4[j + 2] : e4[j]; e2[j] = kp + __shfl_xor(snd, 2); }
            float e = (b2 ? e2[1] : e2[0]) + __shfl_xor(b2 ? e2[0] : e2[1], 4);
            e += __shfl_xor(e, 8); e += __shfl_xor(e, 16); e += __shfl_xor(e, 32);
            const int hh = 4 * (lane & 1) + 2 * ((lane >> 1) & 1) + ((lane >> 2) & 1);
            if (lane < 8 && hh < NH) logf[(size_t)m * NH + hh] = e * r + bfl; } }
}
template <bool RF32, bool XF32, class WFP>
__device__ __forceinline__ void rows_phase(const int gw, const int NGW, const int lane, const void* resid, const float* rs_in, const bf16* y, const float* gpost, void* xout, const bool norm_out, float* rs, WFP WF, const bool has_wf, const float* bfv, float* logf) {
    float gp[16];
#pragma unroll
    for (int j = 0; j < 2; ++j)
#pragma unroll
        for (int c = 0; c < 2; ++c) { const int e = 8 * lane + 512 * j + 4 * c;
            const f32x4 a = y ? *(const f32x4*)(gpost + e) : (f32x4){0.f, 0.f, 0.f, 0.f};
#pragma unroll
            for (int i = 0; i < 4; ++i) gp[8 * j + 4 * c + i] = a[i]; }
    const int hh_ = 4 * (lane & 1) + 2 * ((lane >> 1) & 1) + ((lane >> 2) & 1);
    const float bfl = (has_wf && lane < 8 && hh_ < NH) ? bfv[hh_] : 0.f;
    const bool has_y = (y != nullptr);
    u32x4 r0[4], y0[2], r1[4], y1[2], r2[4], y2[2], r3[4], y3[2], r4[4], y4[2]; float s0 = 1.f, s1 = 1.f, s2 = 1.f, s3 = 1.f, s4 = 1.f;
#define ROWS_LOAD(R, Y, SC, m_) do { if (rs_in) SC = rs_in[(m_)]; \
        if (RF32) { const u32x4* p_ = (const u32x4*)((const float*)resid + (size_t)(m_) * DM + 8 * lane); R[0] = p_[0]; R[1] = p_[1]; R[2] = p_[128]; R[3] = p_[129]; } \
        else { const u32x4* p_ = (const u32x4*)((const bf16*)resid + (size_t)(m_) * DM + 8 * lane); R[0] = p_[0]; R[1] = p_[64]; } \
        if (has_y) { const u32x4* q_ = (const u32x4*)(y + (size_t)(m_) * DM + 8 * lane); Y[0] = q_[0]; Y[1] = q_[64]; } } while (0)
#define ROWS_DO(R, Y, SC, m_) rows_compute<RF32, XF32, WFP>(R, Y, SC, (m_), lane, has_y, gp, xout, norm_out, rs, WF, has_wf, bfl, logf)
#define RFENCE() asm volatile("" ::: "memory")
    int m = gw;
    if (m + 3 * NGW < M) {
        ROWS_LOAD(r0, y0, s0, m); ROWS_LOAD(r1, y1, s1, m + NGW); ROWS_LOAD(r2, y2, s2, m + 2 * NGW); ROWS_LOAD(r3, y3, s3, m + 3 * NGW); RFENCE();
        for (; m + 8 * NGW < M; m += 5 * NGW) {
            ROWS_LOAD(r4, y4, s4, m + 4 * NGW); RFENCE(); ROWS_DO(r0, y0, s0, m); RFENCE();
            ROWS_LOAD(r0, y0, s0, m + 5 * NGW); RFENCE(); ROWS_DO(r1, y1, s1, m + NGW); RFENCE();
            ROWS_LOAD(r1, y1, s1, m + 6 * NGW); RFENCE(); ROWS_DO(r2, y2, s2, m + 2 * NGW); RFENCE();
            ROWS_LOAD(r2, y2, s2, m + 7 * NGW); RFENCE(); ROWS_DO(r3, y3, s3, m + 3 * NGW); RFENCE();
            ROWS_LOAD(r3, y3, s3, m + 8 * NGW); RFENCE(); ROWS_DO(r4, y4, s4, m + 4 * NGW); RFENCE();
        }
        if (m + 4 * NGW < M) ROWS_LOAD(r4, y4, s4, m + 4 * NGW);
        RFENCE(); ROWS_DO(r0, y0, s0, m); RFENCE();
        if (m + 5 * NGW < M) ROWS_LOAD(r0, y0, s0, m + 5 * NGW);
        RFENCE(); ROWS_DO(r1, y1, s1, m + NGW); RFENCE();
        if (m + 6 * NGW < M) ROWS_LOAD(r1, y1, s1, m + 6 * NGW);
        RFENCE(); ROWS_DO(r2, y2, s2, m + 2 * NGW); RFENCE();
        if (m + 7 * NGW < M) ROWS_LOAD(r2, y2, s2, m + 7 * NGW);
        RFENCE(); ROWS_DO(r3, y3, s3, m + 3 * NGW); RFENCE();
        if (m + 4 * NGW < M) ROWS_DO(r4, y4, s4, m + 4 * NGW);
        if (m + 5 * NGW < M) ROWS_DO(r0, y0, s0, m + 5 * NGW);
        if (m + 6 * NGW < M) ROWS_DO(r1, y1, s1, m + 6 * NGW);
        if (m + 7 * NGW < M) ROWS_DO(r2, y2, s2, m + 7 * NGW);
        m = M;
    }
    for (; m < M; m += NGW) { ROWS_LOAD(r0, y0, s0, m); ROWS_DO(r0, y0, s0, m); }
#undef ROWS_LOAD
#undef ROWS_DO
#undef RFENCE
}

struct Args { const float* in[13]; float* out; unsigned char* ws; int ph_lo, ph_hi, li, pad; };

__global__ void __launch_bounds__(NWAVES * 64, 2) mk_fwd(Args args) {
    extern __shared__ __attribute__((aligned(16))) unsigned char lds[];
    LAS unsigned char* L = (LAS unsigned char*)lds;
    volatile LAS unsigned* MISC = (volatile LAS unsigned*)(L + MISC_OFF);
    const int G = gridDim.x; const int bx = blockIdx.x; const int vcu = (G % 8 == 0) ? (bx % 8) * (G / 8) + bx / 8 : bx;
    const int NGW = G * NWAVES;
#define PHASE_IDS() int tid_ = threadIdx.x; asm volatile("" : "+v"(tid_)); const int tid = tid_, lane = tid & 63, wave = __builtin_amdgcn_readfirstlane(tid >> 6), gw = vcu * NWAVES + wave; (void)tid; (void)lane; (void)gw
    unsigned char* ws = args.ws;
    gu32* ctl = (gu32*)(ws + WS_CTL);
    for (int u = threadIdx.x; u < (LDS_BYTES - LDSCTL_OFF) / 4; u += NWAVES * 64) ((LAS unsigned*)(L + LDSCTL_OFF))[u] = 0u;
    __syncthreads();
    XcdBarrier bar = xcd_barrier_post((unsigned*)(ctl + CW_BAR) + args.li * XCD_BAR_WORDS, MISC + 8);
    const int lo = args.ph_lo, hi = args.ph_hi;
#define IN(k) (lo <= (k) && (k) < hi)
#define SEAM(k) do { if (IN(k) && IN((k) + 1)) xcd_barrier(bar); } while (0)
    const float* x = args.in[0]; const float* w_in = args.in[1]; const float* b_f = args.in[2]; const float* conv_w = args.in[3];
    const float* w_out = args.in[4]; const float* rel_bias = args.in[5]; const float* g_pre_mix = args.in[6]; const float* g_post_mix = args.in[7];
    const float* g_pre_ffn = args.in[8]; const float* g_post_ffn = args.in[9]; const float* w_gate = args.in[10]; const float* w_up = args.in[11]; const float* w_down = args.in[12];
    float* out = args.out;
    float* LOGF = (float*)(ws + WS_LOGF); float* RS = (float*)(ws + WS_KMEAN); float* KNP = (float*)(ws + WS_CUM);
    bf16* XN = (bf16*)(ws + WS_XN); bf16* MIXIN = (bf16*)(ws + WS_MIXIN); bf16* XA = (bf16*)(ws + WS_XA); bf16* Y = (bf16*)(ws + WS_XA + 64 * MiB); bf16* P = (bf16*)(ws + WS_P); bf16* H = (bf16*)(ws + WS_H);

    if (IN(0)) { PHASE_IDS();
        LAS float* scr = (LAS float*)(L + RING_OFF + wave * 16384);
        constexpr int I_IN = (PW / 32) * (DM / 64), I_OUT = (DM / 32) * (DM / 64), I_GU = (NGU / 32) * (DM / 64), I_D = (DM / 32) * (DFF / 64), I_L = I_IN + I_OUT + I_GU + I_D;
        for (int it = gw; it < DEPTH * I_L; it += NGW) {
            const int l = it / I_L; int r = it % I_L;
            unsigned char* wl = ws + WS_W + (size_t)l * W_LAYER;
            if (r < I_IN) { const int kb = r / (PW / 32), pb = r % (PW / 32), p0 = pb * 32; const int src = p0 < 2304 ? p0 : p0 + 6;
                const float sc = (p0 < 384 || (p0 >= 1152 && p0 < 1536)) ? C2 : 1.f;
                transpose_item(w_in + (size_t)l * DM * INW, INW, kb * 64, src, sc, g_pre_mix + (size_t)l * DM, (bf16*)(wl + WO_IN) + (size_t)p0 * DM, DM, scr, lane); continue; }
            r -= I_IN;
            if (r < I_OUT) { const int kb = r / (DM / 32), pb = r % (DM / 32);
                transpose_item(w_out + (size_t)l * DM * DM, DM, kb * 64, pb * 32, 1.f, nullptr, (bf16*)(wl + WO_OUT) + (size_t)pb * 32 * DM, DM, scr, lane); continue; }
            r -= I_OUT;
            if (r < I_GU) { const int kb = r / (NGU / 32), pb = r % (NGU / 32), r0 = pb * 32; const int pn = r0 >> 8, bj = (r0 >> 7) & 1, j = r0 & 127;
                transpose_item((bj ? w_up : w_gate) + (size_t)l * DM * DFF, DFF, kb * 64, pn * 128 + j, 1.f, g_pre_ffn + (size_t)l * DM, (bf16*)(wl + WO_GU) + (size_t)r0 * DM, DM, scr, lane); continue; }
            r -= I_GU;
            { const int kb = r / (DM / 32), pb = r % (DM / 32);
                transpose_item(w_down + (size_t)l * DFF * DM, DM, kb * 64, pb * 32, 1.f, nullptr, (bf16*)(wl + WO_D) + (size_t)pb * 32 * DFF, DFF, scr, lane); }
        }
        for (int i = gw * 64 + lane; i < DEPTH * NH * DM; i += NGW * 64) { const int l = i / (NH * DM), r = i % (NH * DM), h = r / DM, q = (r >> 8) & 3, ln = (r >> 2) & 63, k = 8 * ln + 512 * (q >> 1) + 4 * (q & 1) + (r & 3);
            ((float*)(ws + WS_W + (size_t)l * W_LAYER + WO_F))[r] = w_in[(size_t)l * DM * INW + (size_t)k * INW + 2304 + h] * g_pre_mix[(size_t)l * DM + k]; }
        __syncthreads();
        { LAS float* wfl = (LAS float*)(L + RING_OFF + 4096);
          for (int i = tid; i < NH * DM; i += NWAVES * 64) { const int k = i / NH, h = i % NH, ln = (k & 511) >> 3, q = 2 * (k >> 9) + ((k >> 2) & 1); wfl[((h * 4 + q) * 64 + ln) * 4 + (k & 3)] = w_in[(size_t)k * INW + 2304 + h] * g_pre_mix[k]; }
          __syncthreads();
          rows_phase<true, false, const LAS float*>(gw, NGW, lane, x, nullptr, nullptr, nullptr, XN, true, nullptr, (const LAS float*)wfl, true, b_f, LOGF); }
    }
    SEAM(0);
    for (int l = 0; l < DEPTH; ++l) {
        const int pb = 1 + l * NPH_LAYER;
        unsigned char* wl = ws + WS_W + (size_t)l * W_LAYER;
        const bf16* Win_t = (const bf16*)(wl + WO_IN); const bf16* Wout_t = (const bf16*)(wl + WO_OUT); const bf16* Wgu_t = (const bf16*)(wl + WO_GU); const bf16* Wd_t = (const bf16*)(wl + WO_D);
        const bool last = (l == DEPTH - 1);
        float* KM = (float*)(ws + WS_CTL + WS_KM + (size_t)l * KM_LAYER);
        if (IN(pb + 0)) { PHASE_IDS();
            for (int e = vcu * (NWAVES * 64) + tid; e < M * NH; e += G * NWAVES * 64) LOGF[e] = log_sigmoid(LOGF[e]);
            pg8::Gemm g{l == 0 ? XN : XA, Win_t, M, PW, DM}; pg8::StaticOrder S; S.init(M, PW, G, bx);
            pg8::EpiInProj E{P, PW, KM, KNP};
            pg8::gemm_phase<pg8::EpiInProj, pg8::StaticOrder, true, true>(L + RING_OFF, g, S, E);
        }
        SEAM(pb + 0);
        if (IN(pb + 1)) { PHASE_IDS();
            constexpr int NATT = 2 * BATCH * NH * NBLK, NCONV = M / 128, NUNITS = NATT + NCONV;
            char* shm = (char*)lds + RING_OFF;
            attn_body::lds_cptr aux = (attn_body::lds_cptr)(L + AUX_OFF);
            LAS float* auxR0 = (LAS float*)(L + AUX_OFF + attn_body::AUX_R0); LAS unsigned* auxInfo = (LAS unsigned*)(L + AUX_OFF + attn_body::AUX_INFO); LAS float* auxTab = (LAS float*)(L + AUX_OFF + attn_body::AUX_TAB);
            LAS float* wtot = (LAS float*)(L + AUX_OFF + attn_body::AUX_TAB + 16384);
            const float* cw = conv_w + (size_t)l * 3 * CCH;
            int idx = bx, iter = 0; unsigned nA = (unsigned)(bx + G);
            while (idx < NUNITS) {
                if (tid == 0) { MISC[16 + ((iter + 1) & 1)] = nA; nA = __hip_atomic_fetch_add(ctl + CW_Q + 64 * l, 1u, RLX_AGENT) + 2u * (unsigned)G; }
                int tq = threadIdx.x; asm volatile("" : "+v"(tq));
                if (idx < NATT) {
                const int kind = idx < NATT / 2 ? 1 : 0, ia = idx - (kind ? 0 : NATT / 2), qb = (NBLK - 1) - ia / (BATCH * NH), bh = ia % (BATCH * NH), b = bh / NH, h = bh % NH;
                const int q0 = qb * MBLK; const size_t row0 = (size_t)b * SEQ;
                const int prow = tq >> 1, half = tq & 1;
                const int cq = kind == 0 ? P_FQ : P_MQ, ck = kind == 0 ? P_FK : P_MK, cv = kind == 0 ? P_FV : P_MV;
                const bf16* Qg = P + (row0 + q0) * PW + cq + h * HD; const bf16* Kb = P + row0 * PW + ck + h * HD; const bf16* Vb = P + row0 * PW + cv + h * HD;
                bf16* Og = MIXIN + (row0 + q0) * DM + (kind == 0 ? 384 : 0) + h * HD;
                int tile0 = 0;
                if (kind == 0) {
                    const int k0 = tile0 * 64, kend = q0 + MBLK, kb = k0 + 8 * tq;
                    float loc[8]; float run = 0.f;
#pragma unroll
                    for (int i = 0; i < 8; ++i) { const int key = kb + i; const float v = key < kend ? LOGF[(row0 + key) * NH + h] : 0.f; run += v; loc[i] = run; }
                    float incl = run;
#pragma unroll
                    for (int o = 1; o < 64; o <<= 1) { const float t = __shfl_up(incl, o); if ((tq & 63) >= o) incl += t; }
                    if ((tq & 63) == 63) wtot[tq >> 6] = incl;
                    __syncthreads();
                    float off = incl - run; for (int w = 0; w < (tq >> 6); ++w) off += wtot[w];
#pragma unroll
                    for (int i = 0; i < 8; ++i) { const int key = kb + i; if (key < kend) auxTab[key] = (off + loc[i]) * LOG2E; }
                } else {
                    const float bfar = rel_bias[31 * NH + h];
                    if (tq <= 128) auxTab[tq] = (rel_bias[c_bucket[tq] * NH + h] - bfar) * LOG2E;
                    for (int i = tq; i < qb * HD; i += NWAVES * 64) auxTab[256 + i] = KM[(size_t)bh * NBLK * HD + i];
                }
                __syncthreads();
                if (kind == 0) {
                    const bf16* qp = Qg + (size_t)prow * PW + half * 32; const bf16* kp = Kb + (size_t)(q0 + prow) * PW + half * 32; float d = 0.f, qq = 0.f;
#pragma unroll
                    for (int c = 0; c < 4; ++c) { const bf16x8 qv = *(const bf16x8*)(qp + 8 * c), kv = *(const bf16x8*)(kp + 8 * c);
#pragma unroll
                        for (int j = 0; j < 8; ++j) { const float qf = bf2f((unsigned short)qv[j]); d += qf * bf2f((unsigned short)kv[j]); qq += qf * qf; } }
                    d += __shfl_xor(d, 1); qq += __shfl_xor(qq, 1);
                    float u2 = (auxTab[q0 + prow] - auxTab[q0]) - d;
#pragma unroll
                    for (int o = 2; o < 64; o <<= 1) { qq = fmaxf(qq, __shfl_xor(qq, o)); u2 = fmaxf(u2, __shfl_xor(u2, o)); }
                    if ((tq & 63) == 0) { wtot[8 + (tq >> 6)] = qq; wtot[16 + (tq >> 6)] = u2; }
                    if (tq == 0) ((LAS unsigned*)wtot)[24] = (unsigned)(4 * qb);
                    __syncthreads();
                    float U1 = wtot[8], U2 = wtot[16];
#pragma unroll
                    for (int w = 1; w < 8; ++w) { U1 = fmaxf(U1, wtot[8 + w]); U2 = fmaxf(U2, wtot[16 + w]); }
                    U1 = sqrtf(U1) * 1.0001f;
                    if (tq < 4 * qb) { const float* kn = KNP + ((size_t)bh * 64 + tq) * 2; const float bound = U1 * sqrtf(kn[0] + kn[1]) + U2 + (auxTab[q0] - auxTab[64 * tq + 63]);
                        if (!(bound <= -PRUNE_TH)) __hip_atomic_fetch_min((LAS unsigned*)wtot + 24, (unsigned)tq, __ATOMIC_RELAXED, __HIP_MEMORY_SCOPE_WORKGROUP); }
                    __syncthreads();
                    tile0 = (int)(((LAS unsigned*)wtot)[24] & ~1u);
                }
                {   const bf16* qp = Qg + (size_t)prow * PW + half * 32; const bf16* kp = Kb + (size_t)(q0 + prow) * PW + half * 32; float q[32]; float d = 0.f;
#pragma unroll
                    for (int c = 0; c < 4; ++c) { const bf16x8 qv = *(const bf16x8*)(qp + 8 * c), kv = *(const bf16x8*)(kp + 8 * c);
#pragma unroll
                        for (int j = 0; j < 8; ++j) { q[8 * c + j] = bf2f((unsigned short)qv[j]); d += q[8 * c + j] * bf2f((unsigned short)kv[j]); } }
                    d += __shfl_xor(d, 1);
                    if (kind == 0) { if (half == 0) { auxR0[prow] = d - auxTab[q0 + prow]; auxInfo[prow] = 0u; } }
                    else {
                        int s0 = -1, s1 = -1, s2 = -1; float g0 = -INFINITY, g1 = -INFINITY, g2 = -INFINITY;
                        for (int n = 0; n < qb; ++n) { const LAS f32x4* km = (const LAS f32x4*)(auxTab + 256 + n * HD + half * 32); float g = 0.f;
#pragma unroll
                            for (int j = 0; j < 8; ++j) { const f32x4 kk = km[j]; g += (q[4 * j] * kk.x + q[4 * j + 1] * kk.y) + (q[4 * j + 2] * kk.z + q[4 * j + 3] * kk.w); }
                            g += __shfl_xor(g, 1);
                            if (g > g0) { g2 = g1; s2 = s1; g1 = g0; s1 = s0; g0 = g; s0 = n; } else if (g > g1) { g2 = g1; s2 = s1; g1 = g; s1 = n; } else if (g > g2) { g2 = g; s2 = n; } }
                        unsigned msk = 0u; if (s0 >= 0) msk |= 1u << s0; if (s1 >= 0) msk |= 1u << s1; if (s2 >= 0) msk |= 1u << s2;
                        if (half == 0) { auxR0[prow] = d + auxTab[0]; auxInfo[prow] = msk; }
                    }
                }
                __syncthreads();
                if (kind == 0) attn_body::attn_unit<0, 8>((const attn_body::bf16*)Qg, (const attn_body::bf16*)(Kb + (size_t)tile0 * 64 * PW), (const attn_body::bf16*)(Vb + (size_t)tile0 * 64 * PW), (attn_body::bf16*)Og, 4 * (qb + 1) - tile0, tile0, q0, qb, shm, aux);
                else attn_body::attn_unit<1, 8>((const attn_body::bf16*)Qg, (const attn_body::bf16*)Kb, (const attn_body::bf16*)Vb, (attn_body::bf16*)Og, 4 * (qb + 1), 0, q0, qb, shm, aux);
                } else {
                    const int cg = tq & 31, rg = tq >> 5; const size_t r0 = (size_t)(idx - NATT) * 128 + rg * 8; const int c0 = cg * 8;
                    float w0[8], w1[8], w2[8], u2[8], u1[8];
#pragma unroll
                    for (int j = 0; j < 8; ++j) { w0[j] = cw[c0 + j]; w1[j] = cw[CCH + c0 + j]; w2[j] = cw[2 * CCH + c0 + j]; u2[j] = 0.f; u1[j] = 0.f; }
                    if ((r0 % SEQ) != 0) {
                        const bf16x8 a2 = *(const bf16x8*)(P + (r0 - 2) * PW + P_CC + c0), h2 = *(const bf16x8*)(P + (r0 - 2) * PW + P_CH + c0);
                        const bf16x8 a1 = *(const bf16x8*)(P + (r0 - 1) * PW + P_CC + c0), h1 = *(const bf16x8*)(P + (r0 - 1) * PW + P_CH + c0);
#pragma unroll
                        for (int j = 0; j < 8; ++j) { u2[j] = bf2f((unsigned short)a2[j]) * bf2f((unsigned short)h2[j]); u1[j] = bf2f((unsigned short)a1[j]) * bf2f((unsigned short)h1[j]); }
                    }
#pragma unroll
                    for (int rr = 0; rr < 8; ++rr) { const size_t m = r0 + rr;
                        const bf16x8 a = *(const bf16x8*)(P + m * PW + P_CC + c0), hh = *(const bf16x8*)(P + m * PW + P_CH + c0), bb = *(const bf16x8*)(P + m * PW + P_CB + c0);
                        float o8[8];
#pragma unroll
                        for (int j = 0; j < 8; ++j) { const float u0 = bf2f((unsigned short)a[j]) * bf2f((unsigned short)hh[j]); o8[j] = bf2f((unsigned short)bb[j]) * (w0[j] * u2[j] + w1[j] * u1[j] + w2[j] * u0); u2[j] = u1[j]; u1[j] = u0; }
                        u32x4 w; w.x = pk2(o8[0], o8[1]); w.y = pk2(o8[2], o8[3]); w.z = pk2(o8[4], o8[5]); w.w = pk2(o8[6], o8[7]);
                        *(u32x4*)(MIXIN + m * DM + 768 + c0) = w; }
                    __syncthreads();
                }
                idx = (int)MISC[16 + ((iter + 1) & 1)]; ++iter;
            }
        }
        SEAM(pb + 1);
        if (IN(pb + 2)) { PHASE_IDS();
            pg8::Gemm g{MIXIN, Wout_t, M, DM, DM}; pg8::StaticOrder S; S.init(M, DM, G, bx);
            pg8::EpiStoreBf16 E{Y, DM};
            pg8::gemm_phase<pg8::EpiStoreBf16, pg8::StaticOrder, true, true>(L + RING_OFF, g, S, E);
        }
        SEAM(pb + 2);
        if (IN(pb + 3)) { PHASE_IDS();
            if (l == 0) rows_phase<true, false, const float*>(gw, NGW, lane, x, nullptr, Y, g_post_mix + (size_t)l * DM, XA, true, RS, (const float*)nullptr, false, nullptr, nullptr);
            else rows_phase<false, false, const float*>(gw, NGW, lane, XA, RS, Y, g_post_mix + (size_t)l * DM, XA, true, RS, (const float*)nullptr, false, nullptr, nullptr);
        }
        SEAM(pb + 3);
        if (IN(pb + 4)) { PHASE_IDS();
            pg8::Gemm g{XA, Wgu_t, M, NGU, DM}; pg8::StaticOrder S; S.init(M, NGU, G, bx);
            pg8::EpiSwiGLU E{H, DFF};
            pg8::gemm_phase<pg8::EpiSwiGLU, pg8::StaticOrder, true, true>(L + RING_OFF, g, S, E);
        }
        SEAM(pb + 4);
        if (IN(pb + 5)) { PHASE_IDS();
            pg8::Gemm g{H, Wd_t, M, DM, DFF}; pg8::StaticOrder S; S.init(M, DM, G, bx);
            pg8::EpiStoreBf16 E{Y, DM};
            pg8::gemm_phase<pg8::EpiStoreBf16, pg8::StaticOrder, true, true>(L + RING_OFF, g, S, E);
        }
        SEAM(pb + 5);
        if (IN(pb + 6)) { PHASE_IDS();
            if (!last) { const float* WFn = (const float*)(ws + WS_W + (size_t)(l + 1) * W_LAYER + WO_F);
                rows_phase<false, false, const float*>(gw, NGW, lane, XA, RS, Y, g_post_ffn + (size_t)l * DM, XA, true, RS, WFn, true, b_f + (size_t)(l + 1) * NH, LOGF); }
            else rows_phase<false, true, const float*>(gw, NGW, lane, XA, RS, Y, g_post_ffn + (size_t)l * DM, out, false, nullptr, (const float*)nullptr, false, nullptr, nullptr);
        }
        SEAM(pb + 6);
    }
#undef IN
#undef SEAM
}

#ifndef MK_MODE
#define MK_MODE 2
#endif
extern "C" void kernel_launch(void* const* d_in, const int* in_sizes, int n_in, void* d_out, int out_size, void* d_ws, size_t ws_size, hipStream_t stream) {
    if (n_in != 13 || in_sizes[0] != M * DM || out_size != M * DM || ws_size < WS_END) { fprintf(stderr, "kernel_launch: unexpected shapes (n_in %d, in0 %d, out %d, ws %zu)\n", n_in, n_in > 0 ? in_sizes[0] : -1, out_size, ws_size); return; }
    static int grid = 0;
    if (grid == 0) {
        int dev = 0, cus = 0, per_cu = 0;
        if (hipGetDevice(&dev) != hipSuccess || hipDeviceGetAttribute(&cus, hipDeviceAttributeMultiprocessorCount, dev) != hipSuccess) { fprintf(stderr, "kernel_launch: device query failed\n"); grid = -1; return; }
        if (hipFuncSetAttribute((const void*)mk_fwd, hipFuncAttributeMaxDynamicSharedMemorySize, LDS_BYTES) != hipSuccess) { fprintf(stderr, "kernel_launch: hipFuncSetAttribute failed\n"); grid = -1; return; }
        if (hipOccupancyMaxActiveBlocksPerMultiprocessor(&per_cu, (const void*)mk_fwd, NWAVES * 64, LDS_BYTES) != hipSuccess || per_cu < 1) fprintf(stderr, "kernel_launch: occupancy query reports %d\n", per_cu);
        (void)hipGetLastError();
        grid = cus;
    }
    if (grid < 0) return;
    if (hipMemsetAsync((char*)d_ws + WS_CTL, 0, CTL_ZERO_BYTES, stream) != hipSuccess) { fprintf(stderr, "kernel_launch: hipMemsetAsync of the control words failed; nothing launched\n"); return; }
    Args a{};
    for (int i = 0; i < 13; ++i) a.in[i] = (const float*)d_in[i];
    a.out = (float*)d_out; a.ws = (unsigned char*)d_ws;
#if MK_MODE == 2
    a.ph_lo = 0; a.ph_hi = NPH; a.li = 0;
    hipLaunchKernelGGL(mk_fwd, dim3(grid), dim3(NWAVES * 64), LDS_BYTES, stream, a);
#else
    for (int p = 0; p < NPH; ++p) { a.ph_lo = p; a.ph_hi = p + 1; a.li = p; hipLaunchKernelGGL(mk_fwd, dim3(grid), dim3(NWAVES * 64), LDS_BYTES, stream, a); }
#endif
}
```

```cpp
#include <hip/hip_runtime.h>
#include <cstdio>
#include <cstdint>

typedef unsigned short bf16;
typedef short bf16x8 __attribute__((ext_vector_type(8)));
typedef float f32x4 __attribute__((ext_vector_type(4)));
typedef unsigned u32x4 __attribute__((ext_vector_type(4)));
typedef unsigned u32x2 __attribute__((ext_vector_type(2)));

constexpr int DM = 1024, BATCH = 8, SEQ = 4096, DEPTH = 2, HD = 64, NH = 6, CCH = 256;
constexpr int M = BATCH * SEQ;
constexpr int INW = 3078, PW = 3072, DFF = 2816, NGU = 2 * DFF;
constexpr int MBLK = 256, NBLK = SEQ / MBLK;
constexpr float RMS_EPS = 1e-6f;
constexpr float LOG2E = 1.4426950408889634f;
constexpr float C2 = 0.125f * LOG2E;
constexpr int P_MQ = 0, P_MK = 384, P_MV = 768, P_FQ = 1152, P_FK = 1536, P_FV = 1920, P_CB = 2304, P_CC = 2560, P_CH = 2816;
constexpr size_t MiB = 1u << 20;
constexpr size_t WS_CTL = 0;
constexpr size_t WS_W = 2 * MiB, W_LAYER = 25 * MiB;
constexpr size_t WO_IN = 0, WO_OUT = 6 * MiB, WO_GU = 8 * MiB, WO_D = 19 * MiB, WO_F = 24 * MiB + 512 * 1024;
constexpr size_t WS_LOGF = 52 * MiB, WS_CUM = 53 * MiB, WS_KMEAN = 54 * MiB;
constexpr size_t WS_XN = 56 * MiB, WS_MIXIN = 120 * MiB, WS_XA = 184 * MiB, WS_P = 312 * MiB, WS_H = WS_P, WS_END = 504 * MiB;

__constant__ int c_bucket[129] = {0, 1, 2, 3, 4, 5, 6, 7, 8, 9, 10, 11, 12, 13, 14, 15, 16, 16, 16, 17, 17, 18, 18, 18, 19, 19, 19, 20, 20, 20, 20, 21, 21, 21, 21, 22, 22, 22, 22, 22, 23, 23, 23, 23, 23, 23, 24, 24, 24, 24, 24, 24, 25, 25, 25, 25, 25, 25, 25, 26, 26, 26, 26, 26, 26, 26, 26, 27, 27, 27, 27, 27, 27, 27, 27, 27, 27, 28, 28, 28, 28, 28, 28, 28, 28, 28, 28, 29, 29, 29, 29, 29, 29, 29, 29, 29, 29, 29, 29, 30, 30, 30, 30, 30, 30, 30, 30, 30, 30, 30, 30, 30, 30, 31, 31, 31, 31, 31, 31, 31, 31, 31, 31, 31, 31, 31, 31, 31, 31};

__device__ __forceinline__ unsigned f2bf(float f) { unsigned u = __builtin_bit_cast(unsigned, f); return (u + 0x7fffu + ((u >> 16) & 1u)) >> 16; }
typedef float f32x2v __attribute__((ext_vector_type(2))); typedef __bf16 bf16x2v __attribute__((ext_vector_type(2)));
__device__ __forceinline__ unsigned pk2(float lo, float hi) { const f32x2v v = {lo, hi}; const bf16x2v b = __builtin_convertvector(v, bf16x2v); return __builtin_bit_cast(unsigned, b); }
__device__ __forceinline__ float bf2f(unsigned short b) { return __builtin_bit_cast(float, (unsigned)b << 16); }
#define WS_DPP(v, ctrl, rm) (v) = (v) + __builtin_bit_cast(float, __builtin_amdgcn_update_dpp(0, __builtin_bit_cast(int, (v)), (ctrl), (rm), 0xf, false))
__device__ __forceinline__ float wave_sum(float v) {
    WS_DPP(v, 0xB1, 0xf); WS_DPP(v, 0x4E, 0xf); WS_DPP(v, 0x141, 0xf); WS_DPP(v, 0x140, 0xf); WS_DPP(v, 0x142, 0xa); WS_DPP(v, 0x143, 0xc);
    return __builtin_bit_cast(float, __builtin_amdgcn_readlane(__builtin_bit_cast(int, v), 63));
}

__device__ __forceinline__ float log_sigmoid(float z) { return z < 0.f ? z - log1pf(expf(z)) : -log1pf(expf(-z)); }
namespace pg8 {
#define PG8_LAS __attribute__((address_space(3)))
typedef unsigned short bf16_t;
typedef short bf16x8 __attribute__((ext_vector_type(8)));
typedef float f32x4 __attribute__((ext_vector_type(4)));
typedef unsigned u32x4 __attribute__((ext_vector_type(4)));
constexpr int BM = 256, BK = 64, HALF = 128, HTB = HALF * BK * 2  , STAGE_BYTES = 8 * HTB, NXCD = 8, WGM = 8;

__host__ __device__ __forceinline__ int lds_byte(int r, int c) { const int st = (r >> 4) * 2 + (c >> 5), rr = r & 15, cc = c & 31, ob = rr * 64 + cc * 2; return st * 1024 + (ob ^ (((ob >> 9) & 1) << 5)); }
__host__ __device__ __forceinline__ void stage_rc(int b, int& R, int& C) { const int st = b / 1024, sb = b % 1024, swz = sb ^ (((sb >> 9) & 1) << 5); R = (st >> 1) * 16 + swz / 64; C = (st & 1) * 32 + (swz % 64) / 2; }
__host__ __device__ __forceinline__ int perm32(int rho) { const int n = rho >> 4, i = rho & 15; return 8 * (i >> 2) + 4 * n + (i & 3); }

struct Unit { int pm, pn; };
struct Gemm { const bf16_t* A; const bf16_t* Bt; int M, N, K; };

struct StaticOrder {
    int nM, nN, nwg, G, c;
    __host__ __device__ void init(int M, int N, int G_, int c_) { nM = M / BM; nN = N / BM; nwg = nM * nN; G = G_; c = c_; }
    __host__ __device__ bool next(int i, Unit& u) const {
        const long L = (long)i * G + c; if (L >= nwg) return false;
        int wgid = (int)L; { const int q = nwg / NXCD, r = nwg % NXCD, xcd = wgid % NXCD, off = wgid / NXCD; wgid = (xcd < r ? xcd * (q + 1) : r * (q + 1) + (xcd - r) * q) + off; }
        const int nig = WGM * nN, gid = wgid / nig, fm = gid * WGM, gsz = (nM - fm) < WGM ? (nM - fm) : WGM;
        u.pm = fm + ((wgid % nig) % gsz); u.pn = (wgid % nig) / gsz; return true;
    }
    __device__ __forceinline__ void a_ready(const Unit&) const {}
    __device__ __forceinline__ void done(const Unit&) const {}
};
__device__ __forceinline__ unsigned cvt_pk_bf16(float lo, float hi) { unsigned r; asm volatile("v_cvt_pk_bf16_f32 %0, %1, %2" : "=v"(r) : "v"(lo), "v"(hi)); return r; }
typedef float f32x2 __attribute__((ext_vector_type(2)));
struct EpiStoreBf16 {
    static constexpr bool PERM = true, AFTER_DRAIN = false;
    bf16_t* O; int ldc;
    __device__ __forceinline__ void operator()(const f32x4 (&acc)[2][2][4][2], const Unit& u, int wr, int wc, int fr, int fq) const {
        const int row0 = u.pm * BM + wr * 64 + fr, col0 = u.pn * BM + wc * 32 + 8 * fq;
#pragma unroll
        for (int ai = 0; ai < 2; ++ai)
#pragma unroll
            for (int m = 0; m < 4; ++m) { bf16_t* rowp = O + (size_t)(row0 + ai * HALF + m * 16) * ldc + col0;
#pragma unroll
                for (int bj = 0; bj < 2; ++bj) { const f32x4 v0 = acc[ai][bj][m][0], v1 = acc[ai][bj][m][1];
                    u32x4 w; w.x = cvt_pk_bf16(v0[0], v0[1]); w.y = cvt_pk_bf16(v0[2], v0[3]); w.z = cvt_pk_bf16(v1[0], v1[1]); w.w = cvt_pk_bf16(v1[2], v1[3]);
                    *(u32x4*)(rowp + bj * HALF) = w; } }
    }
};
struct EpiStoreF32 {
    static constexpr bool PERM = false, AFTER_DRAIN = false;
    float* C; int ldc;
    __device__ __forceinline__ void operator()(const f32x4 (&acc)[2][2][4][2], const Unit& u, int wr, int wc, int fr, int fq) const {
        const int row0 = u.pm * BM + wr * 64 + fr, col0 = u.pn * BM + wc * 32 + 4 * fq;
#pragma unroll
        for (int ai = 0; ai < 2; ++ai)
#pragma unroll
            for (int m = 0; m < 4; ++m) { float* rowp = C + (size_t)(row0 + ai * HALF + m * 16) * ldc + col0;
#pragma unroll
                for (int bj = 0; bj < 2; ++bj)
#pragma unroll
                    for (int n = 0; n < 2; ++n) *(f32x4*)(rowp + bj * HALF + n * 16) = acc[ai][bj][m][n]; }
    }
};
__device__ __forceinline__ float silu_mul(float g, float u) { return g * __builtin_amdgcn_rcpf(1.0f + __builtin_amdgcn_exp2f(g * -1.4426950408889634f)) * u; }
struct EpiSwiGLU {
    static constexpr bool PERM = true, AFTER_DRAIN = false;
    bf16_t* O; int ldc;
    __device__ __forceinline__ void operator()(f32x4 (&acc)[2][2][4][2], const Unit& u, int wr, int wc, int fr, int fq) const {
        const int row0 = u.pm * BM + wr * 64 + fr, col0 = u.pn * HALF + wc * 32 + 8 * fq;
#pragma unroll
        for (int ai = 0; ai < 2; ++ai)
#pragma unroll
            for (int m = 0; m < 4; ++m) { bf16_t* rowp = O + (size_t)(row0 + ai * HALF + m * 16) * ldc + col0;
                const f32x4 g0 = acc[ai][0][m][0], g1 = acc[ai][0][m][1], u0 = acc[ai][1][m][0], u1 = acc[ai][1][m][1];
                u32x4 w; w.x = cvt_pk_bf16(silu_mul(g0[0], u0[0]), silu_mul(g0[1], u0[1])); w.y = cvt_pk_bf16(silu_mul(g0[2], u0[2]), silu_mul(g0[3], u0[3]));
                w.z = cvt_pk_bf16(silu_mul(g1[0], u1[0]), silu_mul(g1[1], u1[1])); w.w = cvt_pk_bf16(silu_mul(g1[2], u1[2]), silu_mul(g1[3], u1[3]));
                *(u32x4*)rowp = w; }
    }
};
struct EpiInProj {
    static constexpr bool PERM = true, AFTER_DRAIN = false;
    bf16_t* O; int ldc; float* kmean; float* knp;
    __device__ __forceinline__ void operator()(f32x4 (&acc)[2][2][4][2], const Unit& u, int wr, int wc, int fr, int fq) const {
        const int row0 = u.pm * BM + wr * 64 + fr, col0 = u.pn * BM + wc * 32 + 8 * fq;
#pragma unroll
        for (int ai = 0; ai < 2; ++ai)
#pragma unroll
            for (int m = 0; m < 4; ++m) { bf16_t* rowp = O + (size_t)(row0 + ai * HALF + m * 16) * ldc + col0;
#pragma unroll
                for (int bj = 0; bj < 2; ++bj) { const f32x4 v0 = acc[ai][bj][m][0], v1 = acc[ai][bj][m][1];
                    u32x4 w; w.x = cvt_pk_bf16(v0[0], v0[1]); w.y = cvt_pk_bf16(v0[2], v0[3]); w.z = cvt_pk_bf16(v1[0], v1[1]); w.w = cvt_pk_bf16(v1[2], v1[3]);
                    *(u32x4*)(rowp + bj * HALF) = w; } }
        if (u.pn == 6 || u.pn == 7) {
#pragma unroll
            for (int bj = 0; bj < 2; ++bj) {
                if (u.pn == 7 && bj == 1) continue;
                const int head = 4 * (u.pn - 6) + 2 * bj + (wc >> 1);
#pragma unroll
                for (int ai = 0; ai < 2; ++ai) { float mx = 0.f;
#pragma unroll
                    for (int m = 0; m < 4; ++m) { const f32x4 v0 = acc[ai][bj][m][0], v1 = acc[ai][bj][m][1];
                        float ss = (v0[0] * v0[0] + v0[1] * v0[1]) + (v0[2] * v0[2] + v0[3] * v0[3]) + (v1[0] * v1[0] + v1[1] * v1[1]) + (v1[2] * v1[2] + v1[3] * v1[3]);
                        ss += __shfl_xor(ss, 16); ss += __shfl_xor(ss, 32); mx = fmaxf(mx, ss); }
                    mx = fmaxf(mx, __shfl_xor(mx, 1)); mx = fmaxf(mx, __shfl_xor(mx, 2)); mx = fmaxf(mx, __shfl_xor(mx, 4)); mx = fmaxf(mx, __shfl_xor(mx, 8));
                    if (fr == 0 && fq == 0) knp[((size_t)((u.pm >> 4) * 6 + head) * 64 + ((u.pm & 15) * 4 + ai * 2 + wr)) * 2 + (wc & 1)] = mx * 1.02f; }
            }
        }
        if (u.pn == 1 || u.pn == 2) {
#pragma unroll
            for (int bj = 0; bj < 2; ++bj) {
                if (u.pn == 1 && bj == 0) continue;
                const int cp = u.pn * BM + bj * HALF + wc * 32 + 8 * fq - 384;
                float* dst = kmean + ((size_t)((u.pm >> 4) * 6 + (cp >> 6)) * 16 + (u.pm & 15)) * 64 + (cp & 63);
#pragma unroll
                for (int n = 0; n < 2; ++n)
#pragma unroll
                    for (int i = 0; i < 4; ++i) { float s = 0.f;
#pragma unroll
                        for (int ai = 0; ai < 2; ++ai)
#pragma unroll
                            for (int m = 0; m < 4; ++m) s += acc[ai][bj][m][n][i];
                        s += __shfl_xor(s, 1); s += __shfl_xor(s, 2); s += __shfl_xor(s, 4); s += __shfl_xor(s, 8);
                        if (fr == 0) atomicAdd(dst + 4 * n + i, s * (1.0f / 256.0f)); }
            }
        }
    }
};
template <class Epi, class Sched, bool ALIGN_EPI = false, bool SP2 = false>
__device__ __forceinline__ void gemm_phase(PG8_LAS unsigned char* lds, const Gemm g, const Sched& S, const Epi& E) {
    int tid_ = threadIdx.x; asm volatile("" : "+v"(tid_));
    const int tid = tid_, wid = __builtin_amdgcn_readfirstlane(tid >> 6), lane = tid & 63, wr = wid >> 2, wc = wid & 3, fr = lane & 15, fq = lane >> 4;
    const int K = g.K, nt = K / BK;
    unsigned voffA[2], voffB[2];
#pragma unroll
    for (int i = 0; i < 2; ++i) { int R, C; stage_rc(tid * 16 + i * 8192, R, C); const int Rb = Epi::PERM ? ((R & ~31) + perm32(R & 31)) : R;
        voffA[i] = (unsigned)(R * K + C) * 2u; voffB[i] = (unsigned)(Rb * K + C) * 2u; }
    const size_t kstep = (size_t)(BK * 2);
    const size_t hstep = (size_t)HALF * K * 2;
    const size_t tstep = 2 * hstep;
    const unsigned ldsw = (unsigned)wid * 1024u;
    const int aoff = lds_byte(wr * 64 + fr, fq * 8), boff = lds_byte(wc * 32 + fr, fq * 8);
#define PG8_SA(b, h) (((b) * 2 + (h)) * HTB)
#define PG8_SB(b, h) ((4 + (b) * 2 + (h)) * HTB)
#define PG8_STAGE(bufoff, gbase, voff) do { _Pragma("unroll") for (int _i = 0; _i < 2; ++_i) \
        __builtin_amdgcn_global_load_lds((const unsigned*)((const char*)(gbase) + (voff)[_i]), (PG8_LAS unsigned*)(lds + (bufoff) + ldsw + _i * 8192), 16, 0, 0); } while (0)
#define PG8_LDA(dst, b, h) do { _Pragma("unroll") for (int m = 0; m < 4; ++m) _Pragma("unroll") for (int k = 0; k < 2; ++k) dst[m][k] = *(const PG8_LAS bf16x8*)(lds + PG8_SA(b, h) + aoff + m * 2048 + k * 1024); } while (0)
#define PG8_LDB(dst, b, h) do { _Pragma("unroll") for (int n = 0; n < 2; ++n) _Pragma("unroll") for (int k = 0; k < 2; ++k) dst[n][k] = *(const PG8_LAS bf16x8*)(lds + PG8_SB(b, h) + boff + n * 2048 + k * 1024); } while (0)
#define PG8_MMA(ai, bj, At, Bt) do { __builtin_amdgcn_s_setprio(1); _Pragma("unroll") for (int m = 0; m < 4; ++m) _Pragma("unroll") for (int n = 0; n < 2; ++n) _Pragma("unroll") for (int k = 0; k < 2; ++k) \
        acc[ai][bj][m][n] = __builtin_amdgcn_mfma_f32_16x16x32_bf16(Bt[n][k], At[m][k], acc[ai][bj][m][n], 0, 0, 0); __builtin_amdgcn_s_setprio(0); } while (0)
#define PG8_WAIT_V(n) asm volatile("s_waitcnt vmcnt(" #n ")" ::: "memory")
#define PG8_WAIT_L(n) asm volatile("s_waitcnt lgkmcnt(" #n ")" ::: "memory")
#define PG8_BAR __builtin_amdgcn_s_barrier()
#define PG8_SCHED __builtin_amdgcn_sched_barrier(0)
    Unit cur, nxt; int ui = 0;
    if (!S.next(0, cur)) return;
    f32x4 acc[2][2][4][2];
#pragma unroll
    for (int a = 0; a < 2; ++a)
#pragma unroll
        for (int b = 0; b < 2; ++b)
#pragma unroll
            for (int m = 0; m < 4; ++m)
#pragma unroll
                for (int n = 0; n < 2; ++n) acc[a][b][m][n] = (f32x4){0.f, 0.f, 0.f, 0.f};
    bf16x8 At[4][2], B0[2][2], B1[2][2];
    const char* cA = (const char*)g.A + (size_t)cur.pm * tstep; const char* cB = (const char*)g.Bt + (size_t)cur.pn * tstep;
    S.a_ready(cur);
    if constexpr (SP2) {
        PG8_STAGE(PG8_SB(0, 0), cB, voffB); PG8_STAGE(PG8_SB(0, 1), cB + hstep, voffB); PG8_STAGE(PG8_SA(0, 0), cA, voffA); PG8_STAGE(PG8_SA(0, 1), cA + hstep, voffA);
        if (wr == 1) PG8_BAR;
        PG8_WAIT_V(2); PG8_BAR;
        PG8_STAGE(PG8_SB(1, 0), cB + kstep, voffB); PG8_STAGE(PG8_SA(1, 0), cA + kstep, voffA); PG8_STAGE(PG8_SB(1, 1), cB + hstep + kstep, voffB);
        PG8_WAIT_V(6); PG8_BAR;
    } else {
        PG8_STAGE(PG8_SB(0, 0), cB, voffB); PG8_STAGE(PG8_SA(0, 0), cA, voffA); PG8_STAGE(PG8_SB(0, 1), cB + hstep, voffB); PG8_STAGE(PG8_SA(0, 1), cA + hstep, voffA);
        if (wr == 1) PG8_BAR;
        PG8_WAIT_V(4); PG8_BAR;
        PG8_STAGE(PG8_SB(1, 0), cB + kstep, voffB); PG8_STAGE(PG8_SA(1, 0), cA + kstep, voffA); PG8_STAGE(PG8_SB(1, 1), cB + hstep + kstep, voffB);
        PG8_WAIT_V(6); PG8_BAR;
    }
    for (;;) {
        const bool has_next = S.next(ui + 1, nxt);
        const char* nA = has_next ? (const char*)g.A + (size_t)nxt.pm * tstep : cA; const char* nB = has_next ? (const char*)g.Bt + (size_t)nxt.pn * tstep : cB;
        for (int t = 0; t < nt; t += 2) {
            const bool last = (t == nt - 2);
            const char* a1 = cA + (size_t)(t + 1) * kstep;
            const char* a2 = last ? nA : cA + (size_t)(t + 2) * kstep; const char* b2 = last ? nB : cB + (size_t)(t + 2) * kstep;
            const char* a3 = a2 + kstep; const char* b3 = b2 + kstep;
            if (last && has_next) S.a_ready(nxt);
            if constexpr (SP2) {
            PG8_LDB(B0, 0, 0); PG8_LDB(B1, 0, 1); PG8_SCHED; PG8_LDA(At, 0, 0); PG8_STAGE(PG8_SA(1, 1), a1 + hstep, voffA);
            PG8_WAIT_V(8); PG8_WAIT_L(0); PG8_BAR; PG8_MMA(0, 0, At, B0); PG8_MMA(0, 1, At, B1); PG8_BAR; PG8_SCHED;
            PG8_LDA(At, 0, 1); PG8_STAGE(PG8_SB(0, 0), b2, voffB); PG8_STAGE(PG8_SB(0, 1), b2 + hstep, voffB); PG8_STAGE(PG8_SA(0, 0), a2, voffA);
            PG8_WAIT_V(8); PG8_WAIT_L(0); PG8_BAR; PG8_MMA(1, 0, At, B0); PG8_MMA(1, 1, At, B1); PG8_BAR; PG8_SCHED;
            PG8_LDB(B0, 1, 0); PG8_LDB(B1, 1, 1); PG8_SCHED; PG8_LDA(At, 1, 0); PG8_STAGE(PG8_SA(0, 1), a2 + hstep, voffA);
            PG8_WAIT_V(8); PG8_WAIT_L(0); PG8_BAR; PG8_MMA(0, 0, At, B0); PG8_MMA(0, 1, At, B1); PG8_BAR; PG8_SCHED;
            PG8_LDA(At, 1, 1); PG8_STAGE(PG8_SB(1, 0), b3, voffB); PG8_STAGE(PG8_SB(1, 1), b3 + hstep, voffB); PG8_STAGE(PG8_SA(1, 0), a3, voffA);
            PG8_WAIT_V(8); PG8_WAIT_L(0); PG8_BAR; PG8_MMA(1, 0, At, B0); PG8_MMA(1, 1, At, B1); PG8_BAR; PG8_SCHED;
            } else {
            PG8_LDB(B0, 0, 0); PG8_SCHED; PG8_LDA(At, 0, 0); PG8_STAGE(PG8_SA(1, 1), a1 + hstep, voffA);
            PG8_WAIT_L(8); PG8_BAR; PG8_WAIT_L(0); PG8_MMA(0, 0, At, B0); PG8_BAR; PG8_SCHED;
            PG8_LDB(B1, 0, 1); PG8_STAGE(PG8_SB(0, 0), b2, voffB);
            PG8_BAR; PG8_WAIT_L(0); PG8_MMA(0, 1, At, B1); PG8_BAR;
            PG8_LDA(At, 0, 1); PG8_STAGE(PG8_SA(0, 0), a2, voffA);
            PG8_BAR; PG8_WAIT_L(0); PG8_MMA(1, 0, At, B0); PG8_BAR; PG8_SCHED;
            PG8_STAGE(PG8_SB(0, 1), b2 + hstep, voffB);
            PG8_WAIT_V(6); PG8_BAR; PG8_MMA(1, 1, At, B1); PG8_BAR;
            PG8_LDB(B0, 1, 0); PG8_SCHED; PG8_LDA(At, 1, 0); PG8_STAGE(PG8_SA(0, 1), a2 + hstep, voffA);
            PG8_WAIT_L(8); PG8_BAR; PG8_WAIT_L(0); PG8_MMA(0, 0, At, B0); PG8_BAR; PG8_SCHED;
            PG8_LDB(B1, 1, 1); PG8_STAGE(PG8_SB(1, 0), b3, voffB);
            PG8_BAR; PG8_WAIT_L(0); PG8_MMA(0, 1, At, B1); PG8_BAR;
            PG8_LDA(At, 1, 1); PG8_STAGE(PG8_SA(1, 0), a3, voffA);
            PG8_BAR; PG8_WAIT_L(0); PG8_MMA(1, 0, At, B0); PG8_BAR; PG8_SCHED;
            PG8_STAGE(PG8_SB(1, 1), b3 + hstep, voffB);
            PG8_WAIT_V(6); PG8_BAR; PG8_MMA(1, 1, At, B1); PG8_BAR;
            }
        }
        if constexpr (ALIGN_EPI) { if (wr == 0) PG8_BAR; }
        if constexpr (!Epi::AFTER_DRAIN) { E(acc, cur, wr, wc, fr, fq); S.done(cur); }
        if (!has_next) break;
#pragma unroll
        for (int a = 0; a < 2; ++a)
#pragma unroll
            for (int b = 0; b < 2; ++b)
#pragma unroll
                for (int m = 0; m < 4; ++m)
#pragma unroll
                    for (int n = 0; n < 2; ++n) acc[a][b][m][n] = (f32x4){0.f, 0.f, 0.f, 0.f};
        cur = nxt; cA = nA; cB = nB; ++ui;
        if constexpr (ALIGN_EPI) { if (wr == 1) PG8_BAR; }
    }
    PG8_WAIT_V(0);
    if constexpr (!ALIGN_EPI) { if (wr == 0) PG8_BAR; }
    PG8_BAR;
    if constexpr (Epi::AFTER_DRAIN) { E.fused(acc, cur, wr, wc, fr, fq, lds, wid, lane); S.done(cur); }
#undef PG8_SA
#undef PG8_SB
#undef PG8_STAGE
#undef PG8_LDA
#undef PG8_LDB
#undef PG8_MMA
#undef PG8_WAIT_V
#undef PG8_WAIT_L
#undef PG8_BAR
#undef PG8_SCHED
}
}

#include <hip/hip_bf16.h>
#include <cmath>
namespace attn_body {
using bf16=__hip_bfloat16;
using bf16x8=__attribute__((ext_vector_type(8)))short;
using s16x4=__attribute__((ext_vector_type(4)))short;
using f32x16=__attribute__((ext_vector_type(16)))float;
using u32x4=__attribute__((ext_vector_type(4)))unsigned;
using f32x4_t=__attribute__((ext_vector_type(4)))float;
constexpr int D=64;
constexpr int NW=8,QBLK=32,QB=QBLK*NW,KVBLK=64;
constexpr int QP=3072, OPITCH=1024;
constexpr int AUX_R0=0, AUX_INFO=1024, AUX_TAB=2048, AUX_BYTES=2048+16384+1024;
__device__ __forceinline__ int crow(int r,int hi){return (r&3)+8*(r>>2)+4*hi;}
#define SBAR() __builtin_amdgcn_sched_barrier(0)
__device__ __forceinline__ void cmask(f32x16&p0,f32x16&p1,int jb,int qrel,int hi){
  const float NEG=-INFINITY; int kb=64*jb+4*hi;
  #pragma unroll
  for(int r=0;r<16;++r){int kv=kb+(r&3)+8*(r>>2); if(kv>qrel)p0[r]=NEG; if(kv+32>qrel)p1[r]=NEG;}
}

constexpr int NSLOT=3, SLOTB=8192;
constexpr int LDS_K=0, LDS_V=NSLOT*SLOTB, LDS_WS=2*NSLOT*SLOTB, LDS_OST=LDS_WS+NW*64*4, LDS_BYTES=LDS_OST+NW*4096;
constexpr float C2=0.125f*1.4426950408889634f;
__device__ __forceinline__ void glds16(const void*gsrc,unsigned lds_dst){unsigned keep;
  asm volatile("s_mov_b32 %0, m0\n\ts_mov_b32 m0, %2\n\ts_nop 0\n\tglobal_load_lds_dwordx4 %1, off\n\ts_mov_b32 m0, %0":"=&s"(keep):"v"(gsrc),"s"(lds_dst):"memory");}
__device__ __forceinline__ float max3f(float a,float b,float c){float r;asm("v_max3_f32 %0, %1, %2, %3":"=v"(r):"v"(a),"v"(b),"v"(c));return r;}
__device__ __forceinline__ float max2f(float a,float b){float r;asm("v_max_f32_e32 %0, %1, %2":"=v"(r):"v"(a),"v"(b));return r;}
__device__ __forceinline__ float fadd_s(float a,float b){float r;asm("v_add_f32_e32 %0, %1, %2":"=v"(r):"v"(a),"v"(b));return r;}
__device__ __forceinline__ float fsub_s(float a,float b){float r;asm("v_sub_f32_e32 %0, %1, %2":"=v"(r):"v"(a),"v"(b));return r;}
typedef float f32x2_t __attribute__((ext_vector_type(2))); typedef __bf16 bf16x2_t __attribute__((ext_vector_type(2)));
__device__ __forceinline__ unsigned cvtpk_s(float lo,float hi){f32x2_t v={lo,hi};bf16x2_t b=__builtin_convertvector(v,bf16x2_t);return __builtin_bit_cast(unsigned,b);}
#define WAIT_BAR(N) asm volatile("s_waitcnt vmcnt(" #N ") lgkmcnt(0)\n\ts_barrier":::"memory")

__device__ __forceinline__ void qkt(f32x16&p0,f32x16&p1,const char*Kslot,const bf16x8*qr,const f32x16&negm,int r32,int hi){
  const char*kb=Kslot+hi*1024+r32*16;
  #pragma unroll
  for(int d0=0;d0<4;++d0){
    const bf16x8 b0=*reinterpret_cast<const bf16x8*>(kb+d0*2048);
    const bf16x8 b1=*reinterpret_cast<const bf16x8*>(kb+d0*2048+512);
    if(d0==0){p0=__builtin_amdgcn_mfma_f32_32x32x16_bf16(b0,qr[0],negm,0,0,0);p1=__builtin_amdgcn_mfma_f32_32x32x16_bf16(b1,qr[0],negm,0,0,0);}
    else{p0=__builtin_amdgcn_mfma_f32_32x32x16_bf16(b0,qr[d0],p0,0,0,0);p1=__builtin_amdgcn_mfma_f32_32x32x16_bf16(b1,qr[d0],p1,0,0,0);}}
}
typedef __attribute__((address_space(3))) const char* lds_cptr;
typedef short v4i16_t __attribute__((ext_vector_type(4)));
__device__ __forceinline__ void kload8(bf16x8*kf,lds_cptr kp){
  kf[0]=*(const __attribute__((address_space(3))) bf16x8*)(kp);      kf[1]=*(const __attribute__((address_space(3))) bf16x8*)(kp+512);
  kf[2]=*(const __attribute__((address_space(3))) bf16x8*)(kp+2048); kf[3]=*(const __attribute__((address_space(3))) bf16x8*)(kp+2560);
  kf[4]=*(const __attribute__((address_space(3))) bf16x8*)(kp+4096); kf[5]=*(const __attribute__((address_space(3))) bf16x8*)(kp+4608);
  kf[6]=*(const __attribute__((address_space(3))) bf16x8*)(kp+6144); kf[7]=*(const __attribute__((address_space(3))) bf16x8*)(kp+6656);
}
__device__ __forceinline__ void kload2(bf16x8*kf,lds_cptr kp,int j){ kf[2*j]=*(const __attribute__((address_space(3))) bf16x8*)(kp+j*2048); kf[2*j+1]=*(const __attribute__((address_space(3))) bf16x8*)(kp+j*2048+512); }
__device__ __forceinline__ s16x4 vtr(lds_cptr p){ return __builtin_bit_cast(s16x4,__builtin_amdgcn_ds_read_tr16_b64_v4i16((__attribute__((address_space(3))) v4i16_t*)p)); }
__device__ __forceinline__ float rowmax(const f32x16&p0,const f32x16&p1){
  float a=max3f(p0[0],p0[1],p1[0]),b=max3f(p0[2],p0[3],p1[1]);a=max3f(a,p1[2],p1[3]);
  #pragma unroll
  for(int r=4;r<16;r+=4){a=max3f(a,p0[r],p0[r+1]);b=max3f(b,p0[r+2],p0[r+3]);a=max3f(a,p1[r],p1[r+1]);b=max3f(b,p1[r+2],p1[r+3]);}
  const float m=max2f(a,b);
  auto rr=__builtin_amdgcn_permlane32_swap(__float_as_uint(m),__float_as_uint(m),false,false);
  return max2f(__uint_as_float(rr[0]),__uint_as_float(rr[1]));
}
__device__ __forceinline__ void pv(f32x16*o,int vb,bf16x8 pa0,bf16x8 pa1,bf16x8 pa2,bf16x8 pa3){
  #pragma unroll
  for(int d0=0;d0<2;++d0){s16x4 lo[4],hi[4];
    #pragma unroll
    for(int ks=0;ks<4;++ks){
      asm volatile("ds_read_b64_tr_b16 %0,%1 offset:%c2":"=&v"(lo[ks]):"v"(vb),"i"(d0*4096+ks*1024):"memory");
      asm volatile("ds_read_b64_tr_b16 %0,%1 offset:%c2":"=&v"(hi[ks]):"v"(vb),"i"(d0*4096+ks*1024+512):"memory");}
    asm volatile("s_waitcnt lgkmcnt(0)":::"memory");SBAR();
    #define PK(k) (bf16x8){lo[k][0],lo[k][1],lo[k][2],lo[k][3],hi[k][0],hi[k][1],hi[k][2],hi[k][3]}
    o[d0]=__builtin_amdgcn_mfma_f32_32x32x16_bf16(pa0,PK(0),o[d0],0,0,0);
    o[d0]=__builtin_amdgcn_mfma_f32_32x32x16_bf16(pa1,PK(1),o[d0],0,0,0);
    o[d0]=__builtin_amdgcn_mfma_f32_32x32x16_bf16(pa2,PK(2),o[d0],0,0,0);
    o[d0]=__builtin_amdgcn_mfma_f32_32x32x16_bf16(pa3,PK(3),o[d0],0,0,0);
    #undef PK
  }
}

#ifndef ATTN_STORE16
#define ATTN_STORE16(p,v) (*(u32x4*)(p)=(v))
#endif
template<int KIND,int THRL> __device__ __forceinline__ void attn_unit(const bf16*Qg,const bf16*__restrict__ Kg,const bf16*__restrict__ Vg,bf16*Og,const int NT,const int tile0,const int q0,const int qb,char*shm,lds_cptr aux){
  int tid_=threadIdx.x; asm volatile("":"+v"(tid_));
  const int tid=tid_,lane=tid&63,r32=lane&31,hi=lane>>5; const int wid=__builtin_amdgcn_readfirstlane(tid>>6);
  const bf16*Qw=Qg+(long)(wid*QBLK)*QP;
  const bf16*Kh=Kg,*Vh=Vg;
  const unsigned lds0=(unsigned)(uintptr_t)shm;
  float*wsf=(float*)(shm+LDS_WS)+wid*64;
  const bf16*ksrc=Kh+(long)lane*QP+wid*8;
  const bf16*vsrc=Vh+(long)(16*(wid&3)+(lane>>2))*QP+(wid>>2)*32+(lane&3)*8;
  const unsigned kdst=lds0+LDS_K+wid*1024, vdst=lds0+LDS_V+wid*1024;
  #define DMA_K(t,slot) glds16(ksrc+(long)(t)*KVBLK*QP,(unsigned)__builtin_amdgcn_readfirstlane(kdst+(slot)))
  #define DMA_V(t,slot) glds16(vsrc+(long)(t)*KVBLK*QP,(unsigned)__builtin_amdgcn_readfirstlane(vdst+(slot)))
  const int vb0=(int)(lds0+LDS_V)+((lane>>4)&1)*32+(lane&3)*8+(4*hi+((lane&15)>>2))*64;
  const char*Kbase=shm+LDS_K; bf16x8 kf[8];
  const lds_cptr shm3=(lds_cptr)shm; const lds_cptr kp0=shm3+LDS_K+hi*1024+r32*16; const lds_cptr vp0=shm3+LDS_V+((lane>>4)&1)*32+(lane&3)*8+(4*hi+((lane&15)>>2))*64;
  DMA_K(0,0);DMA_V(0,0);DMA_K(1,SLOTB);
  bf16x8 qr[4];
  #pragma unroll
  for(int d0=0;d0<4;++d0)qr[d0]=*reinterpret_cast<const bf16x8*>(&Qw[(long)r32*QP+d0*16+hi*8]);
  typedef __attribute__((address_space(3))) const float* lds_fptr; typedef __attribute__((address_space(3))) const unsigned* lds_uptr; typedef __attribute__((address_space(3))) const f32x4_t* lds_f4ptr;
  const int myrow=wid*QBLK+r32; const lds_fptr aux_tab=(lds_fptr)(aux+AUX_TAB);
  float mhat=((lds_fptr)(aux+AUX_R0))[myrow],l_reg=0.f; const unsigned rinfo=((lds_uptr)(aux+AUX_INFO))[myrow];
  f32x16 o[2];o[0]=f32x16{};o[1]=f32x16{};f32x16 negm=f32x16{};
  #define NEGM_SET(tn) do{ if(KIND==1){ const int bn_=(tile0+(tn))>>2; const float nv_=(bn_<qb&&!((rinfo>>bn_)&1u))?-INFINITY:-mhat; _Pragma("unroll") for(int r=0;r<16;++r)negm[r]=nv_; asm volatile("":"+v"(negm)); } }while(0)
  NEGM_SET(0);
  const float NEGI=-INFINITY;
  #define CFENCE() asm volatile("":::"memory")
  #define POST(C0,C1,t) do{ \
    if(KIND==0){ const float nm_=-mhat; asm volatile("s_nop 15\n\ts_nop 7":"+v"(C0),"+v"(C1));   \
      const lds_f4ptr cp_=(lds_f4ptr)(aux_tab+((tile0+(t))*64+4*hi)); \
      _Pragma("unroll") for(int g_=0;g_<4;++g_){ const f32x4_t a_=cp_[2*g_],b_=cp_[8+2*g_]; \
        _Pragma("unroll") for(int i_=0;i_<4;++i_){ C0[4*g_+i_]=fadd_s(C0[4*g_+i_],fsub_s(nm_,a_[i_])); C1[4*g_+i_]=fadd_s(C1[4*g_+i_],fsub_s(nm_,b_[i_])); } if(g_==1)CFENCE(); } } \
    else { const int blk_=(tile0+(t))>>2; \
      const int dw_=(q0+wid*QBLK)-(tile0+(t))*64;     \
      if(blk_>=qb-1&&dw_<176&&dw_>-32){ asm volatile("s_nop 15\n\ts_nop 7":"+v"(C0),"+v"(C1)); const int db_=(q0+myrow)-((tile0+(t))*64+4*hi); \
        _Pragma("unroll") for(int r=0;r<16;++r){ const int d_=db_-((r&3)+8*(r>>2)); const int i0_=d_<0?0:(d_>128?128:d_), e_=d_-32, i1_=e_<0?0:(e_>128?128:e_); C0[r]=fadd_s(C0[r],aux_tab[i0_]); C1[r]=fadd_s(C1[r],aux_tab[i1_]); if((r&3)==3)CFENCE(); } } } \
  }while(0)
  const int qrel=wid*QBLK+r32;
  #define CMASK(P0,P1,t) do{int jb_=(t)-(NT-4); if(jb_>=0)cmask(P0,P1,jb_,qrel,hi);}while(0)
  bool resc=false;
  #define START(P0,P1) do{ const float rm=rowmax(P0,P1); resc=false; \
    { const float dl=max2f(rm,0.f); mhat=fadd_s(mhat,dl); \
      _Pragma("unroll") for(int r=0;r<16;++r){P0[r]=fsub_s(P0[r],dl);P1[r]=fsub_s(P1[r],dl);} \
      NEGM_SET(1); } \
    _Pragma("unroll") for(int r=0;r<16;++r)P0[r]=__builtin_amdgcn_exp2f(P0[r]); }while(0)
  #define RESC() do{ if(resc){ asm volatile("s_waitcnt lgkmcnt(0)":::"memory"); \
      _Pragma("unroll") for(int d_=0;d_<2;++d_) _Pragma("unroll") for(int r=0;r<16;++r)o[d_][r]*=wsf[crow(r,hi)]; } }while(0)
  f32x16 pA0,pA1,pB0,pB1;
  int sl_prev=0,sl_cur=0,sl_next=SLOTB;
  #define ROT() do{sl_prev=sl_cur;sl_cur=sl_next;sl_next=(sl_next==(NSLOT-1)*SLOTB)?0:sl_next+SLOTB;}while(0)
  DMA_K(2,2*SLOTB);
  WAIT_BAR(3);
  qkt(pA0,pA1,Kbase,qr,negm,r32,hi);asm volatile("s_nop 15\n\ts_nop 7":"+v"(pA0),"+v"(pA1));CMASK(pA0,pA1,0);POST(pA0,pA1,0);
  START(pA0,pA1);
  _Pragma("unroll") for(int r=0;r<16;++r)pA1[r]=__builtin_amdgcn_exp2f(pA1[r]);
  WAIT_BAR(0);
  DMA_K(3,0);DMA_V(1,SLOTB);
  ROT();
  kload8(kf,kp0+sl_cur);
  WAIT_BAR(2);
  s16x4 vlo[8],vhi[8]; u32x4 pw0,pw1,pw2,pw3;
  #define PKW(P,B) cvtpk_s(P[B],P[B+1])
  #define PAF(k) __builtin_bit_cast(bf16x8,pw##k)
  #define VFR(i) (bf16x8){vlo[i][0],vlo[i][1],vlo[i][2],vlo[i][3],vhi[i][0],vhi[i][1],vhi[i][2],vhi[i][3]}
  #define PIN(x) asm volatile("":"+v"(x))
  #define MX3(a,b,c) __builtin_fmaxf(__builtin_fmaxf((a),(b)),(c))
  #define GAPA(MF,A0,A1,A2,A3,W0,W1,PW) do{ MF; sacc+=A0; sacc+=A1; sacc+=A2; sacc+=A3; PIN(sacc); W0; W1; PIN(PW); SBAR(); }while(0)
  #define EX(v) __builtin_amdgcn_exp2f(v)
  #define GAPB(MF,X,B) do{ MF; X[B]=EX(X[B]); X[B+1]=EX(X[B+1]); X[B+2]=EX(X[B+2]); X[B+3]=EX(X[B+3]); PIN(X); SBAR(); }while(0)
  #define VRD(i) do{ vlo[i]=vtr(vp_+(((i)>>2)*4096+((i)&3)*1024)); vhi[i]=vtr(vp_+(((i)>>2)*4096+((i)&3)*1024+512)); }while(0)
  #define KRD(G,j) do{ if(G){ kload2(kf,kp0+sl_next,j); SBAR(); } }while(0)
  #define STEP(C0,C1,P0,P1,t,GK,GV,GL) do{ SBAR(); \
    const lds_cptr vp_=vp0+sl_prev; \
    VRD(0); SBAR(); float sacc=(P0[0]+P0[1]); \
    GAPA(C0=__builtin_amdgcn_mfma_f32_32x32x16_bf16(kf[0],qr[0],negm,0,0,0), P0[2],P0[3],P0[4],P0[5],     pw0[0]=PKW(P0,0), pw0[1]=PKW(P0,2), pw0); \
    VRD(4); SBAR(); GAPA(C1=__builtin_amdgcn_mfma_f32_32x32x16_bf16(kf[1],qr[0],negm,0,0,0), P0[6],P0[7],P0[8],P0[9],     pw0[2]=PKW(P0,4), pw0[3]=PKW(P0,6), pw0); \
    VRD(1); SBAR(); GAPA(C0=__builtin_amdgcn_mfma_f32_32x32x16_bf16(kf[2],qr[1],C0,0,0,0),   P0[10],P0[11],P0[12],P0[13], pw1[0]=PKW(P0,8), pw1[1]=PKW(P0,10), pw1); \
    VRD(5); SBAR(); GAPA(C1=__builtin_amdgcn_mfma_f32_32x32x16_bf16(kf[3],qr[1],C1,0,0,0),   P0[14],P0[15],P1[0],P1[1],   pw1[2]=PKW(P0,12),pw1[3]=PKW(P0,14), pw1); \
    VRD(2); SBAR(); GAPA(C0=__builtin_amdgcn_mfma_f32_32x32x16_bf16(kf[4],qr[2],C0,0,0,0),   P1[2],P1[3],P1[4],P1[5],     pw2[0]=PKW(P1,0), pw2[1]=PKW(P1,2), pw2); \
    VRD(6); SBAR(); GAPA(C1=__builtin_amdgcn_mfma_f32_32x32x16_bf16(kf[5],qr[2],C1,0,0,0),   P1[6],P1[7],P1[8],P1[9],     pw2[2]=PKW(P1,4), pw2[3]=PKW(P1,6), pw2); \
    VRD(3); SBAR(); GAPA(C0=__builtin_amdgcn_mfma_f32_32x32x16_bf16(kf[6],qr[3],C0,0,0,0),   P1[10],P1[11],P1[12],P1[13], pw3[0]=PKW(P1,8), pw3[1]=PKW(P1,10), pw3); \
    VRD(7); SBAR(); GAPA(C1=__builtin_amdgcn_mfma_f32_32x32x16_bf16(kf[7],qr[3],C1,0,0,0),   P1[14],P1[15],0.f,0.f,       pw3[2]=PKW(P1,12),pw3[3]=PKW(P1,14), pw3); \
    l_reg+=sacc; \
    if(GK){DMA_K((t)+3,sl_cur);} if(GV){DMA_V((t)+1,sl_next);} \
    CMASK(C0,C1,t); POST(C0,C1,t); \
    { float a=MX3(C0[0],C0[1],C1[0]),b=MX3(C0[2],C0[3],C1[1]); a=MX3(a,C1[2],C1[3]); \
      _Pragma("unroll") for(int r=4;r<16;r+=4){a=MX3(a,C0[r],C0[r+1]);b=MX3(b,C0[r+2],C0[r+3]);a=MX3(a,C1[r],C1[r+1]);b=MX3(b,C1[r+2],C1[r+3]);} \
      float rm=__builtin_fmaxf(a,b); { auto rr=__builtin_amdgcn_permlane32_swap(__float_as_uint(rm),__float_as_uint(rm),false,false); rm=__builtin_fmaxf(__uint_as_float(rr[0]),__uint_as_float(rr[1])); } \
      resc=false; \
      if(__builtin_expect(__any(rm>(float)THRL),0)){ const float dl=__builtin_fmaxf(rm,0.f); mhat+=dl; \
        _Pragma("unroll") for(int r=0;r<16;++r){C0[r]-=dl;C1[r]-=dl;} \
        const float f=__builtin_amdgcn_exp2f(-dl); l_reg*=f; if(hi==0)wsf[r32]=f; resc=true; } \
      if(KIND==1&&(resc||((tile0+(t)+1)&3)==0)) NEGM_SET((t)+1); } \
    SBAR(); \
    GAPB(o[0]=__builtin_amdgcn_mfma_f32_32x32x16_bf16(PAF(0),VFR(0),o[0],0,0,0), C0,0); \
    GAPB(o[1]=__builtin_amdgcn_mfma_f32_32x32x16_bf16(PAF(0),VFR(4),o[1],0,0,0), C0,4); \
    KRD(GL,0); GAPB(o[0]=__builtin_amdgcn_mfma_f32_32x32x16_bf16(PAF(1),VFR(1),o[0],0,0,0), C0,8); \
    KRD(GL,1); GAPB(o[1]=__builtin_amdgcn_mfma_f32_32x32x16_bf16(PAF(1),VFR(5),o[1],0,0,0), C0,12); \
    KRD(GL,2); GAPB(o[0]=__builtin_amdgcn_mfma_f32_32x32x16_bf16(PAF(2),VFR(2),o[0],0,0,0), C1,0); \
    KRD(GL,3); GAPB(o[1]=__builtin_amdgcn_mfma_f32_32x32x16_bf16(PAF(2),VFR(6),o[1],0,0,0), C1,4); \
    GAPB(o[0]=__builtin_amdgcn_mfma_f32_32x32x16_bf16(PAF(3),VFR(3),o[0],0,0,0), C1,8); \
    GAPB(o[1]=__builtin_amdgcn_mfma_f32_32x32x16_bf16(PAF(3),VFR(7),o[1],0,0,0), C1,12); \
    }while(0)
  int t=1;
  #undef CMASK
  #define CMASK(P0,P1,t) do{}while(0)
  for(;t+5<NT;t+=2){
    STEP(pB0,pB1,pA0,pA1,t,true,true,true);     WAIT_BAR(2); RESC(); ROT();
    STEP(pA0,pA1,pB0,pB1,t+1,true,true,true);   WAIT_BAR(2); RESC(); ROT();
  }
  #undef CMASK
  #define CMASK(P0,P1,t) do{int jb_=(t)-(NT-4); if(jb_>=0)cmask(P0,P1,jb_,qrel,hi);}while(0)
  #define ENDW(tt) do{ if((tt)+3<NT){WAIT_BAR(2);} else if((tt)+2<NT){WAIT_BAR(1);} else {WAIT_BAR(0);} }while(0)
  for(;t+1<NT;t+=2){
    STEP(pB0,pB1,pA0,pA1,t,(t+3<NT),(t+1<NT),(t+1<NT));       ENDW(t);   RESC(); ROT();
    STEP(pA0,pA1,pB0,pB1,t+1,(t+4<NT),(t+2<NT),(t+2<NT));     ENDW(t+1); RESC(); ROT();
  }
  STEP(pB0,pB1,pA0,pA1,NT-1,false,false,false); RESC();
  { float sacc=pB0[0]+pB0[1]; _Pragma("unroll") for(int r=2;r<16;++r)sacc+=pB0[r]; _Pragma("unroll") for(int r=0;r<16;++r)sacc+=pB1[r]; l_reg+=sacc;
    pw0=(u32x4){PKW(pB0,0),PKW(pB0,2),PKW(pB0,4),PKW(pB0,6)};pw1=(u32x4){PKW(pB0,8),PKW(pB0,10),PKW(pB0,12),PKW(pB0,14)};pw2=(u32x4){PKW(pB1,0),PKW(pB1,2),PKW(pB1,4),PKW(pB1,6)};pw3=(u32x4){PKW(pB1,8),PKW(pB1,10),PKW(pB1,12),PKW(pB1,14)};
    SBAR(); pv(o,vb0+sl_cur,PAF(0),PAF(1),PAF(2),PAF(3)); }
  #undef PKW
  #undef PAF
  #undef VFR
  #undef PIN
  #undef MX3
  #undef GAPA
  #undef GAPB
  #undef EX
  #undef VRD
  #undef KRD
  #undef STEP
  #undef ENDW
  {auto rr=__builtin_amdgcn_permlane32_swap(__float_as_uint(l_reg),__float_as_uint(l_reg),false,false);l_reg=__uint_as_float(rr[0])+__uint_as_float(rr[1]);}
  if(hi==0)wsf[32+r32]=l_reg;asm volatile("s_waitcnt lgkmcnt(0)":::"memory");
  float rli[16];
  #pragma unroll
  for(int r=0;r<16;++r)rli[r]=__builtin_amdgcn_rcpf(wsf[32+crow(r,hi)]);
  bf16*Ow=Og+(long)(wid*QBLK)*OPITCH;
  { bf16*stg=(bf16*)(shm+LDS_OST)+wid*2048;
    #pragma unroll
    for(int r=0;r<16;++r){const int orow=crow(r,hi);
      #pragma unroll
      for(int d0=0;d0<2;++d0)stg[orow*64+d0*32+r32]=__float2bfloat16(o[d0][r]*rli[r]);}
    asm volatile("s_waitcnt lgkmcnt(0)":::"memory");
    #pragma unroll
    for(int i=0;i<4;++i){const int row=i*8+(lane>>3),ch=lane&7; const u32x4 v=*(const u32x4*)(stg+row*64+ch*8); ATTN_STORE16(Ow+(long)row*OPITCH+ch*8,v);} }
  asm volatile("s_waitcnt lgkmcnt(0)\n\ts_barrier":::"memory");
  #undef DMA_K
  #undef DMA_V
  #undef CMASK
  #undef START
  #undef RESC
  #undef ROT
  #undef POST
  #undef NEGM_SET
  #undef CFENCE
}
constexpr int ATTN_LDS_BYTES=LDS_BYTES;
#undef SBAR
#undef WAIT_BAR
}

#define GAS __attribute__((address_space(1)))
#define LAS __attribute__((address_space(3)))
typedef unsigned short bf16;
typedef unsigned v4u __attribute__((ext_vector_type(4)));
typedef float f32x4 __attribute__((ext_vector_type(4)));
typedef short bf16x8 __attribute__((ext_vector_type(8)));
typedef GAS unsigned gu32;
typedef GAS unsigned long long gu64;
#define RLX_AGENT __ATOMIC_RELAXED, __HIP_MEMORY_SCOPE_AGENT
#define LDS_WAIT() asm volatile("s_waitcnt lgkmcnt(0)" ::: "memory")
#define VM_WAIT() asm volatile("s_waitcnt vmcnt(0)" ::: "memory")
__device__ __forceinline__ unsigned long long rt() { return __builtin_amdgcn_s_memrealtime(); }

#define XB_TMO      128
#define XB_XCNT(j)  (256  + 64 * (j))
#define XB_XSUB(j)  (1280 + 64 * (j))
#define XB_XGEN(j)  (2304 + 64 * (j))
#define XB_TOP      3328
#define XB_TOPGEN   3392
#define XCD_BAR_WORDS 3456
#define XB_SPIN_CAP (1u << 18)

__device__ __forceinline__ unsigned xb_ld(unsigned* p)              { return __hip_atomic_load(p, __ATOMIC_RELAXED, __HIP_MEMORY_SCOPE_AGENT); }
__device__ __forceinline__ unsigned xb_add(unsigned* p, unsigned v) { return __hip_atomic_fetch_add(p, v, __ATOMIC_RELAXED, __HIP_MEMORY_SCOPE_AGENT); }
__device__ __forceinline__ unsigned xb_xcc_id() { return (unsigned)__builtin_amdgcn_s_getreg((3 << 11) | 20) & 0xFu; }
#define XB_SPIN(cond, bar) do { unsigned _sp = 0; while (cond) { __builtin_amdgcn_s_sleep(1); \
    if ((++_sp & 255u) == 0u) { if (xb_ld(&(bar)[XB_TMO])) break; if (_sp > XB_SPIN_CAP) { atomicAdd(&(bar)[XB_TMO], 1u); break; } } } } while (0)

struct XcdBarrier {
    unsigned* bar; unsigned x;
    unsigned total;
    volatile LAS unsigned* st;
};

__device__ __forceinline__ XcdBarrier xcd_barrier_post(unsigned* bar, volatile LAS unsigned* st, unsigned total) {
    XcdBarrier b; b.bar = bar; b.x = xb_xcc_id(); b.st = st; b.total = total;
    if (threadIdx.x == 0) (void)xb_add(&bar[XB_XCNT(b.x)], 1u);
    return b;
}
__device__ __forceinline__ void xcd_barrier_complete(unsigned* bar, unsigned x, unsigned& nloc, unsigned& nx, const unsigned G) {
    unsigned sum, cnt, mine, sp = 0u;
    for (;;) {
        sum = 0u; cnt = 0u; mine = 0u;
#pragma unroll
        for (unsigned j = 0; j < 16; ++j) { const unsigned c = xb_ld(&bar[XB_XCNT(j)]); sum += c; cnt += (c > 0u) ? 1u : 0u; mine = (j == x) ? c : mine; }
        if (sum == G) break;
        __builtin_amdgcn_s_sleep(1);
        if ((++sp & 255u) == 0u) { if (xb_ld(&bar[XB_TMO])) break; if (sp > XB_SPIN_CAP) { atomicAdd(&bar[XB_TMO], 1u); break; } }
    }
    nloc = mine > 0u ? mine : 1u; nx = cnt > 0u ? cnt : 1u;
}

__device__ __forceinline__ void xcd_barrier(const XcdBarrier& b) {
    asm volatile("s_waitcnt vmcnt(0)" ::: "memory");
    __syncthreads();
    if (threadIdx.x == 0) {
        unsigned* bar = b.bar;
        __builtin_amdgcn_s_waitcnt(0);
        unsigned nloc = b.st[0], nx = b.st[1];
        if (nloc == 0u) { xcd_barrier_complete(bar, b.x, nloc, nx, b.total); b.st[0] = nloc; b.st[1] = nx; }
        const unsigned old = xb_add(&bar[XB_XSUB(b.x)], 1u);
        const unsigned gen = old / nloc;
        if (old + 1u == (gen + 1u) * nloc) {
            __builtin_amdgcn_fence(__ATOMIC_RELEASE, "agent");
            asm volatile("s_waitcnt vmcnt(0)" ::: "memory");
            const unsigned og = xb_add(&bar[XB_TOP], 1u);
            const unsigned tg = og / nx;
            if (og + 1u == (tg + 1u) * nx) xb_add(&bar[XB_TOPGEN], 1u);
            else XB_SPIN(xb_ld(&bar[XB_TOPGEN]) == tg, bar);
            __builtin_amdgcn_fence(__ATOMIC_ACQUIRE, "agent");
            xb_add(&bar[XB_XGEN(b.x)], 1u);
            asm volatile("s_waitcnt vmcnt(0)" ::: "memory");
        } else {
            XB_SPIN(xb_ld(&bar[XB_XGEN(b.x)]) == gen, bar);
            __builtin_amdgcn_fence(__ATOMIC_ACQUIRE, "agent");
            asm volatile("s_waitcnt vmcnt(0)" ::: "memory");
        }
    }
    __syncthreads();
}

constexpr int NWAVES = 8;
constexpr int RING_OFF = 0, RING_BYTES = 131072;
constexpr int LDSCTL_OFF = RING_BYTES, MISC_OFF = LDSCTL_OFF + 320;
constexpr int LDS_BYTES = 147456;
constexpr int CW_TMO = 0, CW_CODE = 1, CW_Q = 1024, CW_BAR = 4096;
constexpr float PRUNE_TH = 36.f;
constexpr int AUX_OFF = 86016;
constexpr size_t CTL_ZERO_BYTES = 2 * MiB;
constexpr size_t WS_KM = 1 * MiB, KM_LAYER = 256 * 1024;
constexpr int NPH_LAYER = 7, NPH = 1 + DEPTH * NPH_LAYER;

__device__ __forceinline__ void transpose_item(const float* W, int ldsrc, int k0, int srccol0, float scale, const float* gk, bf16* dst, int ldd, LAS float* scr, int lane) {
    float t[32];
#pragma unroll
    for (int i = 0; i < 32; ++i) { const int kk = 2 * i + (lane >> 5); t[i] = W[(size_t)(k0 + kk) * ldsrc + srccol0 + (lane & 31)]; }
#pragma unroll
    for (int i = 0; i < 32; ++i) { const int kk = 2 * i + (lane >> 5); scr[kk * 33 + (lane & 31)] = t[i] * (gk ? scale * gk[k0 + kk] : scale); }
    LDS_WAIT(); asm volatile("" ::: "memory");
    const int c = lane & 7;
#pragma unroll
    for (int j = 0; j < 4; ++j) { const int n = (lane >> 3) + 8 * j; const LAS float* s = scr + (8 * c) * 33 + n;
        v4u o; o.x = pk2(s[0 * 33], s[1 * 33]); o.y = pk2(s[2 * 33], s[3 * 33]); o.z = pk2(s[4 * 33], s[5 * 33]); o.w = pk2(s[6 * 33], s[7 * 33]);
        *(GAS v4u*)(dst + (size_t)n * ldd + k0 + 8 * c) = o; }
    LDS_WAIT(); asm volatile("" ::: "memory");
}

__device__ __forceinline__ float u2f(const unsigned u) { return __builtin_bit_cast(float, u); }
__device__ __forceinline__ void unpack8(const u32x4 w, float* f) {
    f[0] = __builtin_bit_cast(float, w.x << 16); f[1] = __builtin_bit_cast(float, w.x & 0xffff0000u); f[2] = __builtin_bit_cast(float, w.y << 16); f[3] = __builtin_bit_cast(float, w.y & 0xffff0000u);
    f[4] = __builtin_bit_cast(float, w.z << 16); f[5] = __builtin_bit_cast(float, w.z & 0xffff0000u); f[6] = __builtin_bit_cast(float, w.w << 16); f[7] = __builtin_bit_cast(float, w.w & 0xffff0000u);
}
__device__ __forceinline__ u32x4 pack8(const float* f) { u32x4 w; w.x = pk2(f[0], f[1]); w.y = pk2(f[2], f[3]); w.z = pk2(f[4], f[5]); w.w = pk2(f[6], f[7]); return w; }
__device__ __forceinline__ f32x4 ld4(const float* p) { return *(const f32x4*)p; }
__device__ __forceinline__ f32x4 ld4(const LAS float* p) { return *(const LAS f32x4*)p; }
template <bool RF32, bool XF32, class WFP>
__device__ __forceinline__ void rows_compute(const u32x4 (&cr)[4], const u32x4 (&cy)[2], const float rin, const int m, const int lane, const bool has_y, const float (&gp)[16], void* xout, const bool norm_out, float* rs, WFP WF, const bool has_wf, const float bfl, float* logf) {
    float v[16];
    if (RF32) {
#pragma unroll
        for (int q = 0; q < 4; ++q) { v[4 * q] = u2f(cr[q].x); v[4 * q + 1] = u2f(cr[q].y); v[4 * q + 2] = u2f(cr[q].z); v[4 * q + 3] = u2f(cr[q].w); }
    } else { unpack8(cr[0], v); unpack8(cr[1], v + 8); }
#pragma unroll
    for (int i = 0; i < 16; ++i) v[i] *= rin;
    if (has_y) { float yv[16]; unpack8(cy[0], yv); unpack8(cy[1], yv + 8); float ss = 0.f;
#pragma unroll
        for (int i = 0; i < 16; ++i) ss += yv[i] * yv[i];
        const float r = __builtin_amdgcn_rsqf(wave_sum(ss) * (1.f / DM) + RMS_EPS);
#pragma unroll
        for (int i = 0; i < 16; ++i) v[i] += yv[i] * r * gp[i]; }
    float r = 1.f;
    if (norm_out || has_wf) { float ss = 0.f;
#pragma unroll
        for (int i = 0; i < 16; ++i) ss += v[i] * v[i];
        const float ms = wave_sum(ss) * (1.f / DM) + RMS_EPS; r = __builtin_amdgcn_rsqf(ms);
        if (rs && lane == 0) rs[m] = __builtin_amdgcn_sqrtf(ms); }
    if (xout) {
        float w[16];
#pragma unroll
        for (int i = 0; i < 16; ++i) w[i] = norm_out ? v[i] * r : v[i];
        if (XF32) { f32x4* o = (f32x4*)((float*)xout + (size_t)m * DM + 8 * lane); o[0] = (f32x4){w[0], w[1], w[2], w[3]}; o[1] = (f32x4){w[4], w[5], w[6], w[7]}; o[128] = (f32x4){w[8], w[9], w[10], w[11]}; o[129] = (f32x4){w[12], w[13], w[14], w[15]}; }
        else { u32x4* o = (u32x4*)((bf16*)xout + (size_t)m * DM + 8 * lane); o[0] = pack8(w); o[64] = pack8(w + 8); } }
    {
        if (has_wf) {
            float d[8];
#pragma unroll
            for (int h = 0; h < 8; ++h) { d[h] = 0.f;
                if (h < NH) {
#pragma unroll
                    for (int q = 0; q < 4; ++q) { const f32x4 w = ld4(WF + ((h * 4 + q) * 64 + lane) * 4); d[h] += (v[4 * q] * w.x + v[4 * q + 1] * w.y) + (v[4 * q + 2] * w.z + v[4 * q + 3] * w.w); } } }
            const bool b0 = lane & 1, b1 = lane & 2, b2 = lane & 4;
            float e4[4], e2[2];
#pragma unroll
            for (int j = 0; j < 4; ++j) { const float snd = b0 ? d[j] : d[j + 4], kp = b0 ? d[j + 4] : d[j]; e4[j] = kp + __shfl_xor(snd, 1); }
#pragma unroll
            for (int j = 0; j < 2; ++j) { const float snd = b1 ? e4[j] : e4[j + 2], kp = b1 ? e4[j + 2] : e4[j]; e2[j] = kp + __shfl_xor(snd, 2); }
            float e = (b2 ? e2[1] : e2[0]) + __shfl_xor(b2 ? e2[0] : e2[1], 4);
            e += __shfl_xor(e, 8); e += __shfl_xor(e, 16); e += __shfl_xor(e, 32);
            const int hh = 4 * (lane & 1) + 2 * ((lane >> 1) & 1) + ((lane >> 2) & 1);
            if (lane < 8 && hh < NH) logf[(size_t)m * NH + hh] = e * r + bfl; } }
}
template <bool RF32, bool XF32, class WFP>
__device__ __forceinline__ void rows_phase(const int gw, const int NGW, const int MEND, const int lane,     const void* resid, const float* rs_in, const bf16* y, const float* gpost, void* xout, const bool norm_out, float* rs, WFP WF, const bool has_wf, const float* bfv, float* logf) {
    float gp[16];
#pragma unroll
    for (int j = 0; j < 2; ++j)
#pragma unroll
        for (int c = 0; c < 2; ++c) { const int e = 8 * lane + 512 * j + 4 * c;
            const f32x4 a = y ? *(const f32x4*)(gpost + e) : (f32x4){0.f, 0.f, 0.f, 0.f};
#pragma unroll
            for (int i = 0; i < 4; ++i) gp[8 * j + 4 * c + i] = a[i]; }
    const int hh_ = 4 * (lane & 1) + 2 * ((lane >> 1) & 1) + ((lane >> 2) & 1);
    const float bfl = (has_wf && lane < 8 && hh_ < NH) ? bfv[hh_] : 0.f;
    const bool has_y = (y != nullptr);
    u32x4 r0[4], y0[2], r1[4], y1[2], r2[4], y2[2], r3[4], y3[2], r4[4], y4[2]; float s0 = 1.f, s1 = 1.f, s2 = 1.f, s3 = 1.f, s4 = 1.f;
#define ROWS_LOAD(R, Y, SC, m_) do { if (rs_in) SC = rs_in[(m_)]; \
        if (RF32) { const u32x4* p_ = (const u32x4*)((const float*)resid + (size_t)(m_) * DM + 8 * lane); R[0] = p_[0]; R[1] = p_[1]; R[2] = p_[128]; R[3] = p_[129]; } \
        else { const u32x4* p_ = (const u32x4*)((const bf16*)resid + (size_t)(m_) * DM + 8 * lane); R[0] = p_[0]; R[1] = p_[64]; } \
        if (has_y) { const u32x4* q_ = (const u32x4*)(y + (size_t)(m_) * DM + 8 * lane); Y[0] = q_[0]; Y[1] = q_[64]; } } while (0)
#define ROWS_DO(R, Y, SC, m_) rows_compute<RF32, XF32, WFP>(R, Y, SC, (m_), lane, has_y, gp, xout, norm_out, rs, WF, has_wf, bfl, logf)
#define RFENCE() asm volatile("" ::: "memory")
    int m = gw;
    if (m + 3 * NGW < MEND) {
        ROWS_LOAD(r0, y0, s0, m); ROWS_LOAD(r1, y1, s1, m + NGW); ROWS_LOAD(r2, y2, s2, m + 2 * NGW); ROWS_LOAD(r3, y3, s3, m + 3 * NGW); RFENCE();
        for (; m + 8 * NGW < MEND; m += 5 * NGW) {
            ROWS_LOAD(r4, y4, s4, m + 4 * NGW); RFENCE(); ROWS_DO(r0, y0, s0, m); RFENCE();
            ROWS_LOAD(r0, y0, s0, m + 5 * NGW); RFENCE(); ROWS_DO(r1, y1, s1, m + NGW); RFENCE();
            ROWS_LOAD(r1, y1, s1, m + 6 * NGW); RFENCE(); ROWS_DO(r2, y2, s2, m + 2 * NGW); RFENCE();
            ROWS_LOAD(r2, y2, s2, m + 7 * NGW); RFENCE(); ROWS_DO(r3, y3, s3, m + 3 * NGW); RFENCE();
            ROWS_LOAD(r3, y3, s3, m + 8 * NGW); RFENCE(); ROWS_DO(r4, y4, s4, m + 4 * NGW); RFENCE();
        }
        if (m + 4 * NGW < MEND) ROWS_LOAD(r4, y4, s4, m + 4 * NGW);
        RFENCE(); ROWS_DO(r0, y0, s0, m); RFENCE();
        if (m + 5 * NGW < MEND) ROWS_LOAD(r0, y0, s0, m + 5 * NGW);
        RFENCE(); ROWS_DO(r1, y1, s1, m + NGW); RFENCE();
        if (m + 6 * NGW < MEND) ROWS_LOAD(r1, y1, s1, m + 6 * NGW);
        RFENCE(); ROWS_DO(r2, y2, s2, m + 2 * NGW); RFENCE();
        if (m + 7 * NGW < MEND) ROWS_LOAD(r2, y2, s2, m + 7 * NGW);
        RFENCE(); ROWS_DO(r3, y3, s3, m + 3 * NGW); RFENCE();
        if (m + 4 * NGW < MEND) ROWS_DO(r4, y4, s4, m + 4 * NGW);
        if (m + 5 * NGW < MEND) ROWS_DO(r0, y0, s0, m + 5 * NGW);
        if (m + 6 * NGW < MEND) ROWS_DO(r1, y1, s1, m + 6 * NGW);
        if (m + 7 * NGW < MEND) ROWS_DO(r2, y2, s2, m + 7 * NGW);
        m = MEND;
    }
    for (; m < MEND; m += NGW) { ROWS_LOAD(r0, y0, s0, m); ROWS_DO(r0, y0, s0, m); }
#undef ROWS_LOAD
#undef ROWS_DO
#undef RFENCE
}

struct Args { const float* in[13]; float* out; unsigned char* ws; int ph_lo, ph_hi, li, pad; };

__global__ void __launch_bounds__(NWAVES * 64, 2) mk_fwd(Args args) {
    extern __shared__ __attribute__((aligned(16))) unsigned char lds[];
    LAS unsigned char* L = (LAS unsigned char*)lds;
    volatile LAS unsigned* MISC = (volatile LAS unsigned*)(L + MISC_OFF);
    constexpr int MH = M / 2, BH = BATCH / 2;
    const int GA = gridDim.x; const int bxa = blockIdx.x; const int half = (bxa >> 2) & 1;
    const int G = GA / 2, bx = (bxa & 3) + 4 * (bxa >> 3);
    const int vcu = (bx % 4) * (G / 4) + bx / 4;
    const int NGW = G * NWAVES;
#define PHASE_IDS() int tid_ = threadIdx.x; asm volatile("" : "+v"(tid_)); const int tid = tid_, lane = tid & 63, wave = __builtin_amdgcn_readfirstlane(tid >> 6), gw = vcu * NWAVES + wave; (void)tid; (void)lane; (void)gw
    unsigned char* ws = args.ws;
    gu32* ctl = (gu32*)(ws + WS_CTL);
    for (int u = threadIdx.x; u < (LDS_BYTES - LDSCTL_OFF) / 4; u += NWAVES * 64) ((LAS unsigned*)(L + LDSCTL_OFF))[u] = 0u;
    __syncthreads();
    XcdBarrier barF = xcd_barrier_post((unsigned*)(ctl + CW_BAR), MISC + 8, (unsigned)GA);
    XcdBarrier bar = xcd_barrier_post((unsigned*)(ctl + CW_BAR) + (1 + half) * XCD_BAR_WORDS, MISC + 10, (unsigned)G);
    const int lo = args.ph_lo, hi = args.ph_hi;
#define IN(k) (lo <= (k) && (k) < hi)
#define SEAM(k) do { if (IN(k) && IN((k) + 1)) xcd_barrier(bar); } while (0)
    const float* x = args.in[0]; const float* w_in = args.in[1]; const float* b_f = args.in[2]; const float* conv_w = args.in[3];
    const float* w_out = args.in[4]; const float* rel_bias = args.in[5]; const float* g_pre_mix = args.in[6]; const float* g_post_mix = args.in[7];
    const float* g_pre_ffn = args.in[8]; const float* g_post_ffn = args.in[9]; const float* w_gate = args.in[10]; const float* w_up = args.in[11]; const float* w_down = args.in[12];
    float* out = args.out + (size_t)half * MH * DM; x += (size_t)half * MH * DM;
    float* LOGF = (float*)(ws + WS_LOGF) + (size_t)half * MH * NH; float* RS = (float*)(ws + WS_KMEAN) + (size_t)half * MH; float* KNP = (float*)(ws + WS_CUM) + (size_t)half * BH * NH * 64 * 2;
    bf16* XN = (bf16*)(ws + WS_XN) + (size_t)half * MH * DM; bf16* MIXIN = (bf16*)(ws + WS_MIXIN) + (size_t)half * MH * DM; bf16* XA = (bf16*)(ws + WS_XA) + (size_t)half * MH * DM; bf16* Y = (bf16*)(ws + WS_XA + 64 * MiB) + (size_t)half * MH * DM;
    bf16* P = (bf16*)(ws + WS_P) + (size_t)half * MH * PW; bf16* H = (bf16*)(ws + WS_H) + (size_t)half * MH * DFF;

    if (IN(0)) { PHASE_IDS();
      if (half == 0) {
        LAS float* scr = (LAS float*)(L + RING_OFF + wave * 16384);
        constexpr int I_IN = (PW / 32) * (DM / 64), I_OUT = (DM / 32) * (DM / 64), I_GU = (NGU / 32) * (DM / 64), I_D = (DM / 32) * (DFF / 64), I_L = I_IN + I_OUT + I_GU + I_D;
        for (int it = gw; it < DEPTH * I_L; it += NGW) {
            const int l = it / I_L; int r = it % I_L;
            unsigned char* wl = ws + WS_W + (size_t)l * W_LAYER;
            if (r < I_IN) { const int kb = r / (PW / 32), pb = r % (PW / 32), p0 = pb * 32; const int src = p0 < 2304 ? p0 : p0 + 6;
                const float sc = (p0 < 384 || (p0 >= 1152 && p0 < 1536)) ? C2 : 1.f;
                transpose_item(w_in + (size_t)l * DM * INW, INW, kb * 64, src, sc, g_pre_mix + (size_t)l * DM, (bf16*)(wl + WO_IN) + (size_t)p0 * DM, DM, scr, lane); continue; }
            r -= I_IN;
            if (r < I_OUT) { const int kb = r / (DM / 32), pb = r % (DM / 32);
                transpose_item(w_out + (size_t)l * DM * DM, DM, kb * 64, pb * 32, 1.f, nullptr, (bf16*)(wl + WO_OUT) + (size_t)pb * 32 * DM, DM, scr, lane); continue; }
            r -= I_OUT;
            if (r < I_GU) { const int kb = r / (NGU / 32), pb = r % (NGU / 32), r0 = pb * 32; const int pn = r0 >> 8, bj = (r0 >> 7) & 1, j = r0 & 127;
                transpose_item((bj ? w_up : w_gate) + (size_t)l * DM * DFF, DFF, kb * 64, pn * 128 + j, 1.f, g_pre_ffn + (size_t)l * DM, (bf16*)(wl + WO_GU) + (size_t)r0 * DM, DM, scr, lane); continue; }
            r -= I_GU;
            { const int kb = r / (DM / 32), pb = r % (DM / 32);
                transpose_item(w_down + (size_t)l * DFF * DM, DM, kb * 64, pb * 32, 1.f, nullptr, (bf16*)(wl + WO_D) + (size_t)pb * 32 * DFF, DFF, scr, lane); }
        }
        for (int i = gw * 64 + lane; i < DEPTH * NH * DM; i += NGW * 64) { const int l = i / (NH * DM), r = i % (NH * DM), h = r / DM, q = (r >> 8) & 3, ln = (r >> 2) & 63, k = 8 * ln + 512 * (q >> 1) + 4 * (q & 1) + (r & 3);
            ((float*)(ws + WS_W + (size_t)l * W_LAYER + WO_F))[r] = w_in[(size_t)l * DM * INW + (size_t)k * INW + 2304 + h] * g_pre_mix[(size_t)l * DM + k]; }
      } else {
        __syncthreads();
        { LAS float* wfl = (LAS float*)(L + RING_OFF + 4096);
          for (int i = tid; i < NH * DM; i += NWAVES * 64) { const int k = i / NH, h = i % NH, ln = (k & 511) >> 3, q = 2 * (k >> 9) + ((k >> 2) & 1); wfl[((h * 4 + q) * 64 + ln) * 4 + (k & 3)] = w_in[(size_t)k * INW + 2304 + h] * g_pre_mix[k]; }
          __syncthreads();
          rows_phase<true, false, const LAS float*>(gw, NGW, MH, lane, x, nullptr, nullptr, nullptr, XN, true, nullptr, (const LAS float*)wfl, true, b_f, LOGF); }
      }
      xcd_barrier(barF);
      if (half == 0) {
        __syncthreads();
        { LAS float* wfl = (LAS float*)(L + RING_OFF + 4096);
          for (int i = tid; i < NH * DM; i += NWAVES * 64) { const int k = i / NH, h = i % NH, ln = (k & 511) >> 3, q = 2 * (k >> 9) + ((k >> 2) & 1); wfl[((h * 4 + q) * 64 + ln) * 4 + (k & 3)] = w_in[(size_t)k * INW + 2304 + h] * g_pre_mix[k]; }
          __syncthreads();
          rows_phase<true, false, const LAS float*>(gw, NGW, MH, lane, x, nullptr, nullptr, nullptr, XN, true, nullptr, (const LAS float*)wfl, true, b_f, LOGF); }
        xcd_barrier(bar);
      }
    }
    for (int l = 0; l < DEPTH; ++l) {
        const int pb = 1 + l * NPH_LAYER;
        unsigned char* wl = ws + WS_W + (size_t)l * W_LAYER;
        const bf16* Win_t = (const bf16*)(wl + WO_IN); const bf16* Wout_t = (const bf16*)(wl + WO_OUT); const bf16* Wgu_t = (const bf16*)(wl + WO_GU); const bf16* Wd_t = (const bf16*)(wl + WO_D);
        const bool last = (l == DEPTH - 1);
        float* KM = (float*)(ws + WS_CTL + WS_KM + (size_t)l * KM_LAYER) + (size_t)half * BH * NH * NBLK * HD;
        if (IN(pb + 0)) { PHASE_IDS();
            for (int e = vcu * (NWAVES * 64) + tid; e < MH * NH; e += G * NWAVES * 64) LOGF[e] = log_sigmoid(LOGF[e]);
            pg8::Gemm g{l == 0 ? XN : XA, Win_t, MH, PW, DM}; pg8::StaticOrder S; S.init(MH, PW, G, bx);
            pg8::EpiInProj E{P, PW, KM, KNP};
            pg8::gemm_phase<pg8::EpiInProj, pg8::StaticOrder, true, true>(L + RING_OFF, g, S, E);
        }
        SEAM(pb + 0);
        if (IN(pb + 1)) { PHASE_IDS();
            constexpr int NATT = 2 * BH * NH * NBLK, NCONV = MH / 128, NUNITS = NATT + NCONV;
            char* shm = (char*)lds + RING_OFF;
            attn_body::lds_cptr aux = (attn_body::lds_cptr)(L + AUX_OFF);
            LAS float* auxR0 = (LAS float*)(L + AUX_OFF + attn_body::AUX_R0); LAS unsigned* auxInfo = (LAS unsigned*)(L + AUX_OFF + attn_body::AUX_INFO); LAS float* auxTab = (LAS float*)(L + AUX_OFF + attn_body::AUX_TAB);
            LAS float* wtot = (LAS float*)(L + AUX_OFF + attn_body::AUX_TAB + 16384);
            const float* cw = conv_w + (size_t)l * 3 * CCH;
            int idx = bx, iter = 0; unsigned nA = (unsigned)(bx + G);
            while (idx < NUNITS) {
                if (tid == 0) { MISC[16 + ((iter + 1) & 1)] = nA; nA = __hip_atomic_fetch_add(ctl + CW_Q + 64 * (2 * l + half), 1u, RLX_AGENT) + 2u * (unsigned)G; }
                int tq = threadIdx.x; asm volatile("" : "+v"(tq));
                if (idx < NATT) {
                const int kind = idx < NATT / 2 ? 1 : 0, ia = idx - (kind ? 0 : NATT / 2), qb = (NBLK - 1) - ia / (BH * NH), bh = ia % (BH * NH), b = bh / NH, h = bh % NH;
                const int q0 = qb * MBLK; const size_t row0 = (size_t)b * SEQ;
                const int prow = tq >> 1, half = tq & 1;
                const int cq = kind == 0 ? P_FQ : P_MQ, ck = kind == 0 ? P_FK : P_MK, cv = kind == 0 ? P_FV : P_MV;
                const bf16* Qg = P + (row0 + q0) * PW + cq + h * HD; const bf16* Kb = P + row0 * PW + ck + h * HD; const bf16* Vb = P + row0 * PW + cv + h * HD;
                bf16* Og = MIXIN + (row0 + q0) * DM + (kind == 0 ? 384 : 0) + h * HD;
                int tile0 = 0;
                if (kind == 0) {
                    const int k0 = tile0 * 64, kend = q0 + MBLK, kb = k0 + 8 * tq;
                    float loc[8]; float run = 0.f;
#pragma unroll
                    for (int i = 0; i < 8; ++i) { const int key = kb + i; const float v = key < kend ? LOGF[(row0 + key) * NH + h] : 0.f; run += v; loc[i] = run; }
                    float incl = run;
#pragma unroll
                    for (int o = 1; o < 64; o <<= 1) { const float t = __shfl_up(incl, o); if ((tq & 63) >= o) incl += t; }
                    if ((tq & 63) == 63) wtot[tq >> 6] = incl;
                    __syncthreads();
                    float off = incl - run; for (int w = 0; w < (tq >> 6); ++w) off += wtot[w];
#pragma unroll
                    for (int i = 0; i < 8; ++i) { const int key = kb + i; if (key < kend) auxTab[key] = (off + loc[i]) * LOG2E; }
                } else {
                    const float bfar = rel_bias[31 * NH + h];
                    if (tq <= 128) auxTab[tq] = (rel_bias[c_bucket[tq] * NH + h] - bfar) * LOG2E;
                    for (int i = tq; i < qb * HD; i += NWAVES * 64) auxTab[256 + i] = KM[(size_t)bh * NBLK * HD + i];
                }
                __syncthreads();
                if (kind == 0) {
                    const bf16* qp = Qg + (size_t)prow * PW + half * 32; const bf16* kp = Kb + (size_t)(q0 + prow) * PW + half * 32; float d = 0.f, qq = 0.f;
#pragma unroll
                    for (int c = 0; c < 4; ++c) { const bf16x8 qv = *(const bf16x8*)(qp + 8 * c), kv = *(const bf16x8*)(kp + 8 * c);
#pragma unroll
                        for (int j = 0; j < 8; ++j) { const float qf = bf2f((unsigned short)qv[j]); d += qf * bf2f((unsigned short)kv[j]); qq += qf * qf; } }
                    d += __shfl_xor(d, 1); qq += __shfl_xor(qq, 1);
                    float u2 = (auxTab[q0 + prow] - auxTab[q0]) - d;
#pragma unroll
                    for (int o = 2; o < 64; o <<= 1) { qq = fmaxf(qq, __shfl_xor(qq, o)); u2 = fmaxf(u2, __shfl_xor(u2, o)); }
                    if ((tq & 63) == 0) { wtot[8 + (tq >> 6)] = qq; wtot[16 + (tq >> 6)] = u2; }
                    if (tq == 0) ((LAS unsigned*)wtot)[24] = (unsigned)(4 * qb);
                    __syncthreads();
                    float U1 = wtot[8], U2 = wtot[16];
#pragma unroll
                    for (int w = 1; w < 8; ++w) { U1 = fmaxf(U1, wtot[8 + w]); U2 = fmaxf(U2, wtot[16 + w]); }
                    U1 = sqrtf(U1) * 1.0001f;
                    if (tq < 4 * qb) { const float* kn = KNP + ((size_t)bh * 64 + tq) * 2; const float bound = U1 * sqrtf(kn[0] + kn[1]) + U2 + (auxTab[q0] - auxTab[64 * tq + 63]);
                        if (!(bound <= -PRUNE_TH)) __hip_atomic_fetch_min((LAS unsigned*)wtot + 24, (unsigned)tq, __ATOMIC_RELAXED, __HIP_MEMORY_SCOPE_WORKGROUP); }
                    __syncthreads();
                    tile0 = (int)(((LAS unsigned*)wtot)[24] & ~1u);
                }
                {   const bf16* qp = Qg + (size_t)prow * PW + half * 32; const bf16* kp = Kb + (size_t)(q0 + prow) * PW + half * 32; float q[32]; float d = 0.f;
#pragma unroll
                    for (int c = 0; c < 4; ++c) { const bf16x8 qv = *(const bf16x8*)(qp + 8 * c), kv = *(const bf16x8*)(kp + 8 * c);
#pragma unroll
                        for (int j = 0; j < 8; ++j) { q[8 * c + j] = bf2f((unsigned short)qv[j]); d += q[8 * c + j] * bf2f((unsigned short)kv[j]); } }
                    d += __shfl_xor(d, 1);
                    if (kind == 0) { if (half == 0) { auxR0[prow] = d - auxTab[q0 + prow]; auxInfo[prow] = 0u; } }
                    else {
                        int s0 = -1, s1 = -1, s2 = -1; float g0 = -INFINITY, g1 = -INFINITY, g2 = -INFINITY;
                        for (int n = 0; n < qb; ++n) { const LAS f32x4* km = (const LAS f32x4*)(auxTab + 256 + n * HD + half * 32); float g = 0.f;
#pragma unroll
                            for (int j = 0; j < 8; ++j) { const f32x4 kk = km[j]; g += (q[4 * j] * kk.x + q[4 * j + 1] * kk.y) + (q[4 * j + 2] * kk.z + q[4 * j + 3] * kk.w); }
                            g += __shfl_xor(g, 1);
                            if (g > g0) { g2 = g1; s2 = s1; g1 = g0; s1 = s0; g0 = g; s0 = n; } else if (g > g1) { g2 = g1; s2 = s1; g1 = g; s1 = n; } else if (g > g2) { g2 = g; s2 = n; } }
                        unsigned msk = 0u; if (s0 >= 0) msk |= 1u << s0; if (s1 >= 0) msk |= 1u << s1; if (s2 >= 0) msk |= 1u << s2;
                        if (half == 0) { auxR0[prow] = d + auxTab[0]; auxInfo[prow] = msk; }
                    }
                }
                __syncthreads();
                if (kind == 0) attn_body::attn_unit<0, 8>((const attn_body::bf16*)Qg, (const attn_body::bf16*)(Kb + (size_t)tile0 * 64 * PW), (const attn_body::bf16*)(Vb + (size_t)tile0 * 64 * PW), (attn_body::bf16*)Og, 4 * (qb + 1) - tile0, tile0, q0, qb, shm, aux);
                else attn_body::attn_unit<1, 8>((const attn_body::bf16*)Qg, (const attn_body::bf16*)Kb, (const attn_body::bf16*)Vb, (attn_body::bf16*)Og, 4 * (qb + 1), 0, q0, qb, shm, aux);
                } else {
                    const int cg = tq & 31, rg = tq >> 5; const size_t r0 = (size_t)(idx - NATT) * 128 + rg * 8; const int c0 = cg * 8;
                    float w0[8], w1[8], w2[8], u2[8], u1[8];
#pragma unroll
                    for (int j = 0; j < 8; ++j) { w0[j] = cw[c0 + j]; w1[j] = cw[CCH + c0 + j]; w2[j] = cw[2 * CCH + c0 + j]; u2[j] = 0.f; u1[j] = 0.f; }
                    if ((r0 % SEQ) != 0) {
                        const bf16x8 a2 = *(const bf16x8*)(P + (r0 - 2) * PW + P_CC + c0), h2 = *(const bf16x8*)(P + (r0 - 2) * PW + P_CH + c0);
                        const bf16x8 a1 = *(const bf16x8*)(P + (r0 - 1) * PW + P_CC + c0), h1 = *(const bf16x8*)(P + (r0 - 1) * PW + P_CH + c0);
#pragma unroll
                        for (int j = 0; j < 8; ++j) { u2[j] = bf2f((unsigned short)a2[j]) * bf2f((unsigned short)h2[j]); u1[j] = bf2f((unsigned short)a1[j]) * bf2f((unsigned short)h1[j]); }
                    }
#pragma unroll
                    for (int rr = 0; rr < 8; ++rr) { const size_t m = r0 + rr;
                        const bf16x8 a = *(const bf16x8*)(P + m * PW + P_CC + c0), hh = *(const bf16x8*)(P + m * PW + P_CH + c0), bb = *(const bf16x8*)(P + m * PW + P_CB + c0);
                        float o8[8];
#pragma unroll
                        for (int j = 0; j < 8; ++j) { const float u0 = bf2f((unsigned short)a[j]) * bf2f((unsigned short)hh[j]); o8[j] = bf2f((unsigned short)bb[j]) * (w0[j] * u2[j] + w1[j] * u1[j] + w2[j] * u0); u2[j] = u1[j]; u1[j] = u0; }
                        u32x4 w; w.x = pk2(o8[0], o8[1]); w.y = pk2(o8[2], o8[3]); w.z = pk2(o8[4], o8[5]); w.w = pk2(o8[6], o8[7]);
                        *(u32x4*)(MIXIN + m * DM + 768 + c0) = w; }
                    __syncthreads();
                }
                idx = (int)MISC[16 + ((iter + 1) & 1)]; ++iter;
            }
        }
        SEAM(pb + 1);
        if (IN(pb + 2)) { PHASE_IDS();
            pg8::Gemm g{MIXIN, Wout_t, MH, DM, DM}; pg8::StaticOrder S; S.init(MH, DM, G, bx);
            pg8::EpiStoreBf16 E{Y, DM};
            pg8::gemm_phase<pg8::EpiStoreBf16, pg8::StaticOrder, true, true>(L + RING_OFF, g, S, E);
        }
        SEAM(pb + 2);
        if (IN(pb + 3)) { PHASE_IDS();
            if (l == 0) rows_phase<true, false, const float*>(gw, NGW, MH, lane, x, nullptr, Y, g_post_mix + (size_t)l * DM, XA, true, RS, (const float*)nullptr, false, nullptr, nullptr);
            else rows_phase<false, false, const float*>(gw, NGW, MH, lane, XA, RS, Y, g_post_mix + (size_t)l * DM, XA, true, RS, (const float*)nullptr, false, nullptr, nullptr);
        }
        SEAM(pb + 3);
        if (IN(pb + 4)) { PHASE_IDS();
            pg8::Gemm g{XA, Wgu_t, MH, NGU, DM}; pg8::StaticOrder S; S.init(MH, NGU, G, bx);
            pg8::EpiSwiGLU E{H, DFF};
            pg8::gemm_phase<pg8::EpiSwiGLU, pg8::StaticOrder, true, true>(L + RING_OFF, g, S, E);
        }
        SEAM(pb + 4);
        if (IN(pb + 5)) { PHASE_IDS();
            pg8::Gemm g{H, Wd_t, MH, DM, DFF}; pg8::StaticOrder S; S.init(MH, DM, G, bx);
            pg8::EpiStoreBf16 E{Y, DM};
            pg8::gemm_phase<pg8::EpiStoreBf16, pg8::StaticOrder, true, true>(L + RING_OFF, g, S, E);
        }
        SEAM(pb + 5);
        if (IN(pb + 6)) { PHASE_IDS();
            if (!last) { const float* WFn = (const float*)(ws + WS_W + (size_t)(l + 1) * W_LAYER + WO_F);
                rows_phase<false, false, const float*>(gw, NGW, MH, lane, XA, RS, Y, g_post_ffn + (size_t)l * DM, XA, true, RS, WFn, true, b_f + (size_t)(l + 1) * NH, LOGF); }
            else rows_phase<false, true, const float*>(gw, NGW, MH, lane, XA, RS, Y, g_post_ffn + (size_t)l * DM, out, false, nullptr, (const float*)nullptr, false, nullptr, nullptr);
        }
        SEAM(pb + 6);
    }
#undef IN
#undef SEAM
}

extern "C" void kernel_launch(void* const* d_in, const int* in_sizes, int n_in, void* d_out, int out_size, void* d_ws, size_t ws_size, hipStream_t stream) {
    if (n_in != 13 || in_sizes[0] != M * DM || out_size != M * DM || ws_size < WS_END) { fprintf(stderr, "kernel_launch: unexpected shapes (n_in %d, in0 %d, out %d, ws %zu)\n", n_in, n_in > 0 ? in_sizes[0] : -1, out_size, ws_size); return; }
    static int grid = 0;
    if (grid == 0) {
        int dev = 0, cus = 0, per_cu = 0;
        if (hipGetDevice(&dev) != hipSuccess || hipDeviceGetAttribute(&cus, hipDeviceAttributeMultiprocessorCount, dev) != hipSuccess) { fprintf(stderr, "kernel_launch: device query failed\n"); grid = -1; return; }
        if (hipFuncSetAttribute((const void*)mk_fwd, hipFuncAttributeMaxDynamicSharedMemorySize, LDS_BYTES) != hipSuccess) { fprintf(stderr, "kernel_launch: hipFuncSetAttribute failed\n"); grid = -1; return; }
        if (hipOccupancyMaxActiveBlocksPerMultiprocessor(&per_cu, (const void*)mk_fwd, NWAVES * 64, LDS_BYTES) != hipSuccess || per_cu < 1) fprintf(stderr, "kernel_launch: occupancy query reports %d\n", per_cu);
        (void)hipGetLastError();
        if (cus % 16 != 0) { fprintf(stderr, "kernel_launch: %d CUs: the two half-batch streams need a multiple of 16; nothing launched\n", cus); grid = -1; return; }
        grid = cus;
    }
    if (grid < 0) return;
    if (hipMemsetAsync((char*)d_ws + WS_CTL, 0, CTL_ZERO_BYTES, stream) != hipSuccess) { fprintf(stderr, "kernel_launch: hipMemsetAsync of the control words failed; nothing launched\n"); return; }
    Args a{};
    for (int i = 0; i < 13; ++i) a.in[i] = (const float*)d_in[i];
    a.out = (float*)d_out; a.ws = (unsigned char*)d_ws;
    a.ph_lo = 0; a.ph_hi = NPH; a.li = 0;
    hipLaunchKernelGGL(mk_fwd, dim3(grid), dim3(NWAVES * 64), LDS_BYTES, stream, a);
}
```

```cpp
#include <hip/hip_runtime.h>
#include <cstdio>
#include <cstdint>

typedef unsigned short bf16;
typedef short bf16x8 __attribute__((ext_vector_type(8)));
typedef float f32x4 __attribute__((ext_vector_type(4)));
typedef unsigned u32x4 __attribute__((ext_vector_type(4)));
typedef unsigned u32x2 __attribute__((ext_vector_type(2)));

constexpr int DM = 1024, BATCH = 8, SEQ = 4096, DEPTH = 2, HD = 64, NH = 6, CCH = 256;
constexpr int M = BATCH * SEQ;
constexpr int INW = 3078, PW = 3072, DFF = 2816, NGU = 2 * DFF;
constexpr int MBLK = 256, NBLK = SEQ / MBLK;
constexpr float RMS_EPS = 1e-6f;
constexpr float LOG2E = 1.4426950408889634f;
constexpr float C2 = 0.125f * LOG2E;
constexpr int P_MQ = 0, P_MK = 384, P_MV = 768, P_FQ = 1152, P_FK = 1536, P_FV = 1920, P_CB = 2304, P_CC = 2560, P_CH = 2816;
constexpr size_t MiB = 1u << 20;
constexpr size_t WS_CTL = 0;
constexpr size_t WS_W = 2 * MiB, W_LAYER = 25 * MiB;
constexpr size_t WO_IN = 0, WO_OUT = 6 * MiB, WO_GU = 8 * MiB, WO_D = 19 * MiB, WO_F = 24 * MiB + 512 * 1024;
constexpr size_t WS_LOGF = 52 * MiB, WS_CUM = 53 * MiB, WS_KMEAN = 54 * MiB;
constexpr size_t WS_XN = 56 * MiB, WS_MIXIN = 120 * MiB, WS_XA = 184 * MiB, WS_P = 312 * MiB, WS_H = WS_P, WS_END = 504 * MiB;

__constant__ int c_bucket[129] = {0, 1, 2, 3, 4, 5, 6, 7, 8, 9, 10, 11, 12, 13, 14, 15, 16, 16, 16, 17, 17, 18, 18, 18, 19, 19, 19, 20, 20, 20, 20, 21, 21, 21, 21, 22, 22, 22, 22, 22, 23, 23, 23, 23, 23, 23, 24, 24, 24, 24, 24, 24, 25, 25, 25, 25, 25, 25, 25, 26, 26, 26, 26, 26, 26, 26, 26, 27, 27, 27, 27, 27, 27, 27, 27, 27, 27, 28, 28, 28, 28, 28, 28, 28, 28, 28, 28, 29, 29, 29, 29, 29, 29, 29, 29, 29, 29, 29, 29, 30, 30, 30, 30, 30, 30, 30, 30, 30, 30, 30, 30, 30, 30, 31, 31, 31, 31, 31, 31, 31, 31, 31, 31, 31, 31, 31, 31, 31, 31};

__device__ __forceinline__ unsigned f2bf(float f) { unsigned u = __builtin_bit_cast(unsigned, f); return (u + 0x7fffu + ((u >> 16) & 1u)) >> 16; }
typedef float f32x2v __attribute__((ext_vector_type(2))); typedef __bf16 bf16x2v __attribute__((ext_vector_type(2)));
__device__ __forceinline__ unsigned pk2(float lo, float hi) { const f32x2v v = {lo, hi}; const bf16x2v b = __builtin_convertvector(v, bf16x2v); return __builtin_bit_cast(unsigned, b); }
__device__ __forceinline__ float bf2f(unsigned short b) { return __builtin_bit_cast(float, (unsigned)b << 16); }
#define WS_DPP(v, ctrl, rm) (v) = (v) + __builtin_bit_cast(float, __builtin_amdgcn_update_dpp(0, __builtin_bit_cast(int, (v)), (ctrl), (rm), 0xf, false))
__device__ __forceinline__ float wave_sum(float v) {
    WS_DPP(v, 0xB1, 0xf); WS_DPP(v, 0x4E, 0xf); WS_DPP(v, 0x141, 0xf); WS_DPP(v, 0x140, 0xf); WS_DPP(v, 0x142, 0xa); WS_DPP(v, 0x143, 0xc);
    return __builtin_bit_cast(float, __builtin_amdgcn_readlane(__builtin_bit_cast(int, v), 63));
}

__device__ __forceinline__ float log_sigmoid(float z) { return z < 0.f ? z - log1pf(expf(z)) : -log1pf(expf(-z)); }
namespace pg8 {
#define PG8_LAS __attribute__((address_space(3)))
typedef unsigned short bf16_t;
typedef short bf16x8 __attribute__((ext_vector_type(8)));
typedef float f32x4 __attribute__((ext_vector_type(4)));
typedef unsigned u32x4 __attribute__((ext_vector_type(4)));
constexpr int BM = 256, BK = 64, HALF = 128, HTB = HALF * BK * 2  , STAGE_BYTES = 8 * HTB, NXCD = 8, WGM = 8;

__host__ __device__ __forceinline__ int lds_byte(int r, int c) { const int st = (r >> 4) * 2 + (c >> 5), rr = r & 15, cc = c & 31, ob = rr * 64 + cc * 2; return st * 1024 + (ob ^ (((ob >> 9) & 1) << 5)); }
__host__ __device__ __forceinline__ void stage_rc(int b, int& R, int& C) { const int st = b / 1024, sb = b % 1024, swz = sb ^ (((sb >> 9) & 1) << 5); R = (st >> 1) * 16 + swz / 64; C = (st & 1) * 32 + (swz % 64) / 2; }
__host__ __device__ __forceinline__ int perm32(int rho) { const int n = rho >> 4, i = rho & 15; return 8 * (i >> 2) + 4 * n + (i & 3); }

struct Unit { int pm, pn; };
struct Gemm { const bf16_t* A; const bf16_t* Bt; int M, N, K; };

struct StaticOrder {
    int nM, nN, nwg, G, c;
    __host__ __device__ void init(int M, int N, int G_, int c_) { nM = M / BM; nN = N / BM; nwg = nM * nN; G = G_; c = c_; }
    __host__ __device__ bool next(int i, Unit& u) const {
        const long L = (long)i * G + c; if (L >= nwg) return false;
        int wgid = (int)L; { const int q = nwg / NXCD, r = nwg % NXCD, xcd = wgid % NXCD, off = wgid / NXCD; wgid = (xcd < r ? xcd * (q + 1) : r * (q + 1) + (xcd - r) * q) + off; }
        const int nig = WGM * nN, gid = wgid / nig, fm = gid * WGM, gsz = (nM - fm) < WGM ? (nM - fm) : WGM;
        u.pm = fm + ((wgid % nig) % gsz); u.pn = (wgid % nig) / gsz; return true;
    }
    __device__ __forceinline__ void a_ready(const Unit&) const {}
    __device__ __forceinline__ void done(const Unit&) const {}
};
__device__ __forceinline__ unsigned cvt_pk_bf16(float lo, float hi) { unsigned r; asm volatile("v_cvt_pk_bf16_f32 %0, %1, %2" : "=v"(r) : "v"(lo), "v"(hi)); return r; }
typedef float f32x2 __attribute__((ext_vector_type(2)));
struct EpiStoreBf16 {
    static constexpr bool PERM = true, AFTER_DRAIN = false;
    bf16_t* O; int ldc;
    __device__ __forceinline__ void operator()(const f32x4 (&acc)[2][2][4][2], const Unit& u, int wr, int wc, int fr, int fq) const {
        const int row0 = u.pm * BM + wr * 64 + fr, col0 = u.pn * BM + wc * 32 + 8 * fq;
#pragma unroll
        for (int ai = 0; ai < 2; ++ai)
#pragma unroll
            for (int m = 0; m < 4; ++m) { bf16_t* rowp = O + (size_t)(row0 + ai * HALF + m * 16) * ldc + col0;
#pragma unroll
                for (int bj = 0; bj < 2; ++bj) { const f32x4 v0 = acc[ai][bj][m][0], v1 = acc[ai][bj][m][1];
                    u32x4 w; w.x = cvt_pk_bf16(v0[0], v0[1]); w.y = cvt_pk_bf16(v0[2], v0[3]); w.z = cvt_pk_bf16(v1[0], v1[1]); w.w = cvt_pk_bf16(v1[2], v1[3]);
                    *(u32x4*)(rowp + bj * HALF) = w; } }
    }
};
struct EpiStoreF32 {
    static constexpr bool PERM = false, AFTER_DRAIN = false;
    float* C; int ldc;
    __device__ __forceinline__ void operator()(const f32x4 (&acc)[2][2][4][2], const Unit& u, int wr, int wc, int fr, int fq) const {
        const int row0 = u.pm * BM + wr * 64 + fr, col0 = u.pn * BM + wc * 32 + 4 * fq;
#pragma unroll
        for (int ai = 0; ai < 2; ++ai)
#pragma unroll
            for (int m = 0; m < 4; ++m) { float* rowp = C + (size_t)(row0 + ai * HALF + m * 16) * ldc + col0;
#pragma unroll
                for (int bj = 0; bj < 2; ++bj)
#pragma unroll
                    for (int n = 0; n < 2; ++n) *(f32x4*)(rowp + bj * HALF + n * 16) = acc[ai][bj][m][n]; }
    }
};
__device__ __forceinline__ float silu_mul(float g, float u) { return g * __builtin_amdgcn_rcpf(1.0f + __builtin_amdgcn_exp2f(g * -1.4426950408889634f)) * u; }
struct EpiSwiGLU {
    static constexpr bool PERM = true, AFTER_DRAIN = false;
    bf16_t* O; int ldc;
    __device__ __forceinline__ void operator()(f32x4 (&acc)[2][2][4][2], const Unit& u, int wr, int wc, int fr, int fq) const {
        const int row0 = u.pm * BM + wr * 64 + fr, col0 = u.pn * HALF + wc * 32 + 8 * fq;
#pragma unroll
        for (int ai = 0; ai < 2; ++ai)
#pragma unroll
            for (int m = 0; m < 4; ++m) { bf16_t* rowp = O + (size_t)(row0 + ai * HALF + m * 16) * ldc + col0;
                const f32x4 g0 = acc[ai][0][m][0], g1 = acc[ai][0][m][1], u0 = acc[ai][1][m][0], u1 = acc[ai][1][m][1];
                u32x4 w; w.x = cvt_pk_bf16(silu_mul(g0[0], u0[0]), silu_mul(g0[1], u0[1])); w.y = cvt_pk_bf16(silu_mul(g0[2], u0[2]), silu_mul(g0[3], u0[3]));
                w.z = cvt_pk_bf16(silu_mul(g1[0], u1[0]), silu_mul(g1[1], u1[1])); w.w = cvt_pk_bf16(silu_mul(g1[2], u1[2]), silu_mul(g1[3], u1[3]));
                *(u32x4*)rowp = w; }
    }
};
struct EpiInProj {
    static constexpr bool PERM = true, AFTER_DRAIN = false;
    bf16_t* O; int ldc; float* kmean; float* knp;
    __device__ __forceinline__ void operator()(f32x4 (&acc)[2][2][4][2], const Unit& u, int wr, int wc, int fr, int fq) const {
        const int row0 = u.pm * BM + wr * 64 + fr, col0 = u.pn * BM + wc * 32 + 8 * fq;
#pragma unroll
        for (int ai = 0; ai < 2; ++ai)
#pragma unroll
            for (int m = 0; m < 4; ++m) { bf16_t* rowp = O + (size_t)(row0 + ai * HALF + m * 16) * ldc + col0;
#pragma unroll
                for (int bj = 0; bj < 2; ++bj) { const f32x4 v0 = acc[ai][bj][m][0], v1 = acc[ai][bj][m][1];
                    u32x4 w; w.x = cvt_pk_bf16(v0[0], v0[1]); w.y = cvt_pk_bf16(v0[2], v0[3]); w.z = cvt_pk_bf16(v1[0], v1[1]); w.w = cvt_pk_bf16(v1[2], v1[3]);
                    *(u32x4*)(rowp + bj * HALF) = w; } }
        if (u.pn == 6 || u.pn == 7) {
#pragma unroll
            for (int bj = 0; bj < 2; ++bj) {
                if (u.pn == 7 && bj == 1) continue;
                const int head = 4 * (u.pn - 6) + 2 * bj + (wc >> 1);
#pragma unroll
                for (int ai = 0; ai < 2; ++ai) { float mx = 0.f;
#pragma unroll
                    for (int m = 0; m < 4; ++m) { const f32x4 v0 = acc[ai][bj][m][0], v1 = acc[ai][bj][m][1];
                        float ss = (v0[0] * v0[0] + v0[1] * v0[1]) + (v0[2] * v0[2] + v0[3] * v0[3]) + (v1[0] * v1[0] + v1[1] * v1[1]) + (v1[2] * v1[2] + v1[3] * v1[3]);
                        ss += __shfl_xor(ss, 16); ss += __shfl_xor(ss, 32); mx = fmaxf(mx, ss); }
                    mx = fmaxf(mx, __shfl_xor(mx, 1)); mx = fmaxf(mx, __shfl_xor(mx, 2)); mx = fmaxf(mx, __shfl_xor(mx, 4)); mx = fmaxf(mx, __shfl_xor(mx, 8));
                    if (fr == 0 && fq == 0) knp[((size_t)((u.pm >> 4) * 6 + head) * 64 + ((u.pm & 15) * 4 + ai * 2 + wr)) * 2 + (wc & 1)] = mx * 1.02f; }
            }
        }
        if (u.pn == 1 || u.pn == 2) {
#pragma unroll
            for (int bj = 0; bj < 2; ++bj) {
                if (u.pn == 1 && bj == 0) continue;
                const int cp = u.pn * BM + bj * HALF + wc * 32 + 8 * fq - 384;
                float* dst = kmean + ((size_t)((u.pm >> 4) * 6 + (cp >> 6)) * 16 + (u.pm & 15)) * 64 + (cp & 63);
#pragma unroll
                for (int n = 0; n < 2; ++n)
#pragma unroll
                    for (int i = 0; i < 4; ++i) { float s = 0.f;
#pragma unroll
                        for (int ai = 0; ai < 2; ++ai)
#pragma unroll
                            for (int m = 0; m < 4; ++m) s += acc[ai][bj][m][n][i];
                        s += __shfl_xor(s, 1); s += __shfl_xor(s, 2); s += __shfl_xor(s, 4); s += __shfl_xor(s, 8);
                        if (fr == 0) atomicAdd(dst + 4 * n + i, s * (1.0f / 256.0f)); }
            }
        }
    }
};
template <class Epi, class Sched, bool ALIGN_EPI = false, bool SP2 = false>
__device__ __forceinline__ void gemm_phase(PG8_LAS unsigned char* lds, const Gemm g, const Sched& S, const Epi& E) {
    int tid_ = threadIdx.x; asm volatile("" : "+v"(tid_));
    const int tid = tid_, wid = __builtin_amdgcn_readfirstlane(tid >> 6), lane = tid & 63, wr = wid >> 2, wc = wid & 3, fr = lane & 15, fq = lane >> 4;
    const int K = g.K, nt = K / BK;
    unsigned voffA[2], voffB[2];
#pragma unroll
    for (int i = 0; i < 2; ++i) { int R, C; stage_rc(tid * 16 + i * 8192, R, C); const int Rb = Epi::PERM ? ((R & ~31) + perm32(R & 31)) : R;
        voffA[i] = (unsigned)(R * K + C) * 2u; voffB[i] = (unsigned)(Rb * K + C) * 2u; }
    const size_t kstep = (size_t)(BK * 2);
    const size_t hstep = (size_t)HALF * K * 2;
    const size_t tstep = 2 * hstep;
    const unsigned ldsw = (unsigned)wid * 1024u;
    const int aoff = lds_byte(wr * 64 + fr, fq * 8), boff = lds_byte(wc * 32 + fr, fq * 8);
#define PG8_SA(b, h) (((b) * 2 + (h)) * HTB)
#define PG8_SB(b, h) ((4 + (b) * 2 + (h)) * HTB)
#define PG8_STAGE(bufoff, gbase, voff) do { _Pragma("unroll") for (int _i = 0; _i < 2; ++_i) \
        __builtin_amdgcn_global_load_lds((const unsigned*)((const char*)(gbase) + (voff)[_i]), (PG8_LAS unsigned*)(lds + (bufoff) + ldsw + _i * 8192), 16, 0, 0); } while (0)
#define PG8_LDA(dst, b, h) do { _Pragma("unroll") for (int m = 0; m < 4; ++m) _Pragma("unroll") for (int k = 0; k < 2; ++k) dst[m][k] = *(const PG8_LAS bf16x8*)(lds + PG8_SA(b, h) + aoff + m * 2048 + k * 1024); } while (0)
#define PG8_LDB(dst, b, h) do { _Pragma("unroll") for (int n = 0; n < 2; ++n) _Pragma("unroll") for (int k = 0; k < 2; ++k) dst[n][k] = *(const PG8_LAS bf16x8*)(lds + PG8_SB(b, h) + boff + n * 2048 + k * 1024); } while (0)
#define PG8_MMA(ai, bj, At, Bt) do { __builtin_amdgcn_s_setprio(1); _Pragma("unroll") for (int m = 0; m < 4; ++m) _Pragma("unroll") for (int n = 0; n < 2; ++n) _Pragma("unroll") for (int k = 0; k < 2; ++k) \
        acc[ai][bj][m][n] = __builtin_amdgcn_mfma_f32_16x16x32_bf16(Bt[n][k], At[m][k], acc[ai][bj][m][n], 0, 0, 0); __builtin_amdgcn_s_setprio(0); } while (0)
#define PG8_WAIT_V(n) asm volatile("s_waitcnt vmcnt(" #n ")" ::: "memory")
#define PG8_WAIT_L(n) asm volatile("s_waitcnt lgkmcnt(" #n ")" ::: "memory")
#define PG8_BAR __builtin_amdgcn_s_barrier()
#define PG8_SCHED __builtin_amdgcn_sched_barrier(0)
    Unit cur, nxt; int ui = 0;
    if (!S.next(0, cur)) return;
    f32x4 acc[2][2][4][2];
#pragma unroll
    for (int a = 0; a < 2; ++a)
#pragma unroll
        for (int b = 0; b < 2; ++b)
#pragma unroll
            for (int m = 0; m < 4; ++m)
#pragma unroll
                for (int n = 0; n < 2; ++n) acc[a][b][m][n] = (f32x4){0.f, 0.f, 0.f, 0.f};
    bf16x8 At[4][2], B0[2][2], B1[2][2];
    const char* cA = (const char*)g.A + (size_t)cur.pm * tstep; const char* cB = (const char*)g.Bt + (size_t)cur.pn * tstep;
    S.a_ready(cur);
    if constexpr (SP2) {
        PG8_STAGE(PG8_SB(0, 0), cB, voffB); PG8_STAGE(PG8_SB(0, 1), cB + hstep, voffB); PG8_STAGE(PG8_SA(0, 0), cA, voffA); PG8_STAGE(PG8_SA(0, 1), cA + hstep, voffA);
        if (wr == 1) PG8_BAR;
        PG8_WAIT_V(2); PG8_BAR;
        PG8_STAGE(PG8_SB(1, 0), cB + kstep, voffB); PG8_STAGE(PG8_SA(1, 0), cA + kstep, voffA); PG8_STAGE(PG8_SB(1, 1), cB + hstep + kstep, voffB);
        PG8_WAIT_V(6); PG8_BAR;
    } else {
        PG8_STAGE(PG8_SB(0, 0), cB, voffB); PG8_STAGE(PG8_SA(0, 0), cA, voffA); PG8_STAGE(PG8_SB(0, 1), cB + hstep, voffB); PG8_STAGE(PG8_SA(0, 1), cA + hstep, voffA);
        if (wr == 1) PG8_BAR;
        PG8_WAIT_V(4); PG8_BAR;
        PG8_STAGE(PG8_SB(1, 0), cB + kstep, voffB); PG8_STAGE(PG8_SA(1, 0), cA + kstep, voffA); PG8_STAGE(PG8_SB(1, 1), cB + hstep + kstep, voffB);
        PG8_WAIT_V(6); PG8_BAR;
    }
    for (;;) {
        const bool has_next = S.next(ui + 1, nxt);
        const char* nA = has_next ? (const char*)g.A + (size_t)nxt.pm * tstep : cA; const char* nB = has_next ? (const char*)g.Bt + (size_t)nxt.pn * tstep : cB;
        for (int t = 0; t < nt; t += 2) {
            const bool last = (t == nt - 2);
            const char* a1 = cA + (size_t)(t + 1) * kstep;
            const char* a2 = last ? nA : cA + (size_t)(t + 2) * kstep; const char* b2 = last ? nB : cB + (size_t)(t + 2) * kstep;
            const char* a3 = a2 + kstep; const char* b3 = b2 + kstep;
            if (last && has_next) S.a_ready(nxt);
            if constexpr (SP2) {
            PG8_LDB(B0, 0, 0); PG8_LDB(B1, 0, 1); PG8_SCHED; PG8_LDA(At, 0, 0); PG8_STAGE(PG8_SA(1, 1), a1 + hstep, voffA);
            PG8_WAIT_V(8); PG8_WAIT_L(0); PG8_BAR; PG8_MMA(0, 0, At, B0); PG8_MMA(0, 1, At, B1); PG8_BAR; PG8_SCHED;
            PG8_LDA(At, 0, 1); PG8_STAGE(PG8_SB(0, 0), b2, voffB); PG8_STAGE(PG8_SB(0, 1), b2 + hstep, voffB); PG8_STAGE(PG8_SA(0, 0), a2, voffA);
            PG8_WAIT_V(8); PG8_WAIT_L(0); PG8_BAR; PG8_MMA(1, 0, At, B0); PG8_MMA(1, 1, At, B1); PG8_BAR; PG8_SCHED;
            PG8_LDB(B0, 1, 0); PG8_LDB(B1, 1, 1); PG8_SCHED; PG8_LDA(At, 1, 0); PG8_STAGE(PG8_SA(0, 1), a2 + hstep, voffA);
            PG8_WAIT_V(8); PG8_WAIT_L(0); PG8_BAR; PG8_MMA(0, 0, At, B0); PG8_MMA(0, 1, At, B1); PG8_BAR; PG8_SCHED;
            PG8_LDA(At, 1, 1); PG8_STAGE(PG8_SB(1, 0), b3, voffB); PG8_STAGE(PG8_SB(1, 1), b3 + hstep, voffB); PG8_STAGE(PG8_SA(1, 0), a3, voffA);
            PG8_WAIT_V(8); PG8_WAIT_L(0); PG8_BAR; PG8_MMA(1, 0, At, B0); PG8_MMA(1, 1, At, B1); PG8_BAR; PG8_SCHED;
            } else {
            PG8_LDB(B0, 0, 0); PG8_SCHED; PG8_LDA(At, 0, 0); PG8_STAGE(PG8_SA(1, 1), a1 + hstep, voffA);
            PG8_WAIT_L(8); PG8_BAR; PG8_WAIT_L(0); PG8_MMA(0, 0, At, B0); PG8_BAR; PG8_SCHED;
            PG8_LDB(B1, 0, 1); PG8_STAGE(PG8_SB(0, 0), b2, voffB);
            PG8_BAR; PG8_WAIT_L(0); PG8_MMA(0, 1, At, B1); PG8_BAR;
            PG8_LDA(At, 0, 1); PG8_STAGE(PG8_SA(0, 0), a2, voffA);
            PG8_BAR; PG8_WAIT_L(0); PG8_MMA(1, 0, At, B0); PG8_BAR; PG8_SCHED;
            PG8_STAGE(PG8_SB(0, 1), b2 + hstep, voffB);
            PG8_WAIT_V(6); PG8_BAR; PG8_MMA(1, 1, At, B1); PG8_BAR;
            PG8_LDB(B0, 1, 0); PG8_SCHED; PG8_LDA(At, 1, 0); PG8_STAGE(PG8_SA(0, 1), a2 + hstep, voffA);
            PG8_WAIT_L(8); PG8_BAR; PG8_WAIT_L(0); PG8_MMA(0, 0, At, B0); PG8_BAR; PG8_SCHED;
            PG8_LDB(B1, 1, 1); PG8_STAGE(PG8_SB(1, 0), b3, voffB);
            PG8_BAR; PG8_WAIT_L(0); PG8_MMA(0, 1, At, B1); PG8_BAR;
            PG8_LDA(At, 1, 1); PG8_STAGE(PG8_SA(1, 0), a3, voffA);
            PG8_BAR; PG8_WAIT_L(0); PG8_MMA(1, 0, At, B0); PG8_BAR; PG8_SCHED;
            PG8_STAGE(PG8_SB(1, 1), b3 + hstep, voffB);
            PG8_WAIT_V(6); PG8_BAR; PG8_MMA(1, 1, At, B1); PG8_BAR;
            }
        }
        if constexpr (ALIGN_EPI) { if (wr == 0) PG8_BAR; }
        if constexpr (!Epi::AFTER_DRAIN) { E(acc, cur, wr, wc, fr, fq); S.done(cur); }
        if (!has_next) break;
#pragma unroll
        for (int a = 0; a < 2; ++a)
#pragma unroll
            for (int b = 0; b < 2; ++b)
#pragma unroll
                for (int m = 0; m < 4; ++m)
#pragma unroll
                    for (int n = 0; n < 2; ++n) acc[a][b][m][n] = (f32x4){0.f, 0.f, 0.f, 0.f};
        cur = nxt; cA = nA; cB = nB; ++ui;
        if constexpr (ALIGN_EPI) { if (wr == 1) PG8_BAR; }
    }
    PG8_WAIT_V(0);
    if constexpr (!ALIGN_EPI) { if (wr == 0) PG8_BAR; }
    PG8_BAR;
    if constexpr (Epi::AFTER_DRAIN) { E.fused(acc, cur, wr, wc, fr, fq, lds, wid, lane); S.done(cur); }
#undef PG8_SA
#undef PG8_SB
#undef PG8_STAGE
#undef PG8_LDA
#undef PG8_LDB
#undef PG8_MMA
#undef PG8_WAIT_V
#undef PG8_WAIT_L
#undef PG8_BAR
#undef PG8_SCHED
}
}

#include <hip/hip_bf16.h>
#include <cmath>
namespace attn_body {
using bf16=__hip_bfloat16;
using bf16x8=__attribute__((ext_vector_type(8)))short;
using s16x4=__attribute__((ext_vector_type(4)))short;
using f32x16=__attribute__((ext_vector_type(16)))float;
using u32x4=__attribute__((ext_vector_type(4)))unsigned;
using f32x4_t=__attribute__((ext_vector_type(4)))float;
constexpr int D=64;
constexpr int NW=8,QBLK=32,QB=QBLK*NW,KVBLK=64;
constexpr int QP=3072, OPITCH=1024;
constexpr int AUX_R0=0, AUX_INFO=1024, AUX_TAB=2048, AUX_BYTES=2048+16384+1024;
__device__ __forceinline__ int crow(int r,int hi){return (r&3)+8*(r>>2)+4*hi;}
#define SBAR() __builtin_amdgcn_sched_barrier(0)
__device__ __forceinline__ void cmask(f32x16&p0,f32x16&p1,int jb,int qrel,int hi){
  const float NEG=-INFINITY; int kb=64*jb+4*hi;
  #pragma unroll
  for(int r=0;r<16;++r){int kv=kb+(r&3)+8*(r>>2); if(kv>qrel)p0[r]=NEG; if(kv+32>qrel)p1[r]=NEG;}
}

constexpr int NSLOT=3, SLOTB=8192;
constexpr int LDS_K=0, LDS_V=NSLOT*SLOTB, LDS_WS=2*NSLOT*SLOTB, LDS_OST=LDS_WS+NW*64*4, LDS_BYTES=LDS_OST+NW*4096;
constexpr float C2=0.125f*1.4426950408889634f;
__device__ __forceinline__ void glds16(const void*gsrc,unsigned lds_dst){unsigned keep;
  asm volatile("s_mov_b32 %0, m0\n\ts_mov_b32 m0, %2\n\ts_nop 0\n\tglobal_load_lds_dwordx4 %1, off\n\ts_mov_b32 m0, %0":"=&s"(keep):"v"(gsrc),"s"(lds_dst):"memory");}
__device__ __forceinline__ float max3f(float a,float b,float c){float r;asm("v_max3_f32 %0, %1, %2, %3":"=v"(r):"v"(a),"v"(b),"v"(c));return r;}
__device__ __forceinline__ float max2f(float a,float b){float r;asm("v_max_f32_e32 %0, %1, %2":"=v"(r):"v"(a),"v"(b));return r;}
__device__ __forceinline__ float fadd_s(float a,float b){float r;asm("v_add_f32_e32 %0, %1, %2":"=v"(r):"v"(a),"v"(b));return r;}
__device__ __forceinline__ float fsub_s(float a,float b){float r;asm("v_sub_f32_e32 %0, %1, %2":"=v"(r):"v"(a),"v"(b));return r;}
typedef float f32x2_t __attribute__((ext_vector_type(2))); typedef __bf16 bf16x2_t __attribute__((ext_vector_type(2)));
__device__ __forceinline__ unsigned cvtpk_s(float lo,float hi){f32x2_t v={lo,hi};bf16x2_t b=__builtin_convertvector(v,bf16x2_t);return __builtin_bit_cast(unsigned,b);}
#define WAIT_BAR(N) asm volatile("s_waitcnt vmcnt(" #N ") lgkmcnt(0)\n\ts_barrier":::"memory")

__device__ __forceinline__ void qkt(f32x16&p0,f32x16&p1,const char*Kslot,const bf16x8*qr,const f32x16&negm,int r32,int hi){
  const char*kb=Kslot+hi*1024+r32*16;
  #pragma unroll
  for(int d0=0;d0<4;++d0){
    const bf16x8 b0=*reinterpret_cast<const bf16x8*>(kb+d0*2048);
    const bf16x8 b1=*reinterpret_cast<const bf16x8*>(kb+d0*2048+512);
    if(d0==0){p0=__builtin_amdgcn_mfma_f32_32x32x16_bf16(b0,qr[0],negm,0,0,0);p1=__builtin_amdgcn_mfma_f32_32x32x16_bf16(b1,qr[0],negm,0,0,0);}
    else{p0=__builtin_amdgcn_mfma_f32_32x32x16_bf16(b0,qr[d0],p0,0,0,0);p1=__builtin_amdgcn_mfma_f32_32x32x16_bf16(b1,qr[d0],p1,0,0,0);}}
}
typedef __attribute__((address_space(3))) const char* lds_cptr;
typedef short v4i16_t __attribute__((ext_vector_type(4)));
__device__ __forceinline__ void kload8(bf16x8*kf,lds_cptr kp){
  kf[0]=*(const __attribute__((address_space(3))) bf16x8*)(kp);      kf[1]=*(const __attribute__((address_space(3))) bf16x8*)(kp+512);
  kf[2]=*(const __attribute__((address_space(3))) bf16x8*)(kp+2048); kf[3]=*(const __attribute__((address_space(3))) bf16x8*)(kp+2560);
  kf[4]=*(const __attribute__((address_space(3))) bf16x8*)(kp+4096); kf[5]=*(const __attribute__((address_space(3))) bf16x8*)(kp+4608);
  kf[6]=*(const __attribute__((address_space(3))) bf16x8*)(kp+6144); kf[7]=*(const __attribute__((address_space(3))) bf16x8*)(kp+6656);
}
__device__ __forceinline__ void kload2(bf16x8*kf,lds_cptr kp,int j){ kf[2*j]=*(const __attribute__((address_space(3))) bf16x8*)(kp+j*2048); kf[2*j+1]=*(const __attribute__((address_space(3))) bf16x8*)(kp+j*2048+512); }
__device__ __forceinline__ s16x4 vtr(lds_cptr p){ return __builtin_bit_cast(s16x4,__builtin_amdgcn_ds_read_tr16_b64_v4i16((__attribute__((address_space(3))) v4i16_t*)p)); }
__device__ __forceinline__ float rowmax(const f32x16&p0,const f32x16&p1){
  float a=max3f(p0[0],p0[1],p1[0]),b=max3f(p0[2],p0[3],p1[1]);a=max3f(a,p1[2],p1[3]);
  #pragma unroll
  for(int r=4;r<16;r+=4){a=max3f(a,p0[r],p0[r+1]);b=max3f(b,p0[r+2],p0[r+3]);a=max3f(a,p1[r],p1[r+1]);b=max3f(b,p1[r+2],p1[r+3]);}
  const float m=max2f(a,b);
  auto rr=__builtin_amdgcn_permlane32_swap(__float_as_uint(m),__float_as_uint(m),false,false);
  return max2f(__uint_as_float(rr[0]),__uint_as_float(rr[1]));
}
__device__ __forceinline__ void pv(f32x16*o,int vb,bf16x8 pa0,bf16x8 pa1,bf16x8 pa2,bf16x8 pa3){
  #pragma unroll
  for(int d0=0;d0<2;++d0){s16x4 lo[4],hi[4];
    #pragma unroll
    for(int ks=0;ks<4;++ks){
      asm volatile("ds_read_b64_tr_b16 %0,%1 offset:%c2":"=&v"(lo[ks]):"v"(vb),"i"(d0*4096+ks*1024):"memory");
      asm volatile("ds_read_b64_tr_b16 %0,%1 offset:%c2":"=&v"(hi[ks]):"v"(vb),"i"(d0*4096+ks*1024+512):"memory");}
    asm volatile("s_waitcnt lgkmcnt(0)":::"memory");SBAR();
    #define PK(k) (bf16x8){lo[k][0],lo[k][1],lo[k][2],lo[k][3],hi[k][0],hi[k][1],hi[k][2],hi[k][3]}
    o[d0]=__builtin_amdgcn_mfma_f32_32x32x16_bf16(pa0,PK(0),o[d0],0,0,0);
    o[d0]=__builtin_amdgcn_mfma_f32_32x32x16_bf16(pa1,PK(1),o[d0],0,0,0);
    o[d0]=__builtin_amdgcn_mfma_f32_32x32x16_bf16(pa2,PK(2),o[d0],0,0,0);
    o[d0]=__builtin_amdgcn_mfma_f32_32x32x16_bf16(pa3,PK(3),o[d0],0,0,0);
    #undef PK
  }
}

#ifndef ATTN_STORE16
#define ATTN_STORE16(p,v) (*(u32x4*)(p)=(v))
#endif
template<int KIND,int THRL> __device__ __forceinline__ void attn_unit(const bf16*Qg,const bf16*__restrict__ Kg,const bf16*__restrict__ Vg,bf16*Og,const int NT,const int tile0,const int q0,const int qb,char*shm,lds_cptr aux){
  int tid_=threadIdx.x; asm volatile("":"+v"(tid_));
  const int tid=tid_,lane=tid&63,r32=lane&31,hi=lane>>5; const int wid=__builtin_amdgcn_readfirstlane(tid>>6);
  const bf16*Qw=Qg+(long)(wid*QBLK)*QP;
  const bf16*Kh=Kg,*Vh=Vg;
  const unsigned lds0=(unsigned)(uintptr_t)shm;
  float*wsf=(float*)(shm+LDS_WS)+wid*64;
  const bf16*ksrc=Kh+(long)lane*QP+wid*8;
  const bf16*vsrc=Vh+(long)(16*(wid&3)+(lane>>2))*QP+(wid>>2)*32+(lane&3)*8;
  const unsigned kdst=lds0+LDS_K+wid*1024, vdst=lds0+LDS_V+wid*1024;
  #define DMA_K(t,slot) glds16(ksrc+(long)(t)*KVBLK*QP,(unsigned)__builtin_amdgcn_readfirstlane(kdst+(slot)))
  #define DMA_V(t,slot) glds16(vsrc+(long)(t)*KVBLK*QP,(unsigned)__builtin_amdgcn_readfirstlane(vdst+(slot)))
  const int vb0=(int)(lds0+LDS_V)+((lane>>4)&1)*32+(lane&3)*8+(4*hi+((lane&15)>>2))*64;
  const char*Kbase=shm+LDS_K; bf16x8 kf[8];
  const lds_cptr shm3=(lds_cptr)shm; const lds_cptr kp0=shm3+LDS_K+hi*1024+r32*16; const lds_cptr vp0=shm3+LDS_V+((lane>>4)&1)*32+(lane&3)*8+(4*hi+((lane&15)>>2))*64;
  DMA_K(0,0);DMA_V(0,0);DMA_K(1,SLOTB);
  bf16x8 qr[4];
  #pragma unroll
  for(int d0=0;d0<4;++d0)qr[d0]=*reinterpret_cast<const bf16x8*>(&Qw[(long)r32*QP+d0*16+hi*8]);
  typedef __attribute__((address_space(3))) const float* lds_fptr; typedef __attribute__((address_space(3))) const unsigned* lds_uptr; typedef __attribute__((address_space(3))) const f32x4_t* lds_f4ptr;
  const int myrow=wid*QBLK+r32; const lds_fptr aux_tab=(lds_fptr)(aux+AUX_TAB);
  float mhat=((lds_fptr)(aux+AUX_R0))[myrow],l_reg=0.f; const unsigned rinfo=((lds_uptr)(aux+AUX_INFO))[myrow];
  f32x16 o[2];o[0]=f32x16{};o[1]=f32x16{};f32x16 negm=f32x16{};
  #define NEGM_SET(tn) do{ if(KIND==1){ const int bn_=(tile0+(tn))>>2; const float nv_=(bn_<qb&&!((rinfo>>bn_)&1u))?-INFINITY:-mhat; _Pragma("unroll") for(int r=0;r<16;++r)negm[r]=nv_; asm volatile("":"+v"(negm)); } }while(0)
  NEGM_SET(0);
  const float NEGI=-INFINITY;
  #define CFENCE() asm volatile("":::"memory")
  #define POST(C0,C1,t) do{ \
    if(KIND==0){ const float nm_=-mhat; asm volatile("s_nop 15\n\ts_nop 7":"+v"(C0),"+v"(C1));   \
      const lds_f4ptr cp_=(lds_f4ptr)(aux_tab+((tile0+(t))*64+4*hi)); \
      _Pragma("unroll") for(int g_=0;g_<4;++g_){ const f32x4_t a_=cp_[2*g_],b_=cp_[8+2*g_]; \
        _Pragma("unroll") for(int i_=0;i_<4;++i_){ C0[4*g_+i_]=fadd_s(C0[4*g_+i_],fsub_s(nm_,a_[i_])); C1[4*g_+i_]=fadd_s(C1[4*g_+i_],fsub_s(nm_,b_[i_])); } if(g_==1)CFENCE(); } } \
    else { const int blk_=(tile0+(t))>>2; \
      const int dw_=(q0+wid*QBLK)-(tile0+(t))*64;     \
      if(blk_>=qb-1&&dw_<176&&dw_>-32){ asm volatile("s_nop 15\n\ts_nop 7":"+v"(C0),"+v"(C1)); const int db_=(q0+myrow)-((tile0+(t))*64+4*hi); \
        _Pragma("unroll") for(int r=0;r<16;++r){ const int d_=db_-((r&3)+8*(r>>2)); const int i0_=d_<0?0:(d_>128?128:d_), e_=d_-32, i1_=e_<0?0:(e_>128?128:e_); C0[r]=fadd_s(C0[r],aux_tab[i0_]); C1[r]=fadd_s(C1[r],aux_tab[i1_]); if((r&3)==3)CFENCE(); } } } \
  }while(0)
  const int qrel=wid*QBLK+r32;
  #define CMASK(P0,P1,t) do{int jb_=(t)-(NT-4); if(jb_>=0)cmask(P0,P1,jb_,qrel,hi);}while(0)
  bool resc=false;
  #define START(P0,P1) do{ const float rm=rowmax(P0,P1); resc=false; \
    { const float dl=max2f(rm,0.f); mhat=fadd_s(mhat,dl); \
      _Pragma("unroll") for(int r=0;r<16;++r){P0[r]=fsub_s(P0[r],dl);P1[r]=fsub_s(P1[r],dl);} \
      NEGM_SET(1); } \
    _Pragma("unroll") for(int r=0;r<16;++r)P0[r]=__builtin_amdgcn_exp2f(P0[r]); }while(0)
  #define RESC() do{ if(resc){ asm volatile("s_waitcnt lgkmcnt(0)":::"memory"); \
      _Pragma("unroll") for(int d_=0;d_<2;++d_) _Pragma("unroll") for(int r=0;r<16;++r)o[d_][r]*=wsf[crow(r,hi)]; } }while(0)
  f32x16 pA0,pA1,pB0,pB1;
  int sl_prev=0,sl_cur=0,sl_next=SLOTB;
  #define ROT() do{sl_prev=sl_cur;sl_cur=sl_next;sl_next=(sl_next==(NSLOT-1)*SLOTB)?0:sl_next+SLOTB;}while(0)
  DMA_K(2,2*SLOTB);
  WAIT_BAR(3);
  qkt(pA0,pA1,Kbase,qr,negm,r32,hi);asm volatile("s_nop 15\n\ts_nop 7":"+v"(pA0),"+v"(pA1));CMASK(pA0,pA1,0);POST(pA0,pA1,0);
  START(pA0,pA1);
  _Pragma("unroll") for(int r=0;r<16;++r)pA1[r]=__builtin_amdgcn_exp2f(pA1[r]);
  WAIT_BAR(0);
  DMA_K(3,0);DMA_V(1,SLOTB);
  ROT();
  kload8(kf,kp0+sl_cur);
  WAIT_BAR(2);
  s16x4 vlo[8],vhi[8]; u32x4 pw0,pw1,pw2,pw3;
  #define PKW(P,B) cvtpk_s(P[B],P[B+1])
  #define PAF(k) __builtin_bit_cast(bf16x8,pw##k)
  #define VFR(i) (bf16x8){vlo[i][0],vlo[i][1],vlo[i][2],vlo[i][3],vhi[i][0],vhi[i][1],vhi[i][2],vhi[i][3]}
  #define PIN(x) asm volatile("":"+v"(x))
  #define MX3(a,b,c) __builtin_fmaxf(__builtin_fmaxf((a),(b)),(c))
  #define GAPA(MF,A0,A1,A2,A3,W0,W1,PW) do{ MF; sacc+=A0; sacc+=A1; sacc+=A2; sacc+=A3; PIN(sacc); W0; W1; PIN(PW); SBAR(); }while(0)
  #define EX(v) __builtin_amdgcn_exp2f(v)
  #define GAPB(MF,X,B) do{ MF; X[B]=EX(X[B]); X[B+1]=EX(X[B+1]); X[B+2]=EX(X[B+2]); X[B+3]=EX(X[B+3]); PIN(X); SBAR(); }while(0)
  #define VRD(i) do{ vlo[i]=vtr(vp_+(((i)>>2)*4096+((i)&3)*1024)); vhi[i]=vtr(vp_+(((i)>>2)*4096+((i)&3)*1024+512)); }while(0)
  #define KRD(G,j) do{ if(G){ kload2(kf,kp0+sl_next,j); SBAR(); } }while(0)
  #define STEP(C0,C1,P0,P1,t,GK,GV,GL) do{ SBAR(); \
    const lds_cptr vp_=vp0+sl_prev; \
    VRD(0); SBAR(); float sacc=(P0[0]+P0[1]); \
    GAPA(C0=__builtin_amdgcn_mfma_f32_32x32x16_bf16(kf[0],qr[0],negm,0,0,0), P0[2],P0[3],P0[4],P0[5],     pw0[0]=PKW(P0,0), pw0[1]=PKW(P0,2), pw0); \
    VRD(4); SBAR(); GAPA(C1=__builtin_amdgcn_mfma_f32_32x32x16_bf16(kf[1],qr[0],negm,0,0,0), P0[6],P0[7],P0[8],P0[9],     pw0[2]=PKW(P0,4), pw0[3]=PKW(P0,6), pw0); \
    VRD(1); SBAR(); GAPA(C0=__builtin_amdgcn_mfma_f32_32x32x16_bf16(kf[2],qr[1],C0,0,0,0),   P0[10],P0[11],P0[12],P0[13], pw1[0]=PKW(P0,8), pw1[1]=PKW(P0,10), pw1); \
    VRD(5); SBAR(); GAPA(C1=__builtin_amdgcn_mfma_f32_32x32x16_bf16(kf[3],qr[1],C1,0,0,0),   P0[14],P0[15],P1[0],P1[1],   pw1[2]=PKW(P0,12),pw1[3]=PKW(P0,14), pw1); \
    VRD(2); SBAR(); GAPA(C0=__builtin_amdgcn_mfma_f32_32x32x16_bf16(kf[4],qr[2],C0,0,0,0),   P1[2],P1[3],P1[4],P1[5],     pw2[0]=PKW(P1,0), pw2[1]=PKW(P1,2), pw2); \
    VRD(6); SBAR(); GAPA(C1=__builtin_amdgcn_mfma_f32_32x32x16_bf16(kf[5],qr[2],C1,0,0,0),   P1[6],P1[7],P1[8],P1[9],     pw2[2]=PKW(P1,4), pw2[3]=PKW(P1,6), pw2); \
    VRD(3); SBAR(); GAPA(C0=__builtin_amdgcn_mfma_f32_32x32x16_bf16(kf[6],qr[3],C0,0,0,0),   P1[10],P1[11],P1[12],P1[13], pw3[0]=PKW(P1,8), pw3[1]=PKW(P1,10), pw3); \
    VRD(7); SBAR(); GAPA(C1=__builtin_amdgcn_mfma_f32_32x32x16_bf16(kf[7],qr[3],C1,0,0,0),   P1[14],P1[15],0.f,0.f,       pw3[2]=PKW(P1,12),pw3[3]=PKW(P1,14), pw3); \
    l_reg+=sacc; \
    if(GK){DMA_K((t)+3,sl_cur);} if(GV){DMA_V((t)+1,sl_next);} \
    CMASK(C0,C1,t); POST(C0,C1,t); \
    { float a=MX3(C0[0],C0[1],C1[0]),b=MX3(C0[2],C0[3],C1[1]); a=MX3(a,C1[2],C1[3]); \
      _Pragma("unroll") for(int r=4;r<16;r+=4){a=MX3(a,C0[r],C0[r+1]);b=MX3(b,C0[r+2],C0[r+3]);a=MX3(a,C1[r],C1[r+1]);b=MX3(b,C1[r+2],C1[r+3]);} \
      float rm=__builtin_fmaxf(a,b); { auto rr=__builtin_amdgcn_permlane32_swap(__float_as_uint(rm),__float_as_uint(rm),false,false); rm=__builtin_fmaxf(__uint_as_float(rr[0]),__uint_as_float(rr[1])); } \
      resc=false; \
      if(__builtin_expect(__any(rm>(float)THRL),0)){ const float dl=__builtin_fmaxf(rm,0.f); mhat+=dl; \
        _Pragma("unroll") for(int r=0;r<16;++r){C0[r]-=dl;C1[r]-=dl;} \
        const float f=__builtin_amdgcn_exp2f(-dl); l_reg*=f; if(hi==0)wsf[r32]=f; resc=true; } \
      if(KIND==1&&(resc||((tile0+(t)+1)&3)==0)) NEGM_SET((t)+1); } \
    SBAR(); \
    GAPB(o[0]=__builtin_amdgcn_mfma_f32_32x32x16_bf16(PAF(0),VFR(0),o[0],0,0,0), C0,0); \
    GAPB(o[1]=__builtin_amdgcn_mfma_f32_32x32x16_bf16(PAF(0),VFR(4),o[1],0,0,0), C0,4); \
    KRD(GL,0); GAPB(o[0]=__builtin_amdgcn_mfma_f32_32x32x16_bf16(PAF(1),VFR(1),o[0],0,0,0), C0,8); \
    KRD(GL,1); GAPB(o[1]=__builtin_amdgcn_mfma_f32_32x32x16_bf16(PAF(1),VFR(5),o[1],0,0,0), C0,12); \
    KRD(GL,2); GAPB(o[0]=__builtin_amdgcn_mfma_f32_32x32x16_bf16(PAF(2),VFR(2),o[0],0,0,0), C1,0); \
    KRD(GL,3); GAPB(o[1]=__builtin_amdgcn_mfma_f32_32x32x16_bf16(PAF(2),VFR(6),o[1],0,0,0), C1,4); \
    GAPB(o[0]=__builtin_amdgcn_mfma_f32_32x32x16_bf16(PAF(3),VFR(3),o[0],0,0,0), C1,8); \
    GAPB(o[1]=__builtin_amdgcn_mfma_f32_32x32x16_bf16(PAF(3),VFR(7),o[1],0,0,0), C1,12); \
    }while(0)
  int t=1;
  #undef CMASK
  #define CMASK(P0,P1,t) do{}while(0)
  for(;t+5<NT;t+=2){
    STEP(pB0,pB1,pA0,pA1,t,true,true,true);     WAIT_BAR(2); RESC(); ROT();
    STEP(pA0,pA1,pB0,pB1,t+1,true,true,true);   WAIT_BAR(2); RESC(); ROT();
  }
  #undef CMASK
  #define CMASK(P0,P1,t) do{int jb_=(t)-(NT-4); if(jb_>=0)cmask(P0,P1,jb_,qrel,hi);}while(0)
  #define ENDW(tt) do{ if((tt)+3<NT){WAIT_BAR(2);} else if((tt)+2<NT){WAIT_BAR(1);} else {WAIT_BAR(0);} }while(0)
  for(;t+1<NT;t+=2){
    STEP(pB0,pB1,pA0,pA1,t,(t+3<NT),(t+1<NT),(t+1<NT));       ENDW(t);   RESC(); ROT();
    STEP(pA0,pA1,pB0,pB1,t+1,(t+4<NT),(t+2<NT),(t+2<NT));     ENDW(t+1); RESC(); ROT();
  }
  STEP(pB0,pB1,pA0,pA1,NT-1,false,false,false); RESC();
  { float sacc=pB0[0]+pB0[1]; _Pragma("unroll") for(int r=2;r<16;++r)sacc+=pB0[r]; _Pragma("unroll") for(int r=0;r<16;++r)sacc+=pB1[r]; l_reg+=sacc;
    pw0=(u32x4){PKW(pB0,0),PKW(pB0,2),PKW(pB0,4),PKW(pB0,6)};pw1=(u32x4){PKW(pB0,8),PKW(pB0,10),PKW(pB0,12),PKW(pB0,14)};pw2=(u32x4){PKW(pB1,0),PKW(pB1,2),PKW(pB1,4),PKW(pB1,6)};pw3=(u32x4){PKW(pB1,8),PKW(pB1,10),PKW(pB1,12),PKW(pB1,14)};
    SBAR(); pv(o,vb0+sl_cur,PAF(0),PAF(1),PAF(2),PAF(3)); }
  #undef PKW
  #undef PAF
  #undef VFR
  #undef PIN
  #undef MX3
  #undef GAPA
  #undef GAPB
  #undef EX
  #undef VRD
  #undef KRD
  #undef STEP
  #undef ENDW
  {auto rr=__builtin_amdgcn_permlane32_swap(__float_as_uint(l_reg),__float_as_uint(l_reg),false,false);l_reg=__uint_as_float(rr[0])+__uint_as_float(rr[1]);}
  if(hi==0)wsf[32+r32]=l_reg;asm volatile("s_waitcnt lgkmcnt(0)":::"memory");
  float rli[16];
  #pragma unroll
  for(int r=0;r<16;++r)rli[r]=__builtin_amdgcn_rcpf(wsf[32+crow(r,hi)]);
  bf16*Ow=Og+(long)(wid*QBLK)*OPITCH;
  { bf16*stg=(bf16*)(shm+LDS_OST)+wid*2048;
    #pragma unroll
    for(int r=0;r<16;++r){const int orow=crow(r,hi);
      #pragma unroll
      for(int d0=0;d0<2;++d0)stg[orow*64+d0*32+r32]=__float2bfloat16(o[d0][r]*rli[r]);}
    asm volatile("s_waitcnt lgkmcnt(0)":::"memory");
    #pragma unroll
    for(int i=0;i<4;++i){const int row=i*8+(lane>>3),ch=lane&7; const u32x4 v=*(const u32x4*)(stg+row*64+ch*8); ATTN_STORE16(Ow+(long)row*OPITCH+ch*8,v);} }
  asm volatile("s_waitcnt lgkmcnt(0)\n\ts_barrier":::"memory");
  #undef DMA_K
  #undef DMA_V
  #undef CMASK
  #undef START
  #undef RESC
  #undef ROT
  #undef POST
  #undef NEGM_SET
  #undef CFENCE
}
constexpr int ATTN_LDS_BYTES=LDS_BYTES;
#undef SBAR
#undef WAIT_BAR
}

#define GAS __attribute__((address_space(1)))
#define LAS __attribute__((address_space(3)))
typedef unsigned short bf16;
typedef unsigned v4u __attribute__((ext_vector_type(4)));
typedef float f32x4 __attribute__((ext_vector_type(4)));
typedef short bf16x8 __attribute__((ext_vector_type(8)));
typedef GAS unsigned gu32;
typedef GAS unsigned long long gu64;
#define RLX_AGENT __ATOMIC_RELAXED, __HIP_MEMORY_SCOPE_AGENT
#define LDS_WAIT() asm volatile("s_waitcnt lgkmcnt(0)" ::: "memory")
#define VM_WAIT() asm volatile("s_waitcnt vmcnt(0)" ::: "memory")
__device__ __forceinline__ unsigned long long rt() { return __builtin_amdgcn_s_memrealtime(); }

#define XB_TMO      128
#define XB_XCNT(j)  (256  + 64 * (j))
#define XB_XSUB(j)  (1280 + 64 * (j))
#define XB_XGEN(j)  (2304 + 64 * (j))
#define XB_TOP      3328
#define XB_TOPGEN   3392
#define XCD_BAR_WORDS 3456
#define XB_SPIN_CAP (1u << 18)

__device__ __forceinline__ unsigned xb_ld(unsigned* p)              { return __hip_atomic_load(p, __ATOMIC_RELAXED, __HIP_MEMORY_SCOPE_AGENT); }
__device__ __forceinline__ unsigned xb_add(unsigned* p, unsigned v) { return __hip_atomic_fetch_add(p, v, __ATOMIC_RELAXED, __HIP_MEMORY_SCOPE_AGENT); }
__device__ __forceinline__ unsigned xb_xcc_id() { return (unsigned)__builtin_amdgcn_s_getreg((3 << 11) | 20) & 0xFu; }
#define XB_SPIN(cond, bar) do { unsigned _sp = 0; while (cond) { __builtin_amdgcn_s_sleep(1); \
    if ((++_sp & 255u) == 0u) { if (xb_ld(&(bar)[XB_TMO])) break; if (_sp > XB_SPIN_CAP) { atomicAdd(&(bar)[XB_TMO], 1u); break; } } } } while (0)

struct XcdBarrier {
    unsigned* bar; unsigned x;
    volatile LAS unsigned* st;
};

__device__ __forceinline__ XcdBarrier xcd_barrier_post(unsigned* bar, volatile LAS unsigned* st) {
    XcdBarrier b; b.bar = bar; b.x = xb_xcc_id(); b.st = st;
    if (threadIdx.x == 0) (void)xb_add(&bar[XB_XCNT(b.x)], 1u);
    return b;
}
__device__ __forceinline__ void xcd_barrier_complete(unsigned* bar, unsigned x, unsigned& nloc, unsigned& nx) {
    const unsigned G = gridDim.x * gridDim.y * gridDim.z;
    unsigned sum, cnt, mine, sp = 0u;
    for (;;) {
        sum = 0u; cnt = 0u; mine = 0u;
#pragma unroll
        for (unsigned j = 0; j < 16; ++j) { const unsigned c = xb_ld(&bar[XB_XCNT(j)]); sum += c; cnt += (c > 0u) ? 1u : 0u; mine = (j == x) ? c : mine; }
        if (sum == G) break;
        __builtin_amdgcn_s_sleep(1);
        if ((++sp & 255u) == 0u) { if (xb_ld(&bar[XB_TMO])) break; if (sp > XB_SPIN_CAP) { atomicAdd(&bar[XB_TMO], 1u); break; } }
    }
    nloc = mine > 0u ? mine : 1u; nx = cnt > 0u ? cnt : 1u;
}

__device__ __forceinline__ void xcd_barrier(const XcdBarrier& b) {
    asm volatile("s_waitcnt vmcnt(0)" ::: "memory");
    __syncthreads();
    if (threadIdx.x == 0) {
        unsigned* bar = b.bar;
        __builtin_amdgcn_s_waitcnt(0);
        unsigned nloc = b.st[0], nx = b.st[1];
        if (nloc == 0u) { xcd_barrier_complete(bar, b.x, nloc, nx); b.st[0] = nloc; b.st[1] = nx; }
        const unsigned old = xb_add(&bar[XB_XSUB(b.x)], 1u);
        const unsigned gen = old / nloc;
        if (old + 1u == (gen + 1u) * nloc) {
            __builtin_amdgcn_fence(__ATOMIC_RELEASE, "agent");
            asm volatile("s_waitcnt vmcnt(0)" ::: "memory");
            const unsigned og = xb_add(&bar[XB_TOP], 1u);
            const unsigned tg = og / nx;
            if (og + 1u == (tg + 1u) * nx) xb_add(&bar[XB_TOPGEN], 1u);
            else XB_SPIN(xb_ld(&bar[XB_TOPGEN]) == tg, bar);
            __builtin_amdgcn_fence(__ATOMIC_ACQUIRE, "agent");
            xb_add(&bar[XB_XGEN(b.x)], 1u);
            asm volatile("s_waitcnt vmcnt(0)" ::: "memory");
        } else {
            XB_SPIN(xb_ld(&bar[XB_XGEN(b.x)]) == gen, bar);
            __builtin_amdgcn_fence(__ATOMIC_ACQUIRE, "agent");
            asm volatile("s_waitcnt vmcnt(0)" ::: "memory");
        }
    }
    __syncthreads();
}

constexpr int NWAVES = 8;
constexpr int RING_OFF = 0, RING_BYTES = 131072;
constexpr int LDSCTL_OFF = RING_BYTES, MISC_OFF = LDSCTL_OFF + 320;
constexpr int LDS_BYTES = 147456;
constexpr int CW_TMO = 0, CW_CODE = 1, CW_Q = 1024, CW_BAR = 4096;
constexpr float PRUNE_TH = 36.f;
constexpr int AUX_OFF = 86016;
constexpr size_t CTL_ZERO_BYTES = 2 * MiB;
constexpr size_t WS_KM = 1 * MiB, KM_LAYER = 256 * 1024;
constexpr int NPH_LAYER = 7, NPH = 1 + DEPTH * NPH_LAYER;

__device__ __forceinline__ void transpose_item(const float* W, int ldsrc, int k0, int srccol0, float scale, const float* gk, bf16* dst, int ldd, LAS float* scr, int lane) {
    float t[32];
#pragma unroll
    for (int i = 0; i < 32; ++i) { const int kk = 2 * i + (lane >> 5); t[i] = W[(size_t)(k0 + kk) * ldsrc + srccol0 + (lane & 31)]; }
#pragma unroll
    for (int i = 0; i < 32; ++i) { const int kk = 2 * i + (lane >> 5); scr[kk * 33 + (lane & 31)] = t[i] * (gk ? scale * gk[k0 + kk] : scale); }
    LDS_WAIT(); asm volatile("" ::: "memory");
    const int c = lane & 7;
#pragma unroll
    for (int j = 0; j < 4; ++j) { const int n = (lane >> 3) + 8 * j; const LAS float* s = scr + (8 * c) * 33 + n;
        v4u o; o.x = pk2(s[0 * 33], s[1 * 33]); o.y = pk2(s[2 * 33], s[3 * 33]); o.z = pk2(s[4 * 33], s[5 * 33]); o.w = pk2(s[6 * 33], s[7 * 33]);
        *(GAS v4u*)(dst + (size_t)n * ldd + k0 + 8 * c) = o; }
    LDS_WAIT(); asm volatile("" ::: "memory");
}

__device__ __forceinline__ float u2f(const unsigned u) { return __builtin_bit_cast(float, u); }
__device__ __forceinline__ void unpack8(const u32x4 w, float* f) {
    f[0] = __builtin_bit_cast(float, w.x << 16); f[1] = __builtin_bit_cast(float, w.x & 0xffff0000u); f[2] = __builtin_bit_cast(float, w.y << 16); f[3] = __builtin_bit_cast(float, w.y & 0xffff0000u);
    f[4] = __builtin_bit_cast(float, w.z << 16); f[5] = __builtin_bit_cast(float, w.z & 0xffff0000u); f[6] = __builtin_bit_cast(float, w.w << 16); f[7] = __builtin_bit_cast(float, w.w & 0xffff0000u);
}
__device__ __forceinline__ u32x4 pack8(const float* f) { u32x4 w; w.x = pk2(f[0], f[1]); w.y = pk2(f[2], f[3]); w.z = pk2(f[4], f[5]); w.w = pk2(f[6], f[7]); return w; }
__device__ __forceinline__ f32x4 ld4(const float* p) { return *(const f32x4*)p; }
__device__ __forceinline__ f32x4 ld4(const LAS float* p) { return *(const LAS f32x4*)p; }
template <bool RF32, bool XF32, class WFP>
__device__ __forceinline__ void rows_compute(const u32x4 (&cr)[4], const u32x4 (&cy)[2], const float rin, const int m, const int lane, const bool has_y, const float (&gp)[16], void* xout, const bool norm_out, float* rs, WFP WF, const bool has_wf, const float bfl, float* logf) {
    float v[16];
    if (RF32) {
#pragma unroll
        for (int q = 0; q < 4; ++q) { v[4 * q] = u2f(cr[q].x); v[4 * q + 1] = u2f(cr[q].y); v[4 * q + 2] = u2f(cr[q].z); v[4 * q + 3] = u2f(cr[q].w); }
    } else { unpack8(cr[0], v); unpack8(cr[1], v + 8); }
#pragma unroll
    for (int i = 0; i < 16; ++i) v[i] *= rin;
    if (has_y) { float yv[16]; unpack8(cy[0], yv); unpack8(cy[1], yv + 8); float ss = 0.f;
#pragma unroll
        for (int i = 0; i < 16; ++i) ss += yv[i] * yv[i];
        const float r = __builtin_amdgcn_rsqf(wave_sum(ss) * (1.f / DM) + RMS_EPS);
#pragma unroll
        for (int i = 0; i < 16; ++i) v[i] += yv[i] * r * gp[i]; }
    float r = 1.f;
    if (norm_out || has_wf) { float ss = 0.f;
#pragma unroll
        for (int i = 0; i < 16; ++i) ss += v[i] * v[i];
        const float ms = wave_sum(ss) * (1.f / DM) + RMS_EPS; r = __builtin_amdgcn_rsqf(ms);
        if (rs && lane == 0) rs[m] = __builtin_amdgcn_sqrtf(ms); }
    if (xout) {
        float w[16];
#pragma unroll
        for (int i = 0; i < 16; ++i) w[i] = norm_out ? v[i] * r : v[i];
        if (XF32) { f32x4* o = (f32x4*)((float*)xout + (size_t)m * DM + 8 * lane); o[0] = (f32x4){w[0], w[1], w[2], w[3]}; o[1] = (f32x4){w[4], w[5], w[6], w[7]}; o[128] = (f32x4){w[8], w[9], w[10], w[11]}; o[129] = (f32x4){w[12], w[13], w[14], w[15]}; }
        else { u32x4* o = (u32x4*)((bf16*)xout + (size_t)m * DM + 8 * lane); o[0] = pack8(w); o[64] = pack8(w + 8); } }
    {
        if (has_wf) {
            float d[8];
#pragma unroll
            for (int h = 0; h < 8; ++h) { d[h] = 0.f;
                if (h < NH) {
#pragma unroll
                    for (int q = 0; q < 4; ++q) { const f32x4 w = ld4(WF + ((h * 4 + q) * 64 + lane) * 4); d[h] += (v[4 * q] * w.x + v[4 * q + 1] * w.y) + (v[4 * q + 2] * w.z + v[4 * q + 3] * w.w); } } }
#define DPPMOV(x_, ctrl_) __builtin_bit_cast(float, __builtin_amdgcn_update_dpp(0, __builtin_bit_cast(int, (x_)), (ctrl_), 0xf, 0xf, false))
            const bool b2 = (lane & 4) != 0, e0 = ((lane ^ (lane >> 2)) & 1) != 0, e1 = (((lane >> 1) ^ (lane >> 2)) & 1) != 0;
            float e4[4], e2[2];
#pragma unroll
            for (int j = 0; j < 4; ++j) { const float snd = e0 ? d[j] : d[j + 4], kp = e0 ? d[j + 4] : d[j]; e4[j] = kp + DPPMOV(snd, 0xB1); }
#pragma unroll
            for (int j = 0; j < 2; ++j) { const float snd = e1 ? e4[j] : e4[j + 2], kp = e1 ? e4[j + 2] : e4[j]; e2[j] = kp + DPPMOV(snd, 0x4E); }
            float e = (b2 ? e2[1] : e2[0]) + DPPMOV(b2 ? e2[0] : e2[1], 0x141);
            e += DPPMOV(e, 0x128);
            e += __shfl_xor(e, 16);
            { auto rr = __builtin_amdgcn_permlane32_swap(__float_as_uint(e), __float_as_uint(e), false, false); e = __uint_as_float(rr[0]) + __uint_as_float(rr[1]); }
#undef DPPMOV
            const int hh = 4 * (int)e0 + 2 * (int)e1 + (int)b2;
            if (lane < 8 && hh < NH) logf[(size_t)m * NH + hh] = e * r + bfl; } }
}
template <bool RF32, bool XF32, class WFP>
__device__ __forceinline__ void rows_phase(const int gw, const int NGW, const int lane, const void* resid, const float* rs_in, const bf16* y, const float* gpost, void* xout, const bool norm_out, float* rs, WFP WF, const bool has_wf, const float* bfv, float* logf) {
    float gp[16];
#pragma unroll
    for (int j = 0; j < 2; ++j)
#pragma unroll
        for (int c = 0; c < 2; ++c) { const int e = 8 * lane + 512 * j + 4 * c;
            const f32x4 a = y ? *(const f32x4*)(gpost + e) : (f32x4){0.f, 0.f, 0.f, 0.f};
#pragma unroll
            for (int i = 0; i < 4; ++i) gp[8 * j + 4 * c + i] = a[i]; }
    const int hh_ = 4 * ((lane ^ (lane >> 2)) & 1) + 2 * (((lane >> 1) ^ (lane >> 2)) & 1) + ((lane >> 2) & 1);
    const float bfl = (has_wf && lane < 8 && hh_ < NH) ? bfv[hh_] : 0.f;
    const bool has_y = (y != nullptr);
    u32x4 r0[4], y0[2], r1[4], y1[2], r2[4], y2[2], r3[4], y3[2], r4[4], y4[2]; float s0 = 1.f, s1 = 1.f, s2 = 1.f, s3 = 1.f, s4 = 1.f;
#define ROWS_LOAD(R, Y, SC, m_) do { if (rs_in) SC = rs_in[(m_)]; \
        if (RF32) { const u32x4* p_ = (const u32x4*)((const float*)resid + (size_t)(m_) * DM + 8 * lane); R[0] = p_[0]; R[1] = p_[1]; R[2] = p_[128]; R[3] = p_[129]; } \
        else { const u32x4* p_ = (const u32x4*)((const bf16*)resid + (size_t)(m_) * DM + 8 * lane); R[0] = p_[0]; R[1] = p_[64]; } \
        if (has_y) { const u32x4* q_ = (const u32x4*)(y + (size_t)(m_) * DM + 8 * lane); Y[0] = q_[0]; Y[1] = q_[64]; } } while (0)
#define ROWS_DO(R, Y, SC, m_) rows_compute<RF32, XF32, WFP>(R, Y, SC, (m_), lane, has_y, gp, xout, norm_out, rs, WF, has_wf, bfl, logf)
#define RFENCE() asm volatile("" ::: "memory")
    int m = gw;
    if (m + 3 * NGW < M) {
        ROWS_LOAD(r0, y0, s0, m); ROWS_LOAD(r1, y1, s1, m + NGW); ROWS_LOAD(r2, y2, s2, m + 2 * NGW); ROWS_LOAD(r3, y3, s3, m + 3 * NGW); RFENCE();
        for (; m + 8 * NGW < M; m += 5 * NGW) {
            ROWS_LOAD(r4, y4, s4, m + 4 * NGW); RFENCE(); ROWS_DO(r0, y0, s0, m); RFENCE();
            ROWS_LOAD(r0, y0, s0, m + 5 * NGW); RFENCE(); ROWS_DO(r1, y1, s1, m + NGW); RFENCE();
            ROWS_LOAD(r1, y1, s1, m + 6 * NGW); RFENCE(); ROWS_DO(r2, y2, s2, m + 2 * NGW); RFENCE();
            ROWS_LOAD(r2, y2, s2, m + 7 * NGW); RFENCE(); ROWS_DO(r3, y3, s3, m + 3 * NGW); RFENCE();
            ROWS_LOAD(r3, y3, s3, m + 8 * NGW); RFENCE(); ROWS_DO(r4, y4, s4, m + 4 * NGW); RFENCE();
        }
        if (m + 4 * NGW < M) ROWS_LOAD(r4, y4, s4, m + 4 * NGW);
        RFENCE(); ROWS_DO(r0, y0, s0, m); RFENCE();
        if (m + 5 * NGW < M) ROWS_LOAD(r0, y0, s0, m + 5 * NGW);
        RFENCE(); ROWS_DO(r1, y1, s1, m + NGW); RFENCE();
        if (m + 6 * NGW < M) ROWS_LOAD(r1, y1, s1, m + 6 * NGW);
        RFENCE(); ROWS_DO(r2, y2, s2, m + 2 * NGW); RFENCE();
        if (m + 7 * NGW < M) ROWS_LOAD(r2, y2, s2, m + 7 * NGW);
        RFENCE(); ROWS_DO(r3, y3, s3, m + 3 * NGW); RFENCE();
        if (m + 4 * NGW < M) ROWS_DO(r4, y4, s4, m + 4 * NGW);
        if (m + 5 * NGW < M) ROWS_DO(r0, y0, s0, m + 5 * NGW);
        if (m + 6 * NGW < M) ROWS_DO(r1, y1, s1, m + 6 * NGW);
        if (m + 7 * NGW < M) ROWS_DO(r2, y2, s2, m + 7 * NGW);
        m = M;
    }
    for (; m < M; m += NGW) { ROWS_LOAD(r0, y0, s0, m); ROWS_DO(r0, y0, s0, m); }
#undef ROWS_LOAD
#undef ROWS_DO
#undef RFENCE
}

struct Args { const float* in[13]; float* out; unsigned char* ws; int ph_lo, ph_hi, li, pad; };

__global__ void __launch_bounds__(NWAVES * 64, 2) mk_fwd(Args args) {
    extern __shared__ __attribute__((aligned(16))) unsigned char lds[];
    LAS unsigned char* L = (LAS unsigned char*)lds;
    volatile LAS unsigned* MISC = (volatile LAS unsigned*)(L + MISC_OFF);
    const int G = gridDim.x; const int bx = blockIdx.x; const int vcu = (G % 8 == 0) ? (bx % 8) * (G / 8) + bx / 8 : bx;
    const int NGW = G * NWAVES;
#define PHASE_IDS() int tid_ = threadIdx.x; asm volatile("" : "+v"(tid_)); const int tid = tid_, lane = tid & 63, wave = __builtin_amdgcn_readfirstlane(tid >> 6), gw = vcu * NWAVES + wave; (void)tid; (void)lane; (void)gw
    unsigned char* ws = args.ws;
    gu32* ctl = (gu32*)(ws + WS_CTL);
    for (int u = threadIdx.x; u < (LDS_BYTES - LDSCTL_OFF) / 4; u += NWAVES * 64) ((LAS unsigned*)(L + LDSCTL_OFF))[u] = 0u;
    __syncthreads();
    XcdBarrier bar = xcd_barrier_post((unsigned*)(ctl + CW_BAR) + args.li * XCD_BAR_WORDS, MISC + 8);
    const int lo = args.ph_lo, hi = args.ph_hi;
#define IN(k) (lo <= (k) && (k) < hi)
#define SEAM(k) do { if (IN(k) && IN((k) + 1)) xcd_barrier(bar); } while (0)
    const float* x = args.in[0]; const float* w_in = args.in[1]; const float* b_f = args.in[2]; const float* conv_w = args.in[3];
    const float* w_out = args.in[4]; const float* rel_bias = args.in[5]; const float* g_pre_mix = args.in[6]; const float* g_post_mix = args.in[7];
    const float* g_pre_ffn = args.in[8]; const float* g_post_ffn = args.in[9]; const float* w_gate = args.in[10]; const float* w_up = args.in[11]; const float* w_down = args.in[12];
    float* out = args.out;
    float* LOGF = (float*)(ws + WS_LOGF); float* RS = (float*)(ws + WS_KMEAN); float* KNP = (float*)(ws + WS_CUM);
    bf16* XN = (bf16*)(ws + WS_XN); bf16* MIXIN = (bf16*)(ws + WS_MIXIN); bf16* XA = (bf16*)(ws + WS_XA); bf16* Y = (bf16*)(ws + WS_XA + 64 * MiB); bf16* P = (bf16*)(ws + WS_P); bf16* H = (bf16*)(ws + WS_H);

    if (IN(0)) { PHASE_IDS();
        LAS float* scr = (LAS float*)(L + RING_OFF + wave * 16384);
        constexpr int I_IN = (PW / 32) * (DM / 64), I_OUT = (DM / 32) * (DM / 64), I_GU = (NGU / 32) * (DM / 64), I_D = (DM / 32) * (DFF / 64), I_L = I_IN + I_OUT + I_GU + I_D;
        for (int it = gw; it < DEPTH * I_L; it += NGW) {
            const int l = it / I_L; int r = it % I_L;
            unsigned char* wl = ws + WS_W + (size_t)l * W_LAYER;
            if (r < I_IN) { const int kb = r / (PW / 32), pb = r % (PW / 32), p0 = pb * 32; const int src = p0 < 2304 ? p0 : p0 + 6;
                const float sc = (p0 < 384 || (p0 >= 1152 && p0 < 1536)) ? C2 : 1.f;
                transpose_item(w_in + (size_t)l * DM * INW, INW, kb * 64, src, sc, g_pre_mix + (size_t)l * DM, (bf16*)(wl + WO_IN) + (size_t)p0 * DM, DM, scr, lane); continue; }
            r -= I_IN;
            if (r < I_OUT) { const int kb = r / (DM / 32), pb = r % (DM / 32);
                transpose_item(w_out + (size_t)l * DM * DM, DM, kb * 64, pb * 32, 1.f, nullptr, (bf16*)(wl + WO_OUT) + (size_t)pb * 32 * DM, DM, scr, lane); continue; }
            r -= I_OUT;
            if (r < I_GU) { const int kb = r / (NGU / 32), pb = r % (NGU / 32), r0 = pb * 32; const int pn = r0 >> 8, bj = (r0 >> 7) & 1, j = r0 & 127;
                transpose_item((bj ? w_up : w_gate) + (size_t)l * DM * DFF, DFF, kb * 64, pn * 128 + j, 1.f, g_pre_ffn + (size_t)l * DM, (bf16*)(wl + WO_GU) + (size_t)r0 * DM, DM, scr, lane); continue; }
            r -= I_GU;
            { const int kb = r / (DM / 32), pb = r % (DM / 32);
                transpose_item(w_down + (size_t)l * DFF * DM, DM, kb * 64, pb * 32, 1.f, nullptr, (bf16*)(wl + WO_D) + (size_t)pb * 32 * DFF, DFF, scr, lane); }
        }
        for (int i = gw * 64 + lane; i < DEPTH * NH * DM; i += NGW * 64) { const int l = i / (NH * DM), r = i % (NH * DM), h = r / DM, q = (r >> 8) & 3, ln = (r >> 2) & 63, k = 8 * ln + 512 * (q >> 1) + 4 * (q & 1) + (r & 3);
            ((float*)(ws + WS_W + (size_t)l * W_LAYER + WO_F))[r] = w_in[(size_t)l * DM * INW + (size_t)k * INW + 2304 + h] * g_pre_mix[(size_t)l * DM + k]; }
        __syncthreads();
        { LAS float* wfl = (LAS float*)(L + RING_OFF + 4096);
          for (int i = tid; i < NH * DM; i += NWAVES * 64) { const int k = i / NH, h = i % NH, ln = (k & 511) >> 3, q = 2 * (k >> 9) + ((k >> 2) & 1); wfl[((h * 4 + q) * 64 + ln) * 4 + (k & 3)] = w_in[(size_t)k * INW + 2304 + h] * g_pre_mix[k]; }
          __syncthreads();
          rows_phase<true, false, const LAS float*>(gw, NGW, lane, x, nullptr, nullptr, nullptr, XN, true, nullptr, (const LAS float*)wfl, true, b_f, LOGF); }
    }
    SEAM(0);
    for (int l = 0; l < DEPTH; ++l) {
        const int pb = 1 + l * NPH_LAYER;
        unsigned char* wl = ws + WS_W + (size_t)l * W_LAYER;
        const bf16* Win_t = (const bf16*)(wl + WO_IN); const bf16* Wout_t = (const bf16*)(wl + WO_OUT); const bf16* Wgu_t = (const bf16*)(wl + WO_GU); const bf16* Wd_t = (const bf16*)(wl + WO_D);
        const bool last = (l == DEPTH - 1);
        float* KM = (float*)(ws + WS_CTL + WS_KM + (size_t)l * KM_LAYER);
        if (IN(pb + 0)) { PHASE_IDS();
            for (int e = vcu * (NWAVES * 64) + tid; e < M * NH; e += G * NWAVES * 64) LOGF[e] = log_sigmoid(LOGF[e]);
            pg8::Gemm g{l == 0 ? XN : XA, Win_t, M, PW, DM}; pg8::StaticOrder S; S.init(M, PW, G, bx);
            pg8::EpiInProj E{P, PW, KM, KNP};
            pg8::gemm_phase<pg8::EpiInProj, pg8::StaticOrder, true, true>(L + RING_OFF, g, S, E);
        }
        SEAM(pb + 0);
        if (IN(pb + 1)) { PHASE_IDS();
            constexpr int NATT = 2 * BATCH * NH * NBLK, NCONV = M / 128, NUNITS = NATT + NCONV;
            char* shm = (char*)lds + RING_OFF;
            attn_body::lds_cptr aux = (attn_body::lds_cptr)(L + AUX_OFF);
            LAS float* auxR0 = (LAS float*)(L + AUX_OFF + attn_body::AUX_R0); LAS unsigned* auxInfo = (LAS unsigned*)(L + AUX_OFF + attn_body::AUX_INFO); LAS float* auxTab = (LAS float*)(L + AUX_OFF + attn_body::AUX_TAB);
            LAS float* wtot = (LAS float*)(L + AUX_OFF + attn_body::AUX_TAB + 16384);
            const float* cw = conv_w + (size_t)l * 3 * CCH;
            int idx = bx, iter = 0; unsigned nA = (unsigned)(bx + G);
            while (idx < NUNITS) {
                if (tid == 0) { MISC[16 + ((iter + 1) & 1)] = nA; nA = __hip_atomic_fetch_add(ctl + CW_Q + 64 * l, 1u, RLX_AGENT) + 2u * (unsigned)G; }
                int tq = threadIdx.x; asm volatile("" : "+v"(tq));
                if (idx < NATT) {
                const int kind = idx < NATT / 2 ? 1 : 0, ia = idx - (kind ? 0 : NATT / 2), qb = (NBLK - 1) - ia / (BATCH * NH), bh = ia % (BATCH * NH), b = bh / NH, h = bh % NH;
                const int q0 = qb * MBLK; const size_t row0 = (size_t)b * SEQ;
                const int prow = tq >> 1, half = tq & 1;
                const int cq = kind == 0 ? P_FQ : P_MQ, ck = kind == 0 ? P_FK : P_MK, cv = kind == 0 ? P_FV : P_MV;
                const bf16* Qg = P + (row0 + q0) * PW + cq + h * HD; const bf16* Kb = P + row0 * PW + ck + h * HD; const bf16* Vb = P + row0 * PW + cv + h * HD;
                bf16* Og = MIXIN + (row0 + q0) * DM + (kind == 0 ? 384 : 0) + h * HD;
                int tile0 = 0;
                if (kind == 0) {
                    const int k0 = tile0 * 64, kend = q0 + MBLK, kb = k0 + 8 * tq;
                    float loc[8]; float run = 0.f;
#pragma unroll
                    for (int i = 0; i < 8; ++i) { const int key = kb + i; const float v = key < kend ? LOGF[(row0 + key) * NH + h] : 0.f; run += v; loc[i] = run; }
                    float incl = run;
#pragma unroll
                    for (int o = 1; o < 64; o <<= 1) { const float t = __shfl_up(incl, o); if ((tq & 63) >= o) incl += t; }
                    if ((tq & 63) == 63) wtot[tq >> 6] = incl;
                    __syncthreads();
                    float off = incl - run; for (int w = 0; w < (tq >> 6); ++w) off += wtot[w];
#pragma unroll
                    for (int i = 0; i < 8; ++i) { const int key = kb + i; if (key < kend) auxTab[key] = (off + loc[i]) * LOG2E; }
                } else {
                    const float bfar = rel_bias[31 * NH + h];
                    if (tq <= 128) auxTab[tq] = (rel_bias[c_bucket[tq] * NH + h] - bfar) * LOG2E;
                    for (int i = tq; i < qb * HD; i += NWAVES * 64) auxTab[256 + i] = KM[(size_t)bh * NBLK * HD + i];
                }
                __syncthreads();
                if (kind == 0) {
                    const bf16* qp = Qg + (size_t)prow * PW + half * 32; const bf16* kp = Kb + (size_t)(q0 + prow) * PW + half * 32; float d = 0.f, qq = 0.f;
#pragma unroll
                    for (int c = 0; c < 4; ++c) { const bf16x8 qv = *(const bf16x8*)(qp + 8 * c), kv = *(const bf16x8*)(kp + 8 * c);
#pragma unroll
                        for (int j = 0; j < 8; ++j) { const float qf = bf2f((unsigned short)qv[j]); d += qf * bf2f((unsigned short)kv[j]); qq += qf * qf; } }
                    d += __shfl_xor(d, 1); qq += __shfl_xor(qq, 1);
                    float u2 = (auxTab[q0 + prow] - auxTab[q0]) - d;
#pragma unroll
                    for (int o = 2; o < 64; o <<= 1) { qq = fmaxf(qq, __shfl_xor(qq, o)); u2 = fmaxf(u2, __shfl_xor(u2, o)); }
                    if ((tq & 63) == 0) { wtot[8 + (tq >> 6)] = qq; wtot[16 + (tq >> 6)] = u2; }
                    if (tq == 0) ((LAS unsigned*)wtot)[24] = (unsigned)(4 * qb);
                    __syncthreads();
                    float U1 = wtot[8], U2 = wtot[16];
#pragma unroll
                    for (int w = 1; w < 8; ++w) { U1 = fmaxf(U1, wtot[8 + w]); U2 = fmaxf(U2, wtot[16 + w]); }
                    U1 = sqrtf(U1) * 1.0001f;
                    if (tq < 4 * qb) { const float* kn = KNP + ((size_t)bh * 64 + tq) * 2; const float bound = U1 * sqrtf(kn[0] + kn[1]) + U2 + (auxTab[q0] - auxTab[64 * tq + 63]);
                        if (!(bound <= -PRUNE_TH)) __hip_atomic_fetch_min((LAS unsigned*)wtot + 24, (unsigned)tq, __ATOMIC_RELAXED, __HIP_MEMORY_SCOPE_WORKGROUP); }
                    __syncthreads();
                    tile0 = (int)(((LAS unsigned*)wtot)[24] & ~1u);
                }
                {   const bf16* qp = Qg + (size_t)prow * PW + half * 32; const bf16* kp = Kb + (size_t)(q0 + prow) * PW + half * 32; float q[32]; float d = 0.f;
#pragma unroll
                    for (int c = 0; c < 4; ++c) { const bf16x8 qv = *(const bf16x8*)(qp + 8 * c), kv = *(const bf16x8*)(kp + 8 * c);
#pragma unroll
                        for (int j = 0; j < 8; ++j) { q[8 * c + j] = bf2f((unsigned short)qv[j]); d += q[8 * c + j] * bf2f((unsigned short)kv[j]); } }
                    d += __shfl_xor(d, 1);
                    if (kind == 0) { if (half == 0) { auxR0[prow] = d - auxTab[q0 + prow]; auxInfo[prow] = 0u; } }
                    else {
                        int s0 = -1, s1 = -1, s2 = -1; float g0 = -INFINITY, g1 = -INFINITY, g2 = -INFINITY;
                        for (int n = 0; n < qb; ++n) { const LAS f32x4* km = (const LAS f32x4*)(auxTab + 256 + n * HD + half * 32); float g = 0.f;
#pragma unroll
                            for (int j = 0; j < 8; ++j) { const f32x4 kk = km[j]; g += (q[4 * j] * kk.x + q[4 * j + 1] * kk.y) + (q[4 * j + 2] * kk.z + q[4 * j + 3] * kk.w); }
                            g += __shfl_xor(g, 1);
                            if (g > g0) { g2 = g1; s2 = s1; g1 = g0; s1 = s0; g0 = g; s0 = n; } else if (g > g1) { g2 = g1; s2 = s1; g1 = g; s1 = n; } else if (g > g2) { g2 = g; s2 = n; } }
                        unsigned msk = 0u; if (s0 >= 0) msk |= 1u << s0; if (s1 >= 0) msk |= 1u << s1; if (s2 >= 0) msk |= 1u << s2;
                        if (half == 0) { auxR0[prow] = d + auxTab[0]; auxInfo[prow] = msk; }
                    }
                }
                __syncthreads();
                if (kind == 0) attn_body::attn_unit<0, 8>((const attn_body::bf16*)Qg, (const attn_body::bf16*)(Kb + (size_t)tile0 * 64 * PW), (const attn_body::bf16*)(Vb + (size_t)tile0 * 64 * PW), (attn_body::bf16*)Og, 4 * (qb + 1) - tile0, tile0, q0, qb, shm, aux);
                else attn_body::attn_unit<1, 8>((const attn_body::bf16*)Qg, (const attn_body::bf16*)Kb, (const attn_body::bf16*)Vb, (attn_body::bf16*)Og, 4 * (qb + 1), 0, q0, qb, shm, aux);
                } else {
                    const int cg = tq & 31, rg = tq >> 5; const size_t r0 = (size_t)(idx - NATT) * 128 + rg * 8; const int c0 = cg * 8;
                    float w0[8], w1[8], w2[8], u2[8], u1[8];
#pragma unroll
                    for (int j = 0; j < 8; ++j) { w0[j] = cw[c0 + j]; w1[j] = cw[CCH + c0 + j]; w2[j] = cw[2 * CCH + c0 + j]; u2[j] = 0.f; u1[j] = 0.f; }
                    if ((r0 % SEQ) != 0) {
                        const bf16x8 a2 = *(const bf16x8*)(P + (r0 - 2) * PW + P_CC + c0), h2 = *(const bf16x8*)(P + (r0 - 2) * PW + P_CH + c0);
                        const bf16x8 a1 = *(const bf16x8*)(P + (r0 - 1) * PW + P_CC + c0), h1 = *(const bf16x8*)(P + (r0 - 1) * PW + P_CH + c0);
#pragma unroll
                        for (int j = 0; j < 8; ++j) { u2[j] = bf2f((unsigned short)a2[j]) * bf2f((unsigned short)h2[j]); u1[j] = bf2f((unsigned short)a1[j]) * bf2f((unsigned short)h1[j]); }
                    }
#pragma unroll
                    for (int rr = 0; rr < 8; ++rr) { const size_t m = r0 + rr;
                        const bf16x8 a = *(const bf16x8*)(P + m * PW + P_CC + c0), hh = *(const bf16x8*)(P + m * PW + P_CH + c0), bb = *(const bf16x8*)(P + m * PW + P_CB + c0);
                        float o8[8];
#pragma unroll
                        for (int j = 0; j < 8; ++j) { const float u0 = bf2f((unsigned short)a[j]) * bf2f((unsigned short)hh[j]); o8[j] = bf2f((unsigned short)bb[j]) * (w0[j] * u2[j] + w1[j] * u1[j] + w2[j] * u0); u2[j] = u1[j]; u1[j] = u0; }
                        u32x4 w; w.x = pk2(o8[0], o8[1]); w.y = pk2(o8[2], o8[3]); w.z = pk2(o8[4], o8[5]); w.w = pk2(o8[6], o8[7]);
                        *(u32x4*)(MIXIN + m * DM + 768 + c0) = w; }
                    __syncthreads();
                }
                idx = (int)MISC[16 + ((iter + 1) & 1)]; ++iter;
            }
        }
        SEAM(pb + 1);
        if (IN(pb + 2)) { PHASE_IDS();
            pg8::Gemm g{MIXIN, Wout_t, M, DM, DM}; pg8::StaticOrder S; S.init(M, DM, G, bx);
            pg8::EpiStoreBf16 E{Y, DM};
            pg8::gemm_phase<pg8::EpiStoreBf16, pg8::StaticOrder, true, true>(L + RING_OFF, g, S, E);
        }
        SEAM(pb + 2);
        if (IN(pb + 3)) { PHASE_IDS();
            if (l == 0) rows_phase<true, false, const float*>(gw, NGW, lane, x, nullptr, Y, g_post_mix + (size_t)l * DM, XA, true, RS, (const float*)nullptr, false, nullptr, nullptr);
            else rows_phase<false, false, const float*>(gw, NGW, lane, XA, RS, Y, g_post_mix + (size_t)l * DM, XA, true, RS, (const float*)nullptr, false, nullptr, nullptr);
        }
        SEAM(pb + 3);
        if (IN(pb + 4)) { PHASE_IDS();
            pg8::Gemm g{XA, Wgu_t, M, NGU, DM}; pg8::StaticOrder S; S.init(M, NGU, G, bx);
            pg8::EpiSwiGLU E{H, DFF};
            pg8::gemm_phase<pg8::EpiSwiGLU, pg8::StaticOrder, true, true>(L + RING_OFF, g, S, E);
        }
        SEAM(pb + 4);
        if (IN(pb + 5)) { PHASE_IDS();
            pg8::Gemm g{H, Wd_t, M, DM, DFF}; pg8::StaticOrder S; S.init(M, DM, G, bx);
            pg8::EpiStoreBf16 E{Y, DM};
            pg8::gemm_phase<pg8::EpiStoreBf16, pg8::StaticOrder, true, true>(L + RING_OFF, g, S, E);
        }
        SEAM(pb + 5);
        if (IN(pb + 6)) { PHASE_IDS();
            if (!last) { const float* WFn = (const float*)(ws + WS_W + (size_t)(l + 1) * W_LAYER + WO_F);
                rows_phase<false, false, const float*>(gw, NGW, lane, XA, RS, Y, g_post_ffn + (size_t)l * DM, XA, true, RS, WFn, true, b_f + (size_t)(l + 1) * NH, LOGF); }
            else rows_phase<false, true, const float*>(gw, NGW, lane, XA, RS, Y, g_post_ffn + (size_t)l * DM, out, false, nullptr, (const float*)nullptr, false, nullptr, nullptr);
        }
        SEAM(pb + 6);
    }
#undef IN
#undef SEAM
}

#ifndef MK_MODE
#define MK_MODE 2
#endif
extern "C" void kernel_launch(void* const* d_in, const int* in_sizes, int n_in, void* d_out, int out_size, void* d_ws, size_t ws_size, hipStream_t stream) {
    if (n_in != 13 || in_sizes[0] != M * DM || out_size != M * DM || ws_size < WS_END) { fprintf(stderr, "kernel_launch: unexpected shapes (n_in %d, in0 %d, out %d, ws %zu)\n", n_in, n_in > 0 ? in_sizes[0] : -1, out_size, ws_size); return; }
    static int grid = 0;
    if (grid == 0) {
        int dev = 0, cus = 0, per_cu = 0;
        if (hipGetDevice(&dev) != hipSuccess || hipDeviceGetAttribute(&cus, hipDeviceAttributeMultiprocessorCount, dev) != hipSuccess) { fprintf(stderr, "kernel_launch: device query failed\n"); grid = -1; return; }
        if (hipFuncSetAttribute((const void*)mk_fwd, hipFuncAttributeMaxDynamicSharedMemorySize, LDS_BYTES) != hipSuccess) { fprintf(stderr, "kernel_launch: hipFuncSetAttribute failed\n"); grid = -1; return; }
        if (hipOccupancyMaxActiveBlocksPerMultiprocessor(&per_cu, (const void*)mk_fwd, NWAVES * 64, LDS_BYTES) != hipSuccess || per_cu < 1) fprintf(stderr, "kernel_launch: occupancy query reports %d\n", per_cu);
        (void)hipGetLastError();
        grid = cus;
    }
    if (grid < 0) return;
    if (hipMemsetAsync((char*)d_ws + WS_CTL, 0, CTL_ZERO_BYTES, stream) != hipSuccess) { fprintf(stderr, "kernel_launch: hipMemsetAsync of the control words failed; nothing launched\n"); return; }
    Args a{};
    for (int i = 0; i < 13; ++i) a.in[i] = (const float*)d_in[i];
    a.out = (float*)d_out; a.ws = (unsigned char*)d_ws;
#if MK_MODE == 2
    a.ph_lo = 0; a.ph_hi = NPH; a.li = 0;
    hipLaunchKernelGGL(mk_fwd, dim3(grid), dim3(NWAVES * 64), LDS_BYTES, stream, a);
#else
    for (int p = 0; p < NPH; ++p) { a.ph_lo = p; a.ph_hi = p + 1; a.li = p; hipLaunchKernelGGL(mk_fwd, dim3(grid), dim3(NWAVES * 64), LDS_BYTES, stream, a); }
#endif
}
```

```cpp
#include <hip/hip_runtime.h>
#include <cstdio>
#include <cstdint>

typedef unsigned short bf16;
typedef short bf16x8 __attribute__((ext_vector_type(8)));
typedef float f32x4 __attribute__((ext_vector_type(4)));
typedef unsigned u32x4 __attribute__((ext_vector_type(4)));
typedef unsigned u32x2 __attribute__((ext_vector_type(2)));

constexpr int DM = 1024, BATCH = 8, SEQ = 4096, DEPTH = 2, HD = 64, NH = 6, CCH = 256;
constexpr int M = BATCH * SEQ;
constexpr int INW = 3078, PW = 3072, DFF = 2816, NGU = 2 * DFF;
constexpr int MBLK = 256, NBLK = SEQ / MBLK;
constexpr float RMS_EPS = 1e-6f;
constexpr float LOG2E = 1.4426950408889634f;
constexpr float C2 = 0.125f * LOG2E;
constexpr int P_MQ = 0, P_MK = 384, P_MV = 768, P_FQ = 1152, P_FK = 1536, P_FV = 1920, P_CB = 2304, P_CC = 2560, P_CH = 2816;
constexpr size_t MiB = 1u << 20;
constexpr size_t WS_CTL = 0;
constexpr size_t WS_W = 2 * MiB, W_LAYER = 25 * MiB;
constexpr size_t WO_IN = 0, WO_OUT = 6 * MiB, WO_GU = 8 * MiB, WO_D = 19 * MiB, WO_F = 24 * MiB + 512 * 1024;
constexpr size_t WS_LOGF = 52 * MiB, WS_CUM = 53 * MiB, WS_KMEAN = 54 * MiB;
constexpr size_t WS_XN = 56 * MiB, WS_MIXIN = 120 * MiB, WS_XA = 184 * MiB, WS_P = 312 * MiB, WS_H = WS_P, WS_END = 504 * MiB;

__constant__ int c_bucket[129] = {0, 1, 2, 3, 4, 5, 6, 7, 8, 9, 10, 11, 12, 13, 14, 15, 16, 16, 16, 17, 17, 18, 18, 18, 19, 19, 19, 20, 20, 20, 20, 21, 21, 21, 21, 22, 22, 22, 22, 22, 23, 23, 23, 23, 23, 23, 24, 24, 24, 24, 24, 24, 25, 25, 25, 25, 25, 25, 25, 26, 26, 26, 26, 26, 26, 26, 26, 27, 27, 27, 27, 27, 27, 27, 27, 27, 27, 28, 28, 28, 28, 28, 28, 28, 28, 28, 28, 29, 29, 29, 29, 29, 29, 29, 29, 29, 29, 29, 29, 30, 30, 30, 30, 30, 30, 30, 30, 30, 30, 30, 30, 30, 30, 31, 31, 31, 31, 31, 31, 31, 31, 31, 31, 31, 31, 31, 31, 31, 31};

__device__ __forceinline__ unsigned f2bf(float f) { unsigned u = __builtin_bit_cast(unsigned, f); return (u + 0x7fffu + ((u >> 16) & 1u)) >> 16; }
typedef float f32x2v __attribute__((ext_vector_type(2))); typedef __bf16 bf16x2v __attribute__((ext_vector_type(2)));
__device__ __forceinline__ unsigned pk2(float lo, float hi) { const f32x2v v = {lo, hi}; const bf16x2v b = __builtin_convertvector(v, bf16x2v); return __builtin_bit_cast(unsigned, b); }
__device__ __forceinline__ float bf2f(unsigned short b) { return __builtin_bit_cast(float, (unsigned)b << 16); }
#define DPPX(x_, ctrl_) __builtin_bit_cast(float, __builtin_amdgcn_update_dpp(0, __builtin_bit_cast(int, (x_)), (ctrl_), 0xf, 0xf, false))
#define WS_DPP(v, ctrl, rm) (v) = (v) + __builtin_bit_cast(float, __builtin_amdgcn_update_dpp(0, __builtin_bit_cast(int, (v)), (ctrl), (rm), 0xf, false))
__device__ __forceinline__ float wave_sum(float v) {
    WS_DPP(v, 0xB1, 0xf); WS_DPP(v, 0x4E, 0xf); WS_DPP(v, 0x141, 0xf); WS_DPP(v, 0x140, 0xf); WS_DPP(v, 0x142, 0xa); WS_DPP(v, 0x143, 0xc);
    return __builtin_bit_cast(float, __builtin_amdgcn_readlane(__builtin_bit_cast(int, v), 63));
}

__device__ __forceinline__ float log_sigmoid(float z) { return z < 0.f ? z - log1pf(expf(z)) : -log1pf(expf(-z)); }
namespace pg8 {
#define PG8_LAS __attribute__((address_space(3)))
typedef unsigned short bf16_t;
typedef short bf16x8 __attribute__((ext_vector_type(8)));
typedef float f32x4 __attribute__((ext_vector_type(4)));
typedef unsigned u32x4 __attribute__((ext_vector_type(4)));
constexpr int BM = 256, BK = 64, HALF = 128, HTB = HALF * BK * 2  , STAGE_BYTES = 8 * HTB, NXCD = 8, WGM = 8;

__host__ __device__ __forceinline__ int lds_byte(int r, int c) { const int st = (r >> 4) * 2 + (c >> 5), rr = r & 15, cc = c & 31, ob = rr * 64 + cc * 2; return st * 1024 + (ob ^ (((ob >> 9) & 1) << 5)); }
__host__ __device__ __forceinline__ void stage_rc(int b, int& R, int& C) { const int st = b / 1024, sb = b % 1024, swz = sb ^ (((sb >> 9) & 1) << 5); R = (st >> 1) * 16 + swz / 64; C = (st & 1) * 32 + (swz % 64) / 2; }
__host__ __device__ __forceinline__ int perm32(int rho) { const int n = rho >> 4, i = rho & 15; return 8 * (i >> 2) + 4 * n + (i & 3); }

struct Unit { int pm, pn; };
struct Gemm { const bf16_t* A; const bf16_t* Bt; int M, N, K; };

struct StaticOrder {
    int nM, nN, nwg, G, c;
    __host__ __device__ void init(int M, int N, int G_, int c_) { nM = M / BM; nN = N / BM; nwg = nM * nN; G = G_; c = c_; }
    __host__ __device__ bool next(int i, Unit& u) const {
        const long L = (long)i * G + c; if (L >= nwg) return false;
        int wgid = (int)L; { const int q = nwg / NXCD, r = nwg % NXCD, xcd = wgid % NXCD, off = wgid / NXCD; wgid = (xcd < r ? xcd * (q + 1) : r * (q + 1) + (xcd - r) * q) + off; }
        const int nig = WGM * nN, gid = wgid / nig, fm = gid * WGM, gsz = (nM - fm) < WGM ? (nM - fm) : WGM;
        u.pm = fm + ((wgid % nig) % gsz); u.pn = (wgid % nig) / gsz; return true;
    }
    __device__ __forceinline__ void a_ready(const Unit&) const {}
    __device__ __forceinline__ void done(const Unit&) const {}
};
__device__ __forceinline__ unsigned cvt_pk_bf16(float lo, float hi) { unsigned r; asm volatile("v_cvt_pk_bf16_f32 %0, %1, %2" : "=v"(r) : "v"(lo), "v"(hi)); return r; }
typedef float f32x2 __attribute__((ext_vector_type(2)));
struct EpiStoreBf16 {
    static constexpr bool PERM = true, AFTER_DRAIN = false;
    bf16_t* O; int ldc;
    __device__ __forceinline__ void operator()(const f32x4 (&acc)[2][2][4][2], const Unit& u, int wr, int wc, int fr, int fq) const {
        const int row0 = u.pm * BM + wr * 64 + fr, col0 = u.pn * BM + wc * 32 + 8 * fq;
#pragma unroll
        for (int ai = 0; ai < 2; ++ai)
#pragma unroll
            for (int m = 0; m < 4; ++m) { bf16_t* rowp = O + (size_t)(row0 + ai * HALF + m * 16) * ldc + col0;
#pragma unroll
                for (int bj = 0; bj < 2; ++bj) { const f32x4 v0 = acc[ai][bj][m][0], v1 = acc[ai][bj][m][1];
                    u32x4 w; w.x = cvt_pk_bf16(v0[0], v0[1]); w.y = cvt_pk_bf16(v0[2], v0[3]); w.z = cvt_pk_bf16(v1[0], v1[1]); w.w = cvt_pk_bf16(v1[2], v1[3]);
                    *(u32x4*)(rowp + bj * HALF) = w; } }
    }
};
struct EpiStoreF32 {
    static constexpr bool PERM = false, AFTER_DRAIN = false;
    float* C; int ldc;
    __device__ __forceinline__ void operator()(const f32x4 (&acc)[2][2][4][2], const Unit& u, int wr, int wc, int fr, int fq) const {
        const int row0 = u.pm * BM + wr * 64 + fr, col0 = u.pn * BM + wc * 32 + 4 * fq;
#pragma unroll
        for (int ai = 0; ai < 2; ++ai)
#pragma unroll
            for (int m = 0; m < 4; ++m) { float* rowp = C + (size_t)(row0 + ai * HALF + m * 16) * ldc + col0;
#pragma unroll
                for (int bj = 0; bj < 2; ++bj)
#pragma unroll
                    for (int n = 0; n < 2; ++n) *(f32x4*)(rowp + bj * HALF + n * 16) = acc[ai][bj][m][n]; }
    }
};
__device__ __forceinline__ float silu_mul(float g, float u) { return g * __builtin_amdgcn_rcpf(1.0f + __builtin_amdgcn_exp2f(g * -1.4426950408889634f)) * u; }
struct EpiSwiGLU {
    static constexpr bool PERM = true, AFTER_DRAIN = false;
    bf16_t* O; int ldc;
    __device__ __forceinline__ void operator()(f32x4 (&acc)[2][2][4][2], const Unit& u, int wr, int wc, int fr, int fq) const {
        const int row0 = u.pm * BM + wr * 64 + fr, col0 = u.pn * HALF + wc * 32 + 8 * fq;
#pragma unroll
        for (int ai = 0; ai < 2; ++ai)
#pragma unroll
            for (int m = 0; m < 4; ++m) { bf16_t* rowp = O + (size_t)(row0 + ai * HALF + m * 16) * ldc + col0;
                const f32x4 g0 = acc[ai][0][m][0], g1 = acc[ai][0][m][1], u0 = acc[ai][1][m][0], u1 = acc[ai][1][m][1];
                u32x4 w; w.x = cvt_pk_bf16(silu_mul(g0[0], u0[0]), silu_mul(g0[1], u0[1])); w.y = cvt_pk_bf16(silu_mul(g0[2], u0[2]), silu_mul(g0[3], u0[3]));
                w.z = cvt_pk_bf16(silu_mul(g1[0], u1[0]), silu_mul(g1[1], u1[1])); w.w = cvt_pk_bf16(silu_mul(g1[2], u1[2]), silu_mul(g1[3], u1[3]));
                *(u32x4*)rowp = w; }
    }
};
struct EpiInProj {
    static constexpr bool PERM = true, AFTER_DRAIN = false;
    bf16_t* O; int ldc; float* kmean; float* knp;
    __device__ __forceinline__ void operator()(f32x4 (&acc)[2][2][4][2], const Unit& u, int wr, int wc, int fr, int fq) const {
        const int row0 = u.pm * BM + wr * 64 + fr, col0 = u.pn * BM + wc * 32 + 8 * fq;
#pragma unroll
        for (int ai = 0; ai < 2; ++ai)
#pragma unroll
            for (int m = 0; m < 4; ++m) { bf16_t* rowp = O + (size_t)(row0 + ai * HALF + m * 16) * ldc + col0;
#pragma unroll
                for (int bj = 0; bj < 2; ++bj) { const f32x4 v0 = acc[ai][bj][m][0], v1 = acc[ai][bj][m][1];
                    u32x4 w; w.x = cvt_pk_bf16(v0[0], v0[1]); w.y = cvt_pk_bf16(v0[2], v0[3]); w.z = cvt_pk_bf16(v1[0], v1[1]); w.w = cvt_pk_bf16(v1[2], v1[3]);
                    *(u32x4*)(rowp + bj * HALF) = w; } }
        if (u.pn == 6 || u.pn == 7) {
#pragma unroll
            for (int bj = 0; bj < 2; ++bj) {
                if (u.pn == 7 && bj == 1) continue;
                const int head = 4 * (u.pn - 6) + 2 * bj + (wc >> 1);
#pragma unroll
                for (int ai = 0; ai < 2; ++ai) { float mx = 0.f;
#pragma unroll
                    for (int m = 0; m < 4; ++m) { const f32x4 v0 = acc[ai][bj][m][0], v1 = acc[ai][bj][m][1];
                        float ss = (v0[0] * v0[0] + v0[1] * v0[1]) + (v0[2] * v0[2] + v0[3] * v0[3]) + (v1[0] * v1[0] + v1[1] * v1[1]) + (v1[2] * v1[2] + v1[3] * v1[3]);
                        ss += __shfl_xor(ss, 16); ss += __shfl_xor(ss, 32); mx = fmaxf(mx, ss); }
                    mx = fmaxf(mx, __shfl_xor(mx, 1)); mx = fmaxf(mx, __shfl_xor(mx, 2)); mx = fmaxf(mx, __shfl_xor(mx, 4)); mx = fmaxf(mx, __shfl_xor(mx, 8));
                    if (fr == 0 && fq == 0) knp[((size_t)((u.pm >> 4) * 6 + head) * 64 + ((u.pm & 15) * 4 + ai * 2 + wr)) * 2 + (wc & 1)] = mx * 1.02f; }
            }
        }
        if (u.pn == 1 || u.pn == 2) {
#pragma unroll
            for (int bj = 0; bj < 2; ++bj) {
                if (u.pn == 1 && bj == 0) continue;
                const int cp = u.pn * BM + bj * HALF + wc * 32 + 8 * fq - 384;
                float* dst = kmean + ((size_t)((u.pm >> 4) * 6 + (cp >> 6)) * 16 + (u.pm & 15)) * 64 + (cp & 63);
#pragma unroll
                for (int n = 0; n < 2; ++n)
#pragma unroll
                    for (int i = 0; i < 4; ++i) { float s = 0.f;
#pragma unroll
                        for (int ai = 0; ai < 2; ++ai)
#pragma unroll
                            for (int m = 0; m < 4; ++m) s += acc[ai][bj][m][n][i];
                        s += DPPX(s, 0xB1); s += DPPX(s, 0x4E); s += DPPX(s, 0x141); s += DPPX(s, 0x140);
                        if (fr == 0) atomicAdd(dst + 4 * n + i, s * (1.0f / 256.0f)); }
            }
        }
    }
};
template <class Epi, class Sched, bool ALIGN_EPI = false, bool SP2 = false>
__device__ __forceinline__ void gemm_phase(PG8_LAS unsigned char* lds, const Gemm g, const Sched& S, const Epi& E) {
    int tid_ = threadIdx.x; asm volatile("" : "+v"(tid_));
    const int tid = tid_, wid = __builtin_amdgcn_readfirstlane(tid >> 6), lane = tid & 63, wr = wid >> 2, wc = wid & 3, fr = lane & 15, fq = lane >> 4;
    const int K = g.K, nt = K / BK;
    unsigned voffA[2], voffB[2];
#pragma unroll
    for (int i = 0; i < 2; ++i) { int R, C; stage_rc(tid * 16 + i * 8192, R, C); const int Rb = Epi::PERM ? ((R & ~31) + perm32(R & 31)) : R;
        voffA[i] = (unsigned)(R * K + C) * 2u; voffB[i] = (unsigned)(Rb * K + C) * 2u; }
    const size_t kstep = (size_t)(BK * 2);
    const size_t hstep = (size_t)HALF * K * 2;
    const size_t tstep = 2 * hstep;
    const unsigned ldsw = (unsigned)wid * 1024u;
    const int aoff = lds_byte(wr * 64 + fr, fq * 8), boff = lds_byte(wc * 32 + fr, fq * 8);
#define PG8_SA(b, h) (((b) * 2 + (h)) * HTB)
#define PG8_SB(b, h) ((4 + (b) * 2 + (h)) * HTB)
#define PG8_STAGE(bufoff, gbase, voff) do { _Pragma("unroll") for (int _i = 0; _i < 2; ++_i) \
        __builtin_amdgcn_global_load_lds((const unsigned*)((const char*)(gbase) + (voff)[_i]), (PG8_LAS unsigned*)(lds + (bufoff) + ldsw + _i * 8192), 16, 0, 0); } while (0)
#define PG8_LDA(dst, b, h) do { _Pragma("unroll") for (int m = 0; m < 4; ++m) _Pragma("unroll") for (int k = 0; k < 2; ++k) dst[m][k] = *(const PG8_LAS bf16x8*)(lds + PG8_SA(b, h) + aoff + m * 2048 + k * 1024); } while (0)
#define PG8_LDB(dst, b, h) do { _Pragma("unroll") for (int n = 0; n < 2; ++n) _Pragma("unroll") for (int k = 0; k < 2; ++k) dst[n][k] = *(const PG8_LAS bf16x8*)(lds + PG8_SB(b, h) + boff + n * 2048 + k * 1024); } while (0)
#define PG8_MMA(ai, bj, At, Bt) do { __builtin_amdgcn_s_setprio(1); _Pragma("unroll") for (int m = 0; m < 4; ++m) _Pragma("unroll") for (int n = 0; n < 2; ++n) _Pragma("unroll") for (int k = 0; k < 2; ++k) \
        acc[ai][bj][m][n] = __builtin_amdgcn_mfma_f32_16x16x32_bf16(Bt[n][k], At[m][k], acc[ai][bj][m][n], 0, 0, 0); __builtin_amdgcn_s_setprio(0); } while (0)
#define PG8_WAIT_V(n) asm volatile("s_waitcnt vmcnt(" #n ")" ::: "memory")
#define PG8_WAIT_L(n) asm volatile("s_waitcnt lgkmcnt(" #n ")" ::: "memory")
#define PG8_BAR __builtin_amdgcn_s_barrier()
#define PG8_SCHED __builtin_amdgcn_sched_barrier(0)
    Unit cur, nxt; int ui = 0;
    if (!S.next(0, cur)) return;
    f32x4 acc[2][2][4][2];
#pragma unroll
    for (int a = 0; a < 2; ++a)
#pragma unroll
        for (int b = 0; b < 2; ++b)
#pragma unroll
            for (int m = 0; m < 4; ++m)
#pragma unroll
                for (int n = 0; n < 2; ++n) acc[a][b][m][n] = (f32x4){0.f, 0.f, 0.f, 0.f};
    bf16x8 At[4][2], B0[2][2], B1[2][2];
    const char* cA = (const char*)g.A + (size_t)cur.pm * tstep; const char* cB = (const char*)g.Bt + (size_t)cur.pn * tstep;
    S.a_ready(cur);
    if constexpr (SP2) {
        PG8_STAGE(PG8_SB(0, 0), cB, voffB); PG8_STAGE(PG8_SB(0, 1), cB + hstep, voffB); PG8_STAGE(PG8_SA(0, 0), cA, voffA); PG8_STAGE(PG8_SA(0, 1), cA + hstep, voffA);
        if (wr == 1) PG8_BAR;
        PG8_WAIT_V(2); PG8_BAR;
        PG8_STAGE(PG8_SB(1, 0), cB + kstep, voffB); PG8_STAGE(PG8_SA(1, 0), cA + kstep, voffA); PG8_STAGE(PG8_SB(1, 1), cB + hstep + kstep, voffB);
        PG8_WAIT_V(6); PG8_BAR;
    } else {
        PG8_STAGE(PG8_SB(0, 0), cB, voffB); PG8_STAGE(PG8_SA(0, 0), cA, voffA); PG8_STAGE(PG8_SB(0, 1), cB + hstep, voffB); PG8_STAGE(PG8_SA(0, 1), cA + hstep, voffA);
        if (wr == 1) PG8_BAR;
        PG8_WAIT_V(4); PG8_BAR;
        PG8_STAGE(PG8_SB(1, 0), cB + kstep, voffB); PG8_STAGE(PG8_SA(1, 0), cA + kstep, voffA); PG8_STAGE(PG8_SB(1, 1), cB + hstep + kstep, voffB);
        PG8_WAIT_V(6); PG8_BAR;
    }
    for (;;) {
        const bool has_next = S.next(ui + 1, nxt);
        const char* nA = has_next ? (const char*)g.A + (size_t)nxt.pm * tstep : cA; const char* nB = has_next ? (const char*)g.Bt + (size_t)nxt.pn * tstep : cB;
        for (int t = 0; t < nt; t += 2) {
            const bool last = (t == nt - 2);
            const char* a1 = cA + (size_t)(t + 1) * kstep;
            const char* a2 = last ? nA : cA + (size_t)(t + 2) * kstep; const char* b2 = last ? nB : cB + (size_t)(t + 2) * kstep;
            const char* a3 = a2 + kstep; const char* b3 = b2 + kstep;
            if (last && has_next) S.a_ready(nxt);
            if constexpr (SP2) {
            PG8_LDB(B0, 0, 0); PG8_LDB(B1, 0, 1); PG8_SCHED; PG8_LDA(At, 0, 0); PG8_STAGE(PG8_SA(1, 1), a1 + hstep, voffA);
            PG8_WAIT_V(8); PG8_WAIT_L(0); PG8_BAR; PG8_MMA(0, 0, At, B0); PG8_MMA(0, 1, At, B1); PG8_BAR; PG8_SCHED;
            PG8_LDA(At, 0, 1); PG8_STAGE(PG8_SB(0, 0), b2, voffB); PG8_STAGE(PG8_SB(0, 1), b2 + hstep, voffB); PG8_STAGE(PG8_SA(0, 0), a2, voffA);
            PG8_WAIT_V(8); PG8_WAIT_L(0); PG8_BAR; PG8_MMA(1, 0, At, B0); PG8_MMA(1, 1, At, B1); PG8_BAR; PG8_SCHED;
            PG8_LDB(B0, 1, 0); PG8_LDB(B1, 1, 1); PG8_SCHED; PG8_LDA(At, 1, 0); PG8_STAGE(PG8_SA(0, 1), a2 + hstep, voffA);
            PG8_WAIT_V(8); PG8_WAIT_L(0); PG8_BAR; PG8_MMA(0, 0, At, B0); PG8_MMA(0, 1, At, B1); PG8_BAR; PG8_SCHED;
            PG8_LDA(At, 1, 1); PG8_STAGE(PG8_SB(1, 0), b3, voffB); PG8_STAGE(PG8_SB(1, 1), b3 + hstep, voffB); PG8_STAGE(PG8_SA(1, 0), a3, voffA);
            PG8_WAIT_V(8); PG8_WAIT_L(0); PG8_BAR; PG8_MMA(1, 0, At, B0); PG8_MMA(1, 1, At, B1); PG8_BAR; PG8_SCHED;
            } else {
            PG8_LDB(B0, 0, 0); PG8_SCHED; PG8_LDA(At, 0, 0); PG8_STAGE(PG8_SA(1, 1), a1 + hstep, voffA);
            PG8_WAIT_L(8); PG8_BAR; PG8_WAIT_L(0); PG8_MMA(0, 0, At, B0); PG8_BAR; PG8_SCHED;
            PG8_LDB(B1, 0, 1); PG8_STAGE(PG8_SB(0, 0), b2, voffB);
            PG8_BAR; PG8_WAIT_L(0); PG8_MMA(0, 1, At, B1); PG8_BAR;
            PG8_LDA(At, 0, 1); PG8_STAGE(PG8_SA(0, 0), a2, voffA);
            PG8_BAR; PG8_WAIT_L(0); PG8_MMA(1, 0, At, B0); PG8_BAR; PG8_SCHED;
            PG8_STAGE(PG8_SB(0, 1), b2 + hstep, voffB);
            PG8_WAIT_V(6); PG8_BAR; PG8_MMA(1, 1, At, B1); PG8_BAR;
            PG8_LDB(B0, 1, 0); PG8_SCHED; PG8_LDA(At, 1, 0); PG8_STAGE(PG8_SA(0, 1), a2 + hstep, voffA);
            PG8_WAIT_L(8); PG8_BAR; PG8_WAIT_L(0); PG8_MMA(0, 0, At, B0); PG8_BAR; PG8_SCHED;
            PG8_LDB(B1, 1, 1); PG8_STAGE(PG8_SB(1, 0), b3, voffB);
            PG8_BAR; PG8_WAIT_L(0); PG8_MMA(0, 1, At, B1); PG8_BAR;
            PG8_LDA(At, 1, 1); PG8_STAGE(PG8_SA(1, 0), a3, voffA);
            PG8_BAR; PG8_WAIT_L(0); PG8_MMA(1, 0, At, B0); PG8_BAR; PG8_SCHED;
            PG8_STAGE(PG8_SB(1, 1), b3 + hstep, voffB);
            PG8_WAIT_V(6); PG8_BAR; PG8_MMA(1, 1, At, B1); PG8_BAR;
            }
        }
        if constexpr (ALIGN_EPI) { if (wr == 0) PG8_BAR; }
        if constexpr (!Epi::AFTER_DRAIN) { E(acc, cur, wr, wc, fr, fq); S.done(cur); }
        if (!has_next) break;
#pragma unroll
        for (int a = 0; a < 2; ++a)
#pragma unroll
            for (int b = 0; b < 2; ++b)
#pragma unroll
                for (int m = 0; m < 4; ++m)
#pragma unroll
                    for (int n = 0; n < 2; ++n) acc[a][b][m][n] = (f32x4){0.f, 0.f, 0.f, 0.f};
        cur = nxt; cA = nA; cB = nB; ++ui;
        if constexpr (ALIGN_EPI) { if (wr == 1) PG8_BAR; }
    }
    PG8_WAIT_V(0);
    if constexpr (!ALIGN_EPI) { if (wr == 0) PG8_BAR; }
    PG8_BAR;
    if constexpr (Epi::AFTER_DRAIN) { E.fused(acc, cur, wr, wc, fr, fq, lds, wid, lane); S.done(cur); }
#undef PG8_SA
#undef PG8_SB
#undef PG8_STAGE
#undef PG8_LDA
#undef PG8_LDB
#undef PG8_MMA
#undef PG8_WAIT_V
#undef PG8_WAIT_L
#undef PG8_BAR
#undef PG8_SCHED
}
}

#include <hip/hip_bf16.h>
#include <cmath>
namespace attn_body {
using bf16=__hip_bfloat16;
using bf16x8=__attribute__((ext_vector_type(8)))short;
using s16x4=__attribute__((ext_vector_type(4)))short;
using f32x16=__attribute__((ext_vector_type(16)))float;
using u32x4=__attribute__((ext_vector_type(4)))unsigned;
using f32x4_t=__attribute__((ext_vector_type(4)))float;
constexpr int D=64;
constexpr int NW=8,QBLK=32,QB=QBLK*NW,KVBLK=64;
constexpr int QP=3072, OPITCH=1024;
constexpr int AUX_R0=0, AUX_INFO=1024, AUX_TAB=2048, AUX_BYTES=2048+16384+1024;
__device__ __forceinline__ int crow(int r,int hi){return (r&3)+8*(r>>2)+4*hi;}
#define SBAR() __builtin_amdgcn_sched_barrier(0)
__device__ __forceinline__ void cmask(f32x16&p0,f32x16&p1,int jb,int qrel,int hi){
  const float NEG=-INFINITY; int kb=64*jb+4*hi;
  #pragma unroll
  for(int r=0;r<16;++r){int kv=kb+(r&3)+8*(r>>2); if(kv>qrel)p0[r]=NEG; if(kv+32>qrel)p1[r]=NEG;}
}

constexpr int NSLOT=3, SLOTB=8192;
constexpr int LDS_K=0, LDS_V=NSLOT*SLOTB, LDS_WS=2*NSLOT*SLOTB, LDS_OST=LDS_WS+NW*64*4, LDS_BYTES=LDS_OST+NW*4096;
constexpr float C2=0.125f*1.4426950408889634f;
__device__ __forceinline__ void glds16(const void*gsrc,unsigned lds_dst){unsigned keep;
  asm volatile("s_mov_b32 %0, m0\n\ts_mov_b32 m0, %2\n\ts_nop 0\n\tglobal_load_lds_dwordx4 %1, off\n\ts_mov_b32 m0, %0":"=&s"(keep):"v"(gsrc),"s"(lds_dst):"memory");}
__device__ __forceinline__ float max3f(float a,float b,float c){float r;asm("v_max3_f32 %0, %1, %2, %3":"=v"(r):"v"(a),"v"(b),"v"(c));return r;}
__device__ __forceinline__ float max2f(float a,float b){float r;asm("v_max_f32_e32 %0, %1, %2":"=v"(r):"v"(a),"v"(b));return r;}
__device__ __forceinline__ float fadd_s(float a,float b){float r;asm("v_add_f32_e32 %0, %1, %2":"=v"(r):"v"(a),"v"(b));return r;}
__device__ __forceinline__ float fsub_s(float a,float b){float r;asm("v_sub_f32_e32 %0, %1, %2":"=v"(r):"v"(a),"v"(b));return r;}
typedef float f32x2_t __attribute__((ext_vector_type(2))); typedef __bf16 bf16x2_t __attribute__((ext_vector_type(2)));
__device__ __forceinline__ unsigned cvtpk_s(float lo,float hi){f32x2_t v={lo,hi};bf16x2_t b=__builtin_convertvector(v,bf16x2_t);return __builtin_bit_cast(unsigned,b);}
#define WAIT_BAR(N) asm volatile("s_waitcnt vmcnt(" #N ") lgkmcnt(0)\n\ts_barrier":::"memory")

__device__ __forceinline__ void qkt(f32x16&p0,f32x16&p1,const char*Kslot,const bf16x8*qr,const f32x16&negm,int r32,int hi){
  const char*kb=Kslot+hi*1024+r32*16;
  #pragma unroll
  for(int d0=0;d0<4;++d0){
    const bf16x8 b0=*reinterpret_cast<const bf16x8*>(kb+d0*2048);
    const bf16x8 b1=*reinterpret_cast<const bf16x8*>(kb+d0*2048+512);
    if(d0==0){p0=__builtin_amdgcn_mfma_f32_32x32x16_bf16(b0,qr[0],negm,0,0,0);p1=__builtin_amdgcn_mfma_f32_32x32x16_bf16(b1,qr[0],negm,0,0,0);}
    else{p0=__builtin_amdgcn_mfma_f32_32x32x16_bf16(b0,qr[d0],p0,0,0,0);p1=__builtin_amdgcn_mfma_f32_32x32x16_bf16(b1,qr[d0],p1,0,0,0);}}
}
typedef __attribute__((address_space(3))) const char* lds_cptr;
typedef short v4i16_t __attribute__((ext_vector_type(4)));
__device__ __forceinline__ void kload8(bf16x8*kf,lds_cptr kp){
  kf[0]=*(const __attribute__((address_space(3))) bf16x8*)(kp);      kf[1]=*(const __attribute__((address_space(3))) bf16x8*)(kp+512);
  kf[2]=*(const __attribute__((address_space(3))) bf16x8*)(kp+2048); kf[3]=*(const __attribute__((address_space(3))) bf16x8*)(kp+2560);
  kf[4]=*(const __attribute__((address_space(3))) bf16x8*)(kp+4096); kf[5]=*(const __attribute__((address_space(3))) bf16x8*)(kp+4608);
  kf[6]=*(const __attribute__((address_space(3))) bf16x8*)(kp+6144); kf[7]=*(const __attribute__((address_space(3))) bf16x8*)(kp+6656);
}
__device__ __forceinline__ void kload2(bf16x8*kf,lds_cptr kp,int j){ kf[2*j]=*(const __attribute__((address_space(3))) bf16x8*)(kp+j*2048); kf[2*j+1]=*(const __attribute__((address_space(3))) bf16x8*)(kp+j*2048+512); }
__device__ __forceinline__ s16x4 vtr(lds_cptr p){ return __builtin_bit_cast(s16x4,__builtin_amdgcn_ds_read_tr16_b64_v4i16((__attribute__((address_space(3))) v4i16_t*)p)); }
__device__ __forceinline__ float rowmax(const f32x16&p0,const f32x16&p1){
  float a=max3f(p0[0],p0[1],p1[0]),b=max3f(p0[2],p0[3],p1[1]);a=max3f(a,p1[2],p1[3]);
  #pragma unroll
  for(int r=4;r<16;r+=4){a=max3f(a,p0[r],p0[r+1]);b=max3f(b,p0[r+2],p0[r+3]);a=max3f(a,p1[r],p1[r+1]);b=max3f(b,p1[r+2],p1[r+3]);}
  const float m=max2f(a,b);
  auto rr=__builtin_amdgcn_permlane32_swap(__float_as_uint(m),__float_as_uint(m),false,false);
  return max2f(__uint_as_float(rr[0]),__uint_as_float(rr[1]));
}
__device__ __forceinline__ void pv(f32x16*o,int vb,bf16x8 pa0,bf16x8 pa1,bf16x8 pa2,bf16x8 pa3){
  #pragma unroll
  for(int d0=0;d0<2;++d0){s16x4 lo[4],hi[4];
    #pragma unroll
    for(int ks=0;ks<4;++ks){
      asm volatile("ds_read_b64_tr_b16 %0,%1 offset:%c2":"=&v"(lo[ks]):"v"(vb),"i"(d0*4096+ks*1024):"memory");
      asm volatile("ds_read_b64_tr_b16 %0,%1 offset:%c2":"=&v"(hi[ks]):"v"(vb),"i"(d0*4096+ks*1024+512):"memory");}
    asm volatile("s_waitcnt lgkmcnt(0)":::"memory");SBAR();
    #define PK(k) (bf16x8){lo[k][0],lo[k][1],lo[k][2],lo[k][3],hi[k][0],hi[k][1],hi[k][2],hi[k][3]}
    o[d0]=__builtin_amdgcn_mfma_f32_32x32x16_bf16(pa0,PK(0),o[d0],0,0,0);
    o[d0]=__builtin_amdgcn_mfma_f32_32x32x16_bf16(pa1,PK(1),o[d0],0,0,0);
    o[d0]=__builtin_amdgcn_mfma_f32_32x32x16_bf16(pa2,PK(2),o[d0],0,0,0);
    o[d0]=__builtin_amdgcn_mfma_f32_32x32x16_bf16(pa3,PK(3),o[d0],0,0,0);
    #undef PK
  }
}

#ifndef ATTN_STORE16
#define ATTN_STORE16(p,v) (*(u32x4*)(p)=(v))
#endif
template<int KIND,int THRL> __device__ __forceinline__ void attn_unit(const bf16*Qg,const bf16*__restrict__ Kg,const bf16*__restrict__ Vg,bf16*Og,const int NT,const int tile0,const int q0,const int qb,char*shm,lds_cptr aux){
  int tid_=threadIdx.x; asm volatile("":"+v"(tid_));
  const int tid=tid_,lane=tid&63,r32=lane&31,hi=lane>>5; const int wid=__builtin_amdgcn_readfirstlane(tid>>6);
  const bf16*Qw=Qg+(long)(wid*QBLK)*QP;
  const bf16*Kh=Kg,*Vh=Vg;
  const unsigned lds0=(unsigned)(uintptr_t)shm;
  float*wsf=(float*)(shm+LDS_WS)+wid*64;
  const bf16*ksrc=Kh+(long)lane*QP+wid*8;
  const bf16*vsrc=Vh+(long)(16*(wid&3)+(lane>>2))*QP+(wid>>2)*32+(lane&3)*8;
  const unsigned kdst=lds0+LDS_K+wid*1024, vdst=lds0+LDS_V+wid*1024;
  #define DMA_K(t,slot) glds16(ksrc+(long)(t)*KVBLK*QP,(unsigned)__builtin_amdgcn_readfirstlane(kdst+(slot)))
  #define DMA_V(t,slot) glds16(vsrc+(long)(t)*KVBLK*QP,(unsigned)__builtin_amdgcn_readfirstlane(vdst+(slot)))
  const int vb0=(int)(lds0+LDS_V)+((lane>>4)&1)*32+(lane&3)*8+(4*hi+((lane&15)>>2))*64;
  const char*Kbase=shm+LDS_K; bf16x8 kf[8];
  const lds_cptr shm3=(lds_cptr)shm; const lds_cptr kp0=shm3+LDS_K+hi*1024+r32*16; const lds_cptr vp0=shm3+LDS_V+((lane>>4)&1)*32+(lane&3)*8+(4*hi+((lane&15)>>2))*64;
  DMA_K(0,0);DMA_V(0,0);DMA_K(1,SLOTB);
  bf16x8 qr[4];
  #pragma unroll
  for(int d0=0;d0<4;++d0)qr[d0]=*reinterpret_cast<const bf16x8*>(&Qw[(long)r32*QP+d0*16+hi*8]);
  typedef __attribute__((address_space(3))) const float* lds_fptr; typedef __attribute__((address_space(3))) const unsigned* lds_uptr; typedef __attribute__((address_space(3))) const f32x4_t* lds_f4ptr;
  const int myrow=wid*QBLK+r32; const lds_fptr aux_tab=(lds_fptr)(aux+AUX_TAB);
  float mhat=((lds_fptr)(aux+AUX_R0))[myrow],l_reg=0.f; const unsigned rinfo=((lds_uptr)(aux+AUX_INFO))[myrow];
  f32x16 o[2];o[0]=f32x16{};o[1]=f32x16{};f32x16 negm=f32x16{};
  #define NEGM_SET(tn) do{ if(KIND==1){ const int bn_=(tile0+(tn))>>2; const float nv_=(bn_<qb&&!((rinfo>>bn_)&1u))?-INFINITY:-mhat; _Pragma("unroll") for(int r=0;r<16;++r)negm[r]=nv_; asm volatile("":"+v"(negm)); } }while(0)
  NEGM_SET(0);
  const float NEGI=-INFINITY;
  #define CFENCE() asm volatile("":::"memory")
  #define POST(C0,C1,t) do{ \
    if(KIND==0){ const float nm_=-mhat; asm volatile("s_nop 15\n\ts_nop 7":"+v"(C0),"+v"(C1));   \
      const lds_f4ptr cp_=(lds_f4ptr)(aux_tab+((tile0+(t))*64+4*hi)); \
      _Pragma("unroll") for(int g_=0;g_<4;++g_){ const f32x4_t a_=cp_[2*g_],b_=cp_[8+2*g_]; \
        _Pragma("unroll") for(int i_=0;i_<4;++i_){ C0[4*g_+i_]=fadd_s(C0[4*g_+i_],fsub_s(nm_,a_[i_])); C1[4*g_+i_]=fadd_s(C1[4*g_+i_],fsub_s(nm_,b_[i_])); } if(g_==1)CFENCE(); } } \
    else { const int blk_=(tile0+(t))>>2; \
      const int dw_=(q0+wid*QBLK)-(tile0+(t))*64;     \
      if(blk_>=qb-1&&dw_<176&&dw_>-32){ asm volatile("s_nop 15\n\ts_nop 7":"+v"(C0),"+v"(C1)); const int db_=(q0+myrow)-((tile0+(t))*64+4*hi); \
        _Pragma("unroll") for(int r=0;r<16;++r){ const int d_=db_-((r&3)+8*(r>>2)); const int i0_=d_<0?0:(d_>128?128:d_), e_=d_-32, i1_=e_<0?0:(e_>128?128:e_); C0[r]=fadd_s(C0[r],aux_tab[i0_]); C1[r]=fadd_s(C1[r],aux_tab[i1_]); if((r&3)==3)CFENCE(); } } } \
  }while(0)
  const int qrel=wid*QBLK+r32;
  #define CMASK(P0,P1,t) do{int jb_=(t)-(NT-4); if(jb_>=0)cmask(P0,P1,jb_,qrel,hi);}while(0)
  bool resc=false;
  #define START(P0,P1) do{ const float rm=rowmax(P0,P1); resc=false; \
    { const float dl=max2f(rm,0.f); mhat=fadd_s(mhat,dl); \
      _Pragma("unroll") for(int r=0;r<16;++r){P0[r]=fsub_s(P0[r],dl);P1[r]=fsub_s(P1[r],dl);} \
      NEGM_SET(1); } \
    _Pragma("unroll") for(int r=0;r<16;++r)P0[r]=__builtin_amdgcn_exp2f(P0[r]); }while(0)
  #define RESC() do{ if(resc){ asm volatile("s_waitcnt lgkmcnt(0)":::"memory"); \
      _Pragma("unroll") for(int d_=0;d_<2;++d_) _Pragma("unroll") for(int r=0;r<16;++r)o[d_][r]*=wsf[crow(r,hi)]; } }while(0)
  f32x16 pA0,pA1,pB0,pB1;
  int sl_prev=0,sl_cur=0,sl_next=SLOTB;
  #define ROT() do{sl_prev=sl_cur;sl_cur=sl_next;sl_next=(sl_next==(NSLOT-1)*SLOTB)?0:sl_next+SLOTB;}while(0)
  DMA_K(2,2*SLOTB);
  WAIT_BAR(3);
  qkt(pA0,pA1,Kbase,qr,negm,r32,hi);asm volatile("s_nop 15\n\ts_nop 7":"+v"(pA0),"+v"(pA1));CMASK(pA0,pA1,0);POST(pA0,pA1,0);
  START(pA0,pA1);
  _Pragma("unroll") for(int r=0;r<16;++r)pA1[r]=__builtin_amdgcn_exp2f(pA1[r]);
  WAIT_BAR(0);
  DMA_K(3,0);DMA_V(1,SLOTB);
  ROT();
  kload8(kf,kp0+sl_cur);
  WAIT_BAR(2);
  s16x4 vlo[8],vhi[8]; u32x4 pw0,pw1,pw2,pw3;
  #define PKW(P,B) cvtpk_s(P[B],P[B+1])
  #define PAF(k) __builtin_bit_cast(bf16x8,pw##k)
  #define VFR(i) (bf16x8){vlo[i][0],vlo[i][1],vlo[i][2],vlo[i][3],vhi[i][0],vhi[i][1],vhi[i][2],vhi[i][3]}
  #define PIN(x) asm volatile("":"+v"(x))
  #define MX3(a,b,c) __builtin_fmaxf(__builtin_fmaxf((a),(b)),(c))
  #define GAPA(MF,A0,A1,A2,A3,W0,W1,PW) do{ MF; sacc+=A0; sacc+=A1; sacc+=A2; sacc+=A3; PIN(sacc); W0; W1; PIN(PW); SBAR(); }while(0)
  #define EX(v) __builtin_amdgcn_exp2f(v)
  #define GAPB(MF,X,B) do{ MF; X[B]=EX(X[B]); X[B+1]=EX(X[B+1]); X[B+2]=EX(X[B+2]); X[B+3]=EX(X[B+3]); PIN(X); SBAR(); }while(0)
  #define VRD(i) do{ vlo[i]=vtr(vp_+(((i)>>2)*4096+((i)&3)*1024)); vhi[i]=vtr(vp_+(((i)>>2)*4096+((i)&3)*1024+512)); }while(0)
  #define KRD(G,j) do{ if(G){ kload2(kf,kp0+sl_next,j); SBAR(); } }while(0)
  #define STEP(C0,C1,P0,P1,t,GK,GV,GL) do{ SBAR(); \
    const lds_cptr vp_=vp0+sl_prev; \
    VRD(0); SBAR(); float sacc=(P0[0]+P0[1]); \
    GAPA(C0=__builtin_amdgcn_mfma_f32_32x32x16_bf16(kf[0],qr[0],negm,0,0,0), P0[2],P0[3],P0[4],P0[5],     pw0[0]=PKW(P0,0), pw0[1]=PKW(P0,2), pw0); \
    VRD(4); SBAR(); GAPA(C1=__builtin_amdgcn_mfma_f32_32x32x16_bf16(kf[1],qr[0],negm,0,0,0), P0[6],P0[7],P0[8],P0[9],     pw0[2]=PKW(P0,4), pw0[3]=PKW(P0,6), pw0); \
    VRD(1); SBAR(); GAPA(C0=__builtin_amdgcn_mfma_f32_32x32x16_bf16(kf[2],qr[1],C0,0,0,0),   P0[10],P0[11],P0[12],P0[13], pw1[0]=PKW(P0,8), pw1[1]=PKW(P0,10), pw1); \
    VRD(5); SBAR(); GAPA(C1=__builtin_amdgcn_mfma_f32_32x32x16_bf16(kf[3],qr[1],C1,0,0,0),   P0[14],P0[15],P1[0],P1[1],   pw1[2]=PKW(P0,12),pw1[3]=PKW(P0,14), pw1); \
    VRD(2); SBAR(); GAPA(C0=__builtin_amdgcn_mfma_f32_32x32x16_bf16(kf[4],qr[2],C0,0,0,0),   P1[2],P1[3],P1[4],P1[5],     pw2[0]=PKW(P1,0), pw2[1]=PKW(P1,2), pw2); \
    VRD(6); SBAR(); GAPA(C1=__builtin_amdgcn_mfma_f32_32x32x16_bf16(kf[5],qr[2],C1,0,0,0),   P1[6],P1[7],P1[8],P1[9],     pw2[2]=PKW(P1,4), pw2[3]=PKW(P1,6), pw2); \
    VRD(3); SBAR(); GAPA(C0=__builtin_amdgcn_mfma_f32_32x32x16_bf16(kf[6],qr[3],C0,0,0,0),   P1[10],P1[11],P1[12],P1[13], pw3[0]=PKW(P1,8), pw3[1]=PKW(P1,10), pw3); \
    VRD(7); SBAR(); GAPA(C1=__builtin_amdgcn_mfma_f32_32x32x16_bf16(kf[7],qr[3],C1,0,0,0),   P1[14],P1[15],0.f,0.f,       pw3[2]=PKW(P1,12),pw3[3]=PKW(P1,14), pw3); \
    l_reg+=sacc; \
    if(GK){DMA_K((t)+3,sl_cur);} if(GV){DMA_V((t)+1,sl_next);} \
    CMASK(C0,C1,t); POST(C0,C1,t); \
    { float a=MX3(C0[0],C0[1],C1[0]),b=MX3(C0[2],C0[3],C1[1]); a=MX3(a,C1[2],C1[3]); \
      _Pragma("unroll") for(int r=4;r<16;r+=4){a=MX3(a,C0[r],C0[r+1]);b=MX3(b,C0[r+2],C0[r+3]);a=MX3(a,C1[r],C1[r+1]);b=MX3(b,C1[r+2],C1[r+3]);} \
      float rm=__builtin_fmaxf(a,b); { auto rr=__builtin_amdgcn_permlane32_swap(__float_as_uint(rm),__float_as_uint(rm),false,false); rm=__builtin_fmaxf(__uint_as_float(rr[0]),__uint_as_float(rr[1])); } \
      resc=false; \
      if(__builtin_expect(__any(rm>(float)THRL),0)){ const float dl=__builtin_fmaxf(rm,0.f); mhat+=dl; \
        _Pragma("unroll") for(int r=0;r<16;++r){C0[r]-=dl;C1[r]-=dl;} \
        const float f=__builtin_amdgcn_exp2f(-dl); l_reg*=f; if(hi==0)wsf[r32]=f; resc=true; } \
      if(KIND==1&&(resc||((tile0+(t)+1)&3)==0)) NEGM_SET((t)+1); } \
    SBAR(); \
    GAPB(o[0]=__builtin_amdgcn_mfma_f32_32x32x16_bf16(PAF(0),VFR(0),o[0],0,0,0), C0,0); \
    GAPB(o[1]=__builtin_amdgcn_mfma_f32_32x32x16_bf16(PAF(0),VFR(4),o[1],0,0,0), C0,4); \
    KRD(GL,0); GAPB(o[0]=__builtin_amdgcn_mfma_f32_32x32x16_bf16(PAF(1),VFR(1),o[0],0,0,0), C0,8); \
    KRD(GL,1); GAPB(o[1]=__builtin_amdgcn_mfma_f32_32x32x16_bf16(PAF(1),VFR(5),o[1],0,0,0), C0,12); \
    KRD(GL,2); GAPB(o[0]=__builtin_amdgcn_mfma_f32_32x32x16_bf16(PAF(2),VFR(2),o[0],0,0,0), C1,0); \
    KRD(GL,3); GAPB(o[1]=__builtin_amdgcn_mfma_f32_32x32x16_bf16(PAF(2),VFR(6),o[1],0,0,0), C1,4); \
    GAPB(o[0]=__builtin_amdgcn_mfma_f32_32x32x16_bf16(PAF(3),VFR(3),o[0],0,0,0), C1,8); \
    GAPB(o[1]=__builtin_amdgcn_mfma_f32_32x32x16_bf16(PAF(3),VFR(7),o[1],0,0,0), C1,12); \
    }while(0)
  int t=1;
  #undef CMASK
  #define CMASK(P0,P1,t) do{}while(0)
  for(;t+5<NT;t+=2){
    STEP(pB0,pB1,pA0,pA1,t,true,true,true);     WAIT_BAR(2); RESC(); ROT();
    STEP(pA0,pA1,pB0,pB1,t+1,true,true,true);   WAIT_BAR(2); RESC(); ROT();
  }
  #undef CMASK
  #define CMASK(P0,P1,t) do{int jb_=(t)-(NT-4); if(jb_>=0)cmask(P0,P1,jb_,qrel,hi);}while(0)
  #define ENDW(tt) do{ if((tt)+3<NT){WAIT_BAR(2);} else if((tt)+2<NT){WAIT_BAR(1);} else {WAIT_BAR(0);} }while(0)
  for(;t+1<NT;t+=2){
    STEP(pB0,pB1,pA0,pA1,t,(t+3<NT),(t+1<NT),(t+1<NT));       ENDW(t);   RESC(); ROT();
    STEP(pA0,pA1,pB0,pB1,t+1,(t+4<NT),(t+2<NT),(t+2<NT));     ENDW(t+1); RESC(); ROT();
  }
  STEP(pB0,pB1,pA0,pA1,NT-1,false,false,false); RESC();
  { float sacc=pB0[0]+pB0[1]; _Pragma("unroll") for(int r=2;r<16;++r)sacc+=pB0[r]; _Pragma("unroll") for(int r=0;r<16;++r)sacc+=pB1[r]; l_reg+=sacc;
    pw0=(u32x4){PKW(pB0,0),PKW(pB0,2),PKW(pB0,4),PKW(pB0,6)};pw1=(u32x4){PKW(pB0,8),PKW(pB0,10),PKW(pB0,12),PKW(pB0,14)};pw2=(u32x4){PKW(pB1,0),PKW(pB1,2),PKW(pB1,4),PKW(pB1,6)};pw3=(u32x4){PKW(pB1,8),PKW(pB1,10),PKW(pB1,12),PKW(pB1,14)};
    SBAR(); pv(o,vb0+sl_cur,PAF(0),PAF(1),PAF(2),PAF(3)); }
  #undef PKW
  #undef PAF
  #undef VFR
  #undef PIN
  #undef MX3
  #undef GAPA
  #undef GAPB
  #undef EX
  #undef VRD
  #undef KRD
  #undef STEP
  #undef ENDW
  {auto rr=__builtin_amdgcn_permlane32_swap(__float_as_uint(l_reg),__float_as_uint(l_reg),false,false);l_reg=__uint_as_float(rr[0])+__uint_as_float(rr[1]);}
  if(hi==0)wsf[32+r32]=l_reg;asm volatile("s_waitcnt lgkmcnt(0)":::"memory");
  float rli[16];
  #pragma unroll
  for(int r=0;r<16;++r)rli[r]=__builtin_amdgcn_rcpf(wsf[32+crow(r,hi)]);
  bf16*Ow=Og+(long)(wid*QBLK)*OPITCH;
  { bf16*stg=(bf16*)(shm+LDS_OST)+wid*2048;
    #pragma unroll
    for(int r=0;r<16;++r){const int orow=crow(r,hi);
      #pragma unroll
      for(int d0=0;d0<2;++d0)stg[orow*64+d0*32+r32]=__float2bfloat16(o[d0][r]*rli[r]);}
    asm volatile("s_waitcnt lgkmcnt(0)":::"memory");
    #pragma unroll
    for(int i=0;i<4;++i){const int row=i*8+(lane>>3),ch=lane&7; const u32x4 v=*(const u32x4*)(stg+row*64+ch*8); ATTN_STORE16(Ow+(long)row*OPITCH+ch*8,v);} }
  asm volatile("s_waitcnt lgkmcnt(0)\n\ts_barrier":::"memory");
  #undef DMA_K
  #undef DMA_V
  #undef CMASK
  #undef START
  #undef RESC
  #undef ROT
  #undef POST
  #undef NEGM_SET
  #undef CFENCE
}
constexpr int ATTN_LDS_BYTES=LDS_BYTES;
#undef SBAR
#undef WAIT_BAR
}

#define GAS __attribute__((address_space(1)))
#define LAS __attribute__((address_space(3)))
typedef unsigned short bf16;
typedef unsigned v4u __attribute__((ext_vector_type(4)));
typedef float f32x4 __attribute__((ext_vector_type(4)));
typedef short bf16x8 __attribute__((ext_vector_type(8)));
typedef GAS unsigned gu32;
typedef GAS unsigned long long gu64;
#define RLX_AGENT __ATOMIC_RELAXED, __HIP_MEMORY_SCOPE_AGENT
#define LDS_WAIT() asm volatile("s_waitcnt lgkmcnt(0)" ::: "memory")
#define VM_WAIT() asm volatile("s_waitcnt vmcnt(0)" ::: "memory")
__device__ __forceinline__ unsigned long long rt() { return __builtin_amdgcn_s_memrealtime(); }

#define XB_TMO      128
#define XB_XCNT(j)  (256  + 64 * (j))
#define XB_XSUB(j)  (1280 + 64 * (j))
#define XB_XGEN(j)  (2304 + 64 * (j))
#define XB_TOP      3328
#define XB_TOPGEN   3392
#define XCD_BAR_WORDS 3456
#define XB_SPIN_CAP (1u << 18)

__device__ __forceinline__ unsigned xb_ld(unsigned* p)              { return __hip_atomic_load(p, __ATOMIC_RELAXED, __HIP_MEMORY_SCOPE_AGENT); }
__device__ __forceinline__ unsigned xb_add(unsigned* p, unsigned v) { return __hip_atomic_fetch_add(p, v, __ATOMIC_RELAXED, __HIP_MEMORY_SCOPE_AGENT); }
__device__ __forceinline__ unsigned xb_xcc_id() { return (unsigned)__builtin_amdgcn_s_getreg((3 << 11) | 20) & 0xFu; }
#define XB_SPIN(cond, bar) do { unsigned _sp = 0; while (cond) { __builtin_amdgcn_s_sleep(1); \
    if ((++_sp & 255u) == 0u) { if (xb_ld(&(bar)[XB_TMO])) break; if (_sp > XB_SPIN_CAP) { atomicAdd(&(bar)[XB_TMO], 1u); break; } } } } while (0)

struct XcdBarrier {
    unsigned* bar; unsigned x;
    volatile LAS unsigned* st;
};

__device__ __forceinline__ XcdBarrier xcd_barrier_post(unsigned* bar, volatile LAS unsigned* st) {
    XcdBarrier b; b.bar = bar; b.x = xb_xcc_id(); b.st = st;
    if (threadIdx.x == 0) (void)xb_add(&bar[XB_XCNT(b.x)], 1u);
    return b;
}
__device__ __forceinline__ void xcd_barrier_complete(unsigned* bar, unsigned x, unsigned& nloc, unsigned& nx) {
    const unsigned G = gridDim.x * gridDim.y * gridDim.z;
    unsigned sum, cnt, mine, sp = 0u;
    for (;;) {
        sum = 0u; cnt = 0u; mine = 0u;
#pragma unroll
        for (unsigned j = 0; j < 16; ++j) { const unsigned c = xb_ld(&bar[XB_XCNT(j)]); sum += c; cnt += (c > 0u) ? 1u : 0u; mine = (j == x) ? c : mine; }
        if (sum == G) break;
        __builtin_amdgcn_s_sleep(1);
        if ((++sp & 255u) == 0u) { if (xb_ld(&bar[XB_TMO])) break; if (sp > XB_SPIN_CAP) { atomicAdd(&bar[XB_TMO], 1u); break; } }
    }
    nloc = mine > 0u ? mine : 1u; nx = cnt > 0u ? cnt : 1u;
}

__device__ __forceinline__ void xcd_barrier(const XcdBarrier& b) {
    asm volatile("s_waitcnt vmcnt(0)" ::: "memory");
    __syncthreads();
    if (threadIdx.x == 0) {
        unsigned* bar = b.bar;
        __builtin_amdgcn_s_waitcnt(0);
        unsigned nloc = b.st[0], nx = b.st[1];
        if (nloc == 0u) { xcd_barrier_complete(bar, b.x, nloc, nx); b.st[0] = nloc; b.st[1] = nx; }
        const unsigned old = xb_add(&bar[XB_XSUB(b.x)], 1u);
        const unsigned gen = old / nloc;
        if (old + 1u == (gen + 1u) * nloc) {
            __builtin_amdgcn_fence(__ATOMIC_RELEASE, "agent");
            asm volatile("s_waitcnt vmcnt(0)" ::: "memory");
            const unsigned og = xb_add(&bar[XB_TOP], 1u);
            const unsigned tg = og / nx;
            if (og + 1u == (tg + 1u) * nx) xb_add(&bar[XB_TOPGEN], 1u);
            else XB_SPIN(xb_ld(&bar[XB_TOPGEN]) == tg, bar);
            __builtin_amdgcn_fence(__ATOMIC_ACQUIRE, "agent");
            xb_add(&bar[XB_XGEN(b.x)], 1u);
            asm volatile("s_waitcnt vmcnt(0)" ::: "memory");
        } else {
            XB_SPIN(xb_ld(&bar[XB_XGEN(b.x)]) == gen, bar);
            __builtin_amdgcn_fence(__ATOMIC_ACQUIRE, "agent");
            asm volatile("s_waitcnt vmcnt(0)" ::: "memory");
        }
    }
    __syncthreads();
}

constexpr int NWAVES = 8;
constexpr int RING_OFF = 0, RING_BYTES = 131072;
constexpr int LDSCTL_OFF = RING_BYTES, MISC_OFF = LDSCTL_OFF + 320;
constexpr int LDS_BYTES = 147456;
constexpr int CW_TMO = 0, CW_CODE = 1, CW_Q = 1024, CW_BAR = 4096;
constexpr float PRUNE_TH = 36.f;
constexpr int AUX_OFF = 86016;
constexpr size_t CTL_ZERO_BYTES = 2 * MiB;
constexpr size_t WS_KM = 1 * MiB, KM_LAYER = 256 * 1024;
constexpr int NPH_LAYER = 7, NPH = 1 + DEPTH * NPH_LAYER;

__device__ __forceinline__ void transpose_item(const float* W, int ldsrc, int k0, int srccol0, float scale, const float* gk, bf16* dst, int ldd, LAS float* scr, int lane) {
    float t[32];
#pragma unroll
    for (int i = 0; i < 32; ++i) { const int kk = 2 * i + (lane >> 5); t[i] = W[(size_t)(k0 + kk) * ldsrc + srccol0 + (lane & 31)]; }
#pragma unroll
    for (int i = 0; i < 32; ++i) { const int kk = 2 * i + (lane >> 5); scr[kk * 33 + (lane & 31)] = t[i] * (gk ? scale * gk[k0 + kk] : scale); }
    LDS_WAIT(); asm volatile("" ::: "memory");
    const int c = lane & 7;
#pragma unroll
    for (int j = 0; j < 4; ++j) { const int n = (lane >> 3) + 8 * j; const LAS float* s = scr + (8 * c) * 33 + n;
        v4u o; o.x = pk2(s[0 * 33], s[1 * 33]); o.y = pk2(s[2 * 33], s[3 * 33]); o.z = pk2(s[4 * 33], s[5 * 33]); o.w = pk2(s[6 * 33], s[7 * 33]);
        *(GAS v4u*)(dst + (size_t)n * ldd + k0 + 8 * c) = o; }
    LDS_WAIT(); asm volatile("" ::: "memory");
}

__device__ __forceinline__ float u2f(const unsigned u) { return __builtin_bit_cast(float, u); }
__device__ __forceinline__ void unpack8(const u32x4 w, float* f) {
    f[0] = __builtin_bit_cast(float, w.x << 16); f[1] = __builtin_bit_cast(float, w.x & 0xffff0000u); f[2] = __builtin_bit_cast(float, w.y << 16); f[3] = __builtin_bit_cast(float, w.y & 0xffff0000u);
    f[4] = __builtin_bit_cast(float, w.z << 16); f[5] = __builtin_bit_cast(float, w.z & 0xffff0000u); f[6] = __builtin_bit_cast(float, w.w << 16); f[7] = __builtin_bit_cast(float, w.w & 0xffff0000u);
}
__device__ __forceinline__ u32x4 pack8(const float* f) { u32x4 w; w.x = pk2(f[0], f[1]); w.y = pk2(f[2], f[3]); w.z = pk2(f[4], f[5]); w.w = pk2(f[6], f[7]); return w; }
__device__ __forceinline__ f32x4 ld4(const float* p) { return *(const f32x4*)p; }
__device__ __forceinline__ f32x4 ld4(const LAS float* p) { return *(const LAS f32x4*)p; }
template <bool RF32, bool XF32, class WFP>
__device__ __forceinline__ void rows_compute(const u32x4 (&cr)[4], const u32x4 (&cy)[2], const float rin, const int m, const int lane, const bool has_y, const float (&gp)[16], void* xout, const bool norm_out, float* rs, WFP WF, const bool has_wf, const float bfl, float* logf) {
    float v[16];
    if (RF32) {
#pragma unroll
        for (int q = 0; q < 4; ++q) { v[4 * q] = u2f(cr[q].x); v[4 * q + 1] = u2f(cr[q].y); v[4 * q + 2] = u2f(cr[q].z); v[4 * q + 3] = u2f(cr[q].w); }
    } else { unpack8(cr[0], v); unpack8(cr[1], v + 8); }
#pragma unroll
    for (int i = 0; i < 16; ++i) v[i] *= rin;
    if (has_y) { float yv[16]; unpack8(cy[0], yv); unpack8(cy[1], yv + 8); float ss = 0.f;
#pragma unroll
        for (int i = 0; i < 16; ++i) ss += yv[i] * yv[i];
        const float r = __builtin_amdgcn_rsqf(wave_sum(ss) * (1.f / DM) + RMS_EPS);
#pragma unroll
        for (int i = 0; i < 16; ++i) v[i] += yv[i] * r * gp[i]; }
    float r = 1.f;
    if (norm_out || has_wf) { float ss = 0.f;
#pragma unroll
        for (int i = 0; i < 16; ++i) ss += v[i] * v[i];
        const float ms = wave_sum(ss) * (1.f / DM) + RMS_EPS; r = __builtin_amdgcn_rsqf(ms);
        if (rs && lane == 0) rs[m] = __builtin_amdgcn_sqrtf(ms); }
    if (xout) {
        float w[16];
#pragma unroll
        for (int i = 0; i < 16; ++i) w[i] = norm_out ? v[i] * r : v[i];
        if (XF32) { f32x4* o = (f32x4*)((float*)xout + (size_t)m * DM + 8 * lane); o[0] = (f32x4){w[0], w[1], w[2], w[3]}; o[1] = (f32x4){w[4], w[5], w[6], w[7]}; o[128] = (f32x4){w[8], w[9], w[10], w[11]}; o[129] = (f32x4){w[12], w[13], w[14], w[15]}; }
        else { u32x4* o = (u32x4*)((bf16*)xout + (size_t)m * DM + 8 * lane); o[0] = pack8(w); o[64] = pack8(w + 8); } }
    {
        if (has_wf) {
            float d[8];
#pragma unroll
            for (int h = 0; h < 8; ++h) { d[h] = 0.f;
                if (h < NH) {
#pragma unroll
                    for (int q = 0; q < 4; ++q) { const f32x4 w = ld4(WF + ((h * 4 + q) * 64 + lane) * 4); d[h] += (v[4 * q] * w.x + v[4 * q + 1] * w.y) + (v[4 * q + 2] * w.z + v[4 * q + 3] * w.w); } } }
#define DPPMOV(x_, ctrl_) __builtin_bit_cast(float, __builtin_amdgcn_update_dpp(0, __builtin_bit_cast(int, (x_)), (ctrl_), 0xf, 0xf, false))
            const bool b2 = (lane & 4) != 0, e0 = ((lane ^ (lane >> 2)) & 1) != 0, e1 = (((lane >> 1) ^ (lane >> 2)) & 1) != 0;
            float e4[4], e2[2];
#pragma unroll
            for (int j = 0; j < 4; ++j) { const float snd = e0 ? d[j] : d[j + 4], kp = e0 ? d[j + 4] : d[j]; e4[j] = kp + DPPMOV(snd, 0xB1); }
#pragma unroll
            for (int j = 0; j < 2; ++j) { const float snd = e1 ? e4[j] : e4[j + 2], kp = e1 ? e4[j + 2] : e4[j]; e2[j] = kp + DPPMOV(snd, 0x4E); }
            float e = (b2 ? e2[1] : e2[0]) + DPPMOV(b2 ? e2[0] : e2[1], 0x141);
            e += DPPMOV(e, 0x128);
            e += __shfl_xor(e, 16);
            { auto rr = __builtin_amdgcn_permlane32_swap(__float_as_uint(e), __float_as_uint(e), false, false); e = __uint_as_float(rr[0]) + __uint_as_float(rr[1]); }
#undef DPPMOV
            const int hh = 4 * (int)e0 + 2 * (int)e1 + (int)b2;
            if (lane < 8 && hh < NH) logf[(size_t)m * NH + hh] = e * r + bfl; } }
}
template <bool RF32, bool XF32, class WFP>
__device__ __forceinline__ void rows_phase(const int gw, const int NGW, const int lane, const void* resid, const float* rs_in, const bf16* y, const float* gpost, void* xout, const bool norm_out, float* rs, WFP WF, const bool has_wf, const float* bfv, float* logf) {
    float gp[16];
#pragma unroll
    for (int j = 0; j < 2; ++j)
#pragma unroll
        for (int c = 0; c < 2; ++c) { const int e = 8 * lane + 512 * j + 4 * c;
            const f32x4 a = y ? *(const f32x4*)(gpost + e) : (f32x4){0.f, 0.f, 0.f, 0.f};
#pragma unroll
            for (int i = 0; i < 4; ++i) gp[8 * j + 4 * c + i] = a[i]; }
    const int hh_ = 4 * ((lane ^ (lane >> 2)) & 1) + 2 * (((lane >> 1) ^ (lane >> 2)) & 1) + ((lane >> 2) & 1);
    const float bfl = (has_wf && lane < 8 && hh_ < NH) ? bfv[hh_] : 0.f;
    const bool has_y = (y != nullptr);
    u32x4 r0[4], y0[2], r1[4], y1[2], r2[4], y2[2], r3[4], y3[2], r4[4], y4[2]; float s0 = 1.f, s1 = 1.f, s2 = 1.f, s3 = 1.f, s4 = 1.f;
#define ROWS_LOAD(R, Y, SC, m_) do { if (rs_in) SC = rs_in[(m_)]; \
        if (RF32) { const u32x4* p_ = (const u32x4*)((const float*)resid + (size_t)(m_) * DM + 8 * lane); R[0] = p_[0]; R[1] = p_[1]; R[2] = p_[128]; R[3] = p_[129]; } \
        else { const u32x4* p_ = (const u32x4*)((const bf16*)resid + (size_t)(m_) * DM + 8 * lane); R[0] = p_[0]; R[1] = p_[64]; } \
        if (has_y) { const u32x4* q_ = (const u32x4*)(y + (size_t)(m_) * DM + 8 * lane); Y[0] = q_[0]; Y[1] = q_[64]; } } while (0)
#define ROWS_DO(R, Y, SC, m_) rows_compute<RF32, XF32, WFP>(R, Y, SC, (m_), lane, has_y, gp, xout, norm_out, rs, WF, has_wf, bfl, logf)
#define RFENCE() asm volatile("" ::: "memory")
    int m = gw;
    if (m + 3 * NGW < M) {
        ROWS_LOAD(r0, y0, s0, m); ROWS_LOAD(r1, y1, s1, m + NGW); ROWS_LOAD(r2, y2, s2, m + 2 * NGW); ROWS_LOAD(r3, y3, s3, m + 3 * NGW); RFENCE();
        for (; m + 8 * NGW < M; m += 5 * NGW) {
            ROWS_LOAD(r4, y4, s4, m + 4 * NGW); RFENCE(); ROWS_DO(r0, y0, s0, m); RFENCE();
            ROWS_LOAD(r0, y0, s0, m + 5 * NGW); RFENCE(); ROWS_DO(r1, y1, s1, m + NGW); RFENCE();
            ROWS_LOAD(r1, y1, s1, m + 6 * NGW); RFENCE(); ROWS_DO(r2, y2, s2, m + 2 * NGW); RFENCE();
            ROWS_LOAD(r2, y2, s2, m + 7 * NGW); RFENCE(); ROWS_DO(r3, y3, s3, m + 3 * NGW); RFENCE();
            ROWS_LOAD(r3, y3, s3, m + 8 * NGW); RFENCE(); ROWS_DO(r4, y4, s4, m + 4 * NGW); RFENCE();
        }
        if (m + 4 * NGW < M) ROWS_LOAD(r4, y4, s4, m + 4 * NGW);
        RFENCE(); ROWS_DO(r0, y0, s0, m); RFENCE();
        if (m + 5 * NGW < M) ROWS_LOAD(r0, y0, s0, m + 5 * NGW);
        RFENCE(); ROWS_DO(r1, y1, s1, m + NGW); RFENCE();
        if (m + 6 * NGW < M) ROWS_LOAD(r1, y1, s1, m + 6 * NGW);
        RFENCE(); ROWS_DO(r2, y2, s2, m + 2 * NGW); RFENCE();
        if (m + 7 * NGW < M) ROWS_LOAD(r2, y2, s2, m + 7 * NGW);
        RFENCE(); ROWS_DO(r3, y3, s3, m + 3 * NGW); RFENCE();
        if (m + 4 * NGW < M) ROWS_DO(r4, y4, s4, m + 4 * NGW);
        if (m + 5 * NGW < M) ROWS_DO(r0, y0, s0, m + 5 * NGW);
        if (m + 6 * NGW < M) ROWS_DO(r1, y1, s1, m + 6 * NGW);
        if (m + 7 * NGW < M) ROWS_DO(r2, y2, s2, m + 7 * NGW);
        m = M;
    }
    for (; m < M; m += NGW) { ROWS_LOAD(r0, y0, s0, m); ROWS_DO(r0, y0, s0, m); }
#undef ROWS_LOAD
#undef ROWS_DO
#undef RFENCE
}

struct Args { const float* in[13]; float* out; unsigned char* ws; int ph_lo, ph_hi, li, pad; };

__global__ void __launch_bounds__(NWAVES * 64, 2) mk_fwd(Args args) {
    extern __shared__ __attribute__((aligned(16))) unsigned char lds[];
    LAS unsigned char* L = (LAS unsigned char*)lds;
    volatile LAS unsigned* MISC = (volatile LAS unsigned*)(L + MISC_OFF);
    const int G = gridDim.x; const int bx = blockIdx.x; const int vcu = (G % 8 == 0) ? (bx % 8) * (G / 8) + bx / 8 : bx;
    const int NGW = G * NWAVES;
#define PHASE_IDS() int tid_ = threadIdx.x; asm volatile("" : "+v"(tid_)); const int tid = tid_, lane = tid & 63, wave = __builtin_amdgcn_readfirstlane(tid >> 6), gw = vcu * NWAVES + wave; (void)tid; (void)lane; (void)gw
    unsigned char* ws = args.ws;
    gu32* ctl = (gu32*)(ws + WS_CTL);
    for (int u = threadIdx.x; u < (LDS_BYTES - LDSCTL_OFF) / 4; u += NWAVES * 64) ((LAS unsigned*)(L + LDSCTL_OFF))[u] = 0u;
    __syncthreads();
    XcdBarrier bar = xcd_barrier_post((unsigned*)(ctl + CW_BAR) + args.li * XCD_BAR_WORDS, MISC + 8);
    const int lo = args.ph_lo, hi = args.ph_hi;
#define IN(k) (lo <= (k) && (k) < hi)
#define SEAM(k) do { if (IN(k) && IN((k) + 1)) xcd_barrier(bar); } while (0)
    const float* x = args.in[0]; const float* w_in = args.in[1]; const float* b_f = args.in[2]; const float* conv_w = args.in[3];
    const float* w_out = args.in[4]; const float* rel_bias = args.in[5]; const float* g_pre_mix = args.in[6]; const float* g_post_mix = args.in[7];
    const float* g_pre_ffn = args.in[8]; const float* g_post_ffn = args.in[9]; const float* w_gate = args.in[10]; const float* w_up = args.in[11]; const float* w_down = args.in[12];
    float* out = args.out;
    float* LOGF = (float*)(ws + WS_LOGF); float* RS = (float*)(ws + WS_KMEAN); float* KNP = (float*)(ws + WS_CUM);
    bf16* XN = (bf16*)(ws + WS_XN); bf16* MIXIN = (bf16*)(ws + WS_MIXIN); bf16* XA = (bf16*)(ws + WS_XA); bf16* Y = (bf16*)(ws + WS_XA + 64 * MiB); bf16* P = (bf16*)(ws + WS_P); bf16* H = (bf16*)(ws + WS_H);

    if (IN(0)) { PHASE_IDS();
        LAS float* scr = (LAS float*)(L + RING_OFF + wave * 16384);
        constexpr int I_IN = (PW / 32) * (DM / 64), I_OUT = (DM / 32) * (DM / 64), I_GU = (NGU / 32) * (DM / 64), I_D = (DM / 32) * (DFF / 64), I_L = I_IN + I_OUT + I_GU + I_D;
        for (int it = gw; it < DEPTH * I_L; it += NGW) {
            const int l = it / I_L; int r = it % I_L;
            unsigned char* wl = ws + WS_W + (size_t)l * W_LAYER;
            if (r < I_IN) { const int kb = r / (PW / 32), pb = r % (PW / 32), p0 = pb * 32; const int src = p0 < 2304 ? p0 : p0 + 6;
                const float sc = (p0 < 384 || (p0 >= 1152 && p0 < 1536)) ? C2 : 1.f;
                transpose_item(w_in + (size_t)l * DM * INW, INW, kb * 64, src, sc, g_pre_mix + (size_t)l * DM, (bf16*)(wl + WO_IN) + (size_t)p0 * DM, DM, scr, lane); continue; }
            r -= I_IN;
            if (r < I_OUT) { const int kb = r / (DM / 32), pb = r % (DM / 32);
                transpose_item(w_out + (size_t)l * DM * DM, DM, kb * 64, pb * 32, 1.f, nullptr, (bf16*)(wl + WO_OUT) + (size_t)pb * 32 * DM, DM, scr, lane); continue; }
            r -= I_OUT;
            if (r < I_GU) { const int kb = r / (NGU / 32), pb = r % (NGU / 32), r0 = pb * 32; const int pn = r0 >> 8, bj = (r0 >> 7) & 1, j = r0 & 127;
                transpose_item((bj ? w_up : w_gate) + (size_t)l * DM * DFF, DFF, kb * 64, pn * 128 + j, 1.f, g_pre_ffn + (size_t)l * DM, (bf16*)(wl + WO_GU) + (size_t)r0 * DM, DM, scr, lane); continue; }
            r -= I_GU;
            { const int kb = r / (DM / 32), pb = r % (DM / 32);
                transpose_item(w_down + (size_t)l * DFF * DM, DM, kb * 64, pb * 32, 1.f, nullptr, (bf16*)(wl + WO_D) + (size_t)pb * 32 * DFF, DFF, scr, lane); }
        }
        for (int i = gw * 64 + lane; i < DEPTH * NH * DM; i += NGW * 64) { const int l = i / (NH * DM), r = i % (NH * DM), h = r / DM, q = (r >> 8) & 3, ln = (r >> 2) & 63, k = 8 * ln + 512 * (q >> 1) + 4 * (q & 1) + (r & 3);
            ((float*)(ws + WS_W + (size_t)l * W_LAYER + WO_F))[r] = w_in[(size_t)l * DM * INW + (size_t)k * INW + 2304 + h] * g_pre_mix[(size_t)l * DM + k]; }
        __syncthreads();
        { LAS float* wfl = (LAS float*)(L + RING_OFF + 4096);
          for (int i = tid; i < NH * DM; i += NWAVES * 64) { const int k = i / NH, h = i % NH, ln = (k & 511) >> 3, q = 2 * (k >> 9) + ((k >> 2) & 1); wfl[((h * 4 + q) * 64 + ln) * 4 + (k & 3)] = w_in[(size_t)k * INW + 2304 + h] * g_pre_mix[k]; }
          __syncthreads();
          rows_phase<true, false, const LAS float*>(gw, NGW, lane, x, nullptr, nullptr, nullptr, XN, true, nullptr, (const LAS float*)wfl, true, b_f, LOGF); }
    }
    SEAM(0);
    for (int l = 0; l < DEPTH; ++l) {
        const int pb = 1 + l * NPH_LAYER;
        unsigned char* wl = ws + WS_W + (size_t)l * W_LAYER;
        const bf16* Win_t = (const bf16*)(wl + WO_IN); const bf16* Wout_t = (const bf16*)(wl + WO_OUT); const bf16* Wgu_t = (const bf16*)(wl + WO_GU); const bf16* Wd_t = (const bf16*)(wl + WO_D);
        const bool last = (l == DEPTH - 1);
        float* KM = (float*)(ws + WS_CTL + WS_KM + (size_t)l * KM_LAYER);
        if (IN(pb + 0)) { PHASE_IDS();
            for (int e = vcu * (NWAVES * 64) + tid; e < M * NH; e += G * NWAVES * 64) LOGF[e] = log_sigmoid(LOGF[e]);
            pg8::Gemm g{l == 0 ? XN : XA, Win_t, M, PW, DM}; pg8::StaticOrder S; S.init(M, PW, G, bx);
            pg8::EpiInProj E{P, PW, KM, KNP};
            pg8::gemm_phase<pg8::EpiInProj, pg8::StaticOrder, true, true>(L + RING_OFF, g, S, E);
        }
        SEAM(pb + 0);
        if (IN(pb + 1)) { PHASE_IDS();
            constexpr int NATT = 2 * BATCH * NH * NBLK, NCONV = M / 128, NUNITS = NATT + NCONV;
            char* shm = (char*)lds + RING_OFF;
            attn_body::lds_cptr aux = (attn_body::lds_cptr)(L + AUX_OFF);
            LAS float* auxR0 = (LAS float*)(L + AUX_OFF + attn_body::AUX_R0); LAS unsigned* auxInfo = (LAS unsigned*)(L + AUX_OFF + attn_body::AUX_INFO); LAS float* auxTab = (LAS float*)(L + AUX_OFF + attn_body::AUX_TAB);
            LAS float* wtot = (LAS float*)(L + AUX_OFF + attn_body::AUX_TAB + 16384);
            const float* cw = conv_w + (size_t)l * 3 * CCH;
            int idx = bx, iter = 0; unsigned nA = (unsigned)(bx + G);
            while (idx < NUNITS) {
                if (tid == 0) { MISC[16 + ((iter + 1) & 1)] = nA; nA = __hip_atomic_fetch_add(ctl + CW_Q + 64 * l, 1u, RLX_AGENT) + 2u * (unsigned)G; }
                int tq = threadIdx.x; asm volatile("" : "+v"(tq));
                if (idx < NATT) {
                const int kind = idx < NATT / 2 ? 1 : 0, ia = idx - (kind ? 0 : NATT / 2), qb = (NBLK - 1) - ia / (BATCH * NH), bh = ia % (BATCH * NH), b = bh / NH, h = bh % NH;
                const int q0 = qb * MBLK; const size_t row0 = (size_t)b * SEQ;
                const int prow = tq >> 1, half = tq & 1;
                const int cq = kind == 0 ? P_FQ : P_MQ, ck = kind == 0 ? P_FK : P_MK, cv = kind == 0 ? P_FV : P_MV;
                const bf16* Qg = P + (row0 + q0) * PW + cq + h * HD; const bf16* Kb = P + row0 * PW + ck + h * HD; const bf16* Vb = P + row0 * PW + cv + h * HD;
                bf16* Og = MIXIN + (row0 + q0) * DM + (kind == 0 ? 384 : 0) + h * HD;
                int tile0 = 0;
                if (kind == 0) {
                    const int k0 = tile0 * 64, kend = q0 + MBLK, kb = k0 + 8 * tq;
                    float loc[8]; float run = 0.f;
#pragma unroll
                    for (int i = 0; i < 8; ++i) { const int key = kb + i; const float v = key < kend ? LOGF[(row0 + key) * NH + h] : 0.f; run += v; loc[i] = run; }
                    float incl = run;
#pragma unroll
                    for (int o = 1; o < 64; o <<= 1) { const float t = __shfl_up(incl, o); if ((tq & 63) >= o) incl += t; }
                    if ((tq & 63) == 63) wtot[tq >> 6] = incl;
                    __syncthreads();
                    float off = incl - run; for (int w = 0; w < (tq >> 6); ++w) off += wtot[w];
#pragma unroll
                    for (int i = 0; i < 8; ++i) { const int key = kb + i; if (key < kend) auxTab[key] = (off + loc[i]) * LOG2E; }
                } else {
                    const float bfar = rel_bias[31 * NH + h];
                    if (tq <= 128) auxTab[tq] = (rel_bias[c_bucket[tq] * NH + h] - bfar) * LOG2E;
                    for (int i = tq; i < qb * HD; i += NWAVES * 64) auxTab[256 + i] = KM[(size_t)bh * NBLK * HD + i];
                }
                __syncthreads();
                if (kind == 0) {
                    const bf16* qp = Qg + (size_t)prow * PW + half * 32; const bf16* kp = Kb + (size_t)(q0 + prow) * PW + half * 32; float d = 0.f, qq = 0.f;
#pragma unroll
                    for (int c = 0; c < 4; ++c) { const bf16x8 qv = *(const bf16x8*)(qp + 8 * c), kv = *(const bf16x8*)(kp + 8 * c);
#pragma unroll
                        for (int j = 0; j < 8; ++j) { const float qf = bf2f((unsigned short)qv[j]); d += qf * bf2f((unsigned short)kv[j]); qq += qf * qf; } }
                    d += DPPX(d, 0xB1); qq += DPPX(qq, 0xB1);
                    float u2 = (auxTab[q0 + prow] - auxTab[q0]) - d;
#pragma unroll
                    for (int o = 2; o < 64; o <<= 1) { qq = fmaxf(qq, __shfl_xor(qq, o)); u2 = fmaxf(u2, __shfl_xor(u2, o)); }
                    if ((tq & 63) == 0) { wtot[8 + (tq >> 6)] = qq; wtot[16 + (tq >> 6)] = u2; }
                    if (tq == 0) ((LAS unsigned*)wtot)[24] = (unsigned)(4 * qb);
                    __syncthreads();
                    float U1 = wtot[8], U2 = wtot[16];
#pragma unroll
                    for (int w = 1; w < 8; ++w) { U1 = fmaxf(U1, wtot[8 + w]); U2 = fmaxf(U2, wtot[16 + w]); }
                    U1 = sqrtf(U1) * 1.0001f;
                    if (tq < 4 * qb) { const float* kn = KNP + ((size_t)bh * 64 + tq) * 2; const float bound = U1 * sqrtf(kn[0] + kn[1]) + U2 + (auxTab[q0] - auxTab[64 * tq + 63]);
                        if (!(bound <= -PRUNE_TH)) __hip_atomic_fetch_min((LAS unsigned*)wtot + 24, (unsigned)tq, __ATOMIC_RELAXED, __HIP_MEMORY_SCOPE_WORKGROUP); }
                    __syncthreads();
                    tile0 = (int)(((LAS unsigned*)wtot)[24] & ~1u);
                }
                {   const bf16* qp = Qg + (size_t)prow * PW + half * 32; const bf16* kp = Kb + (size_t)(q0 + prow) * PW + half * 32; float q[32]; float d = 0.f;
#pragma unroll
                    for (int c = 0; c < 4; ++c) { const bf16x8 qv = *(const bf16x8*)(qp + 8 * c), kv = *(const bf16x8*)(kp + 8 * c);
#pragma unroll
                        for (int j = 0; j < 8; ++j) { q[8 * c + j] = bf2f((unsigned short)qv[j]); d += q[8 * c + j] * bf2f((unsigned short)kv[j]); } }
                    d += DPPX(d, 0xB1);
                    if (kind == 0) { if (half == 0) { auxR0[prow] = d - auxTab[q0 + prow]; auxInfo[prow] = 0u; } }
                    else {
                        int s0 = -1, s1 = -1, s2 = -1; float g0 = -INFINITY, g1 = -INFINITY, g2 = -INFINITY;
                        for (int n = 0; n < qb; ++n) { const LAS f32x4* km = (const LAS f32x4*)(auxTab + 256 + n * HD + half * 32); float g = 0.f;
#pragma unroll
                            for (int j = 0; j < 8; ++j) { const f32x4 kk = km[j]; g += (q[4 * j] * kk.x + q[4 * j + 1] * kk.y) + (q[4 * j + 2] * kk.z + q[4 * j + 3] * kk.w); }
                            g += DPPX(g, 0xB1);
                            if (g > g0) { g2 = g1; s2 = s1; g1 = g0; s1 = s0; g0 = g; s0 = n; } else if (g > g1) { g2 = g1; s2 = s1; g1 = g; s1 = n; } else if (g > g2) { g2 = g; s2 = n; } }
                        unsigned msk = 0u; if (s0 >= 0) msk |= 1u << s0; if (s1 >= 0) msk |= 1u << s1; if (s2 >= 0) msk |= 1u << s2;
                        if (half == 0) { auxR0[prow] = d + auxTab[0]; auxInfo[prow] = msk; }
                    }
                }
                __syncthreads();
                if (kind == 0) attn_body::attn_unit<0, 8>((const attn_body::bf16*)Qg, (const attn_body::bf16*)(Kb + (size_t)tile0 * 64 * PW), (const attn_body::bf16*)(Vb + (size_t)tile0 * 64 * PW), (attn_body::bf16*)Og, 4 * (qb + 1) - tile0, tile0, q0, qb, shm, aux);
                else attn_body::attn_unit<1, 8>((const attn_body::bf16*)Qg, (const attn_body::bf16*)Kb, (const attn_body::bf16*)Vb, (attn_body::bf16*)Og, 4 * (qb + 1), 0, q0, qb, shm, aux);
                } else {
                    const int cg = tq & 31, rg = tq >> 5; const size_t r0 = (size_t)(idx - NATT) * 128 + rg * 8; const int c0 = cg * 8;
                    float w0[8], w1[8], w2[8], u2[8], u1[8];
#pragma unroll
                    for (int j = 0; j < 8; ++j) { w0[j] = cw[c0 + j]; w1[j] = cw[CCH + c0 + j]; w2[j] = cw[2 * CCH + c0 + j]; u2[j] = 0.f; u1[j] = 0.f; }
                    if ((r0 % SEQ) != 0) {
                        const bf16x8 a2 = *(const bf16x8*)(P + (r0 - 2) * PW + P_CC + c0), h2 = *(const bf16x8*)(P + (r0 - 2) * PW + P_CH + c0);
                        const bf16x8 a1 = *(const bf16x8*)(P + (r0 - 1) * PW + P_CC + c0), h1 = *(const bf16x8*)(P + (r0 - 1) * PW + P_CH + c0);
#pragma unroll
                        for (int j = 0; j < 8; ++j) { u2[j] = bf2f((unsigned short)a2[j]) * bf2f((unsigned short)h2[j]); u1[j] = bf2f((unsigned short)a1[j]) * bf2f((unsigned short)h1[j]); }
                    }
#pragma unroll
                    for (int rr = 0; rr < 8; ++rr) { const size_t m = r0 + rr;
                        const bf16x8 a = *(const bf16x8*)(P + m * PW + P_CC + c0), hh = *(const bf16x8*)(P + m * PW + P_CH + c0), bb = *(const bf16x8*)(P + m * PW + P_CB + c0);
                        float o8[8];
#pragma unroll
                        for (int j = 0; j < 8; ++j) { const float u0 = bf2f((unsigned short)a[j]) * bf2f((unsigned short)hh[j]); o8[j] = bf2f((unsigned short)bb[j]) * (w0[j] * u2[j] + w1[j] * u1[j] + w2[j] * u0); u2[j] = u1[j]; u1[j] = u0; }
                        u32x4 w; w.x = pk2(o8[0], o8[1]); w.y = pk2(o8[2], o8[3]); w.z = pk2(o8[4], o8[5]); w.w = pk2(o8[6], o8[7]);
                        *(u32x4*)(MIXIN + m * DM + 768 + c0) = w; }
                    __syncthreads();
                }
                idx = (int)MISC[16 + ((iter + 1) & 1)]; ++iter;
            }
        }
        SEAM(pb + 1);
        if (IN(pb + 2)) { PHASE_IDS();
            pg8::Gemm g{MIXIN, Wout_t, M, DM, DM}; pg8::StaticOrder S; S.init(M, DM, G, bx);
            pg8::EpiStoreBf16 E{Y, DM};
            pg8::gemm_phase<pg8::EpiStoreBf16, pg8::StaticOrder, true, true>(L + RING_OFF, g, S, E);
        }
        SEAM(pb + 2);
        if (IN(pb + 3)) { PHASE_IDS();
            if (l == 0) rows_phase<true, false, const float*>(gw, NGW, lane, x, nullptr, Y, g_post_mix + (size_t)l * DM, XA, true, RS, (const float*)nullptr, false, nullptr, nullptr);
            else rows_phase<false, false, const float*>(gw, NGW, lane, XA, RS, Y, g_post_mix + (size_t)l * DM, XA, true, RS, (const float*)nullptr, false, nullptr, nullptr);
        }
        SEAM(pb + 3);
        if (IN(pb + 4)) { PHASE_IDS();
            pg8::Gemm g{XA, Wgu_t, M, NGU, DM}; pg8::StaticOrder S; S.init(M, NGU, G, bx);
            pg8::EpiSwiGLU E{H, DFF};
            pg8::gemm_phase<pg8::EpiSwiGLU, pg8::StaticOrder, true, true>(L + RING_OFF, g, S, E);
        }
        SEAM(pb + 4);
        if (IN(pb + 5)) { PHASE_IDS();
            pg8::Gemm g{H, Wd_t, M, DM, DFF}; pg8::StaticOrder S; S.init(M, DM, G, bx);
            pg8::EpiStoreBf16 E{Y, DM};
            pg8::gemm_phase<pg8::EpiStoreBf16, pg8::StaticOrder, true, true>(L + RING_OFF, g, S, E);
        }
        SEAM(pb + 5);
        if (IN(pb + 6)) { PHASE_IDS();
            if (!last) { const float* WFn = (const float*)(ws + WS_W + (size_t)(l + 1) * W_LAYER + WO_F);
                rows_phase<false, false, const float*>(gw, NGW, lane, XA, RS, Y, g_post_ffn + (size_t)l * DM, XA, true, RS, WFn, true, b_f + (size_t)(l + 1) * NH, LOGF); }
            else rows_phase<false, true, const float*>(gw, NGW, lane, XA, RS, Y, g_post_ffn + (size_t)l * DM, out, false, nullptr, (const float*)nullptr, false, nullptr, nullptr);
        }
        SEAM(pb + 6);
    }
#undef IN
#undef SEAM
}

#ifndef MK_MODE
#define MK_MODE 2
#endif
extern "C" void kernel_launch(void* const* d_in, const int* in_sizes, int n_in, void* d_out, int out_size, void* d_ws, size_t ws_size, hipStream_t stream) {
    if (n_in != 13 || in_sizes[0] != M * DM || out_size != M * DM || ws_size < WS_END) { fprintf(stderr, "kernel_launch: unexpected shapes (n_in %d, in0 %d, out %d, ws %zu)\n", n_in, n_in > 0 ? in_sizes[0] : -1, out_size, ws_size); return; }
    static int grid = 0;
    if (grid == 0) {
        int dev = 0, cus = 0, per_cu = 0;
        if (hipGetDevice(&dev) != hipSuccess || hipDeviceGetAttribute(&cus, hipDeviceAttributeMultiprocessorCount, dev) != hipSuccess) { fprintf(stderr, "kernel_launch: device query failed\n"); grid = -1; return; }
        if (hipFuncSetAttribute((const void*)mk_fwd, hipFuncAttributeMaxDynamicSharedMemorySize, LDS_BYTES) != hipSuccess) { fprintf(stderr, "kernel_launch: hipFuncSetAttribute failed\n"); grid = -1; return; }
        if (hipOccupancyMaxActiveBlocksPerMultiprocessor(&per_cu, (const void*)mk_fwd, NWAVES * 64, LDS_BYTES) != hipSuccess || per_cu < 1) fprintf(stderr, "kernel_launch: occupancy query reports %d\n", per_cu);
        (void)hipGetLastError();
        grid = cus;
    }
    if (grid < 0) return;
    if (hipMemsetAsync((char*)d_ws + WS_CTL, 0, CTL_ZERO_BYTES, stream) != hipSuccess) { fprintf(stderr, "kernel_launch: hipMemsetAsync of the control words failed; nothing launched\n"); return; }
    Args a{};
    for (int i = 0; i < 13; ++i) a.in[i] = (const float*)d_in[i];
    a.out = (float*)d_out; a.ws = (unsigned char*)d_ws;
#if MK_MODE == 2
    a.ph_lo = 0; a.ph_hi = NPH; a.li = 0;
    hipLaunchKernelGGL(mk_fwd, dim3(grid), dim3(NWAVES * 64), LDS_BYTES, stream, a);
#else
    for (int p = 0; p < NPH; ++p) { a.ph_lo = p; a.ph_hi = p + 1; a.li = p; hipLaunchKernelGGL(mk_fwd, dim3(grid), dim3(NWAVES * 64), LDS_BYTES, stream, a); }
#endif
}
```

```cpp
#include <hip/hip_runtime.h>
#include <cstdio>
#include <cstdint>

typedef unsigned short bf16;
typedef short bf16x8 __attribute__((ext_vector_type(8)));
typedef float f32x4 __attribute__((ext_vector_type(4)));
typedef unsigned u32x4 __attribute__((ext_vector_type(4)));
typedef unsigned u32x2 __attribute__((ext_vector_type(2)));

constexpr int DM = 1024, BATCH = 8, SEQ = 4096, DEPTH = 2, HD = 64, NH = 6, CCH = 256;
constexpr int M = BATCH * SEQ;
constexpr int INW = 3078, PW = 3072, DFF = 2816, NGU = 2 * DFF;
constexpr int MBLK = 256, NBLK = SEQ / MBLK;
constexpr float RMS_EPS = 1e-6f;
constexpr float LOG2E = 1.4426950408889634f;
constexpr float C2 = 0.125f * LOG2E;
constexpr int P_MQ = 0, P_MK = 384, P_MV = 768, P_FQ = 1152, P_FK = 1536, P_FV = 1920, P_CB = 2304, P_CC = 2560, P_CH = 2816;
constexpr size_t MiB = 1u << 20;
constexpr size_t WS_CTL = 0;
constexpr size_t WS_W = 2 * MiB, W_LAYER = 25 * MiB;
constexpr size_t WO_IN = 0, WO_OUT = 6 * MiB, WO_GU = 8 * MiB, WO_D = 19 * MiB, WO_F = 24 * MiB + 512 * 1024;
constexpr size_t WS_LOGF = 52 * MiB, WS_CUM = 53 * MiB, WS_KMEAN = 54 * MiB;
constexpr size_t WS_XN = 56 * MiB, WS_MIXIN = 120 * MiB, WS_XA = 184 * MiB, WS_P = 312 * MiB, WS_H = WS_P, WS_END = 504 * MiB;

__constant__ int c_bucket[129] = {0, 1, 2, 3, 4, 5, 6, 7, 8, 9, 10, 11, 12, 13, 14, 15, 16, 16, 16, 17, 17, 18, 18, 18, 19, 19, 19, 20, 20, 20, 20, 21, 21, 21, 21, 22, 22, 22, 22, 22, 23, 23, 23, 23, 23, 23, 24, 24, 24, 24, 24, 24, 25, 25, 25, 25, 25, 25, 25, 26, 26, 26, 26, 26, 26, 26, 26, 27, 27, 27, 27, 27, 27, 27, 27, 27, 27, 28, 28, 28, 28, 28, 28, 28, 28, 28, 28, 29, 29, 29, 29, 29, 29, 29, 29, 29, 29, 29, 29, 30, 30, 30, 30, 30, 30, 30, 30, 30, 30, 30, 30, 30, 30, 31, 31, 31, 31, 31, 31, 31, 31, 31, 31, 31, 31, 31, 31, 31, 31};

__device__ __forceinline__ unsigned f2bf(float f) { unsigned u = __builtin_bit_cast(unsigned, f); return (u + 0x7fffu + ((u >> 16) & 1u)) >> 16; }
typedef float f32x2v __attribute__((ext_vector_type(2))); typedef __bf16 bf16x2v __attribute__((ext_vector_type(2)));
__device__ __forceinline__ unsigned pk2(float lo, float hi) { const f32x2v v = {lo, hi}; const bf16x2v b = __builtin_convertvector(v, bf16x2v); return __builtin_bit_cast(unsigned, b); }
__device__ __forceinline__ float bf2f(unsigned short b) { return __builtin_bit_cast(float, (unsigned)b << 16); }
#define DPPX(x_, ctrl_) __builtin_bit_cast(float, __builtin_amdgcn_update_dpp(0, __builtin_bit_cast(int, (x_)), (ctrl_), 0xf, 0xf, false))
#define WS_DPP(v, ctrl, rm) (v) = (v) + __builtin_bit_cast(float, __builtin_amdgcn_update_dpp(0, __builtin_bit_cast(int, (v)), (ctrl), (rm), 0xf, false))
__device__ __forceinline__ float wave_sum(float v) {
    WS_DPP(v, 0xB1, 0xf); WS_DPP(v, 0x4E, 0xf); WS_DPP(v, 0x141, 0xf); WS_DPP(v, 0x140, 0xf); WS_DPP(v, 0x142, 0xa); WS_DPP(v, 0x143, 0xc);
    return __builtin_bit_cast(float, __builtin_amdgcn_readlane(__builtin_bit_cast(int, v), 63));
}

__device__ __forceinline__ float log_sigmoid(float z) { return z < 0.f ? z - log1pf(expf(z)) : -log1pf(expf(-z)); }
namespace pg8 {
#define PG8_LAS __attribute__((address_space(3)))
typedef unsigned short bf16_t;
typedef short bf16x8 __attribute__((ext_vector_type(8)));
typedef float f32x4 __attribute__((ext_vector_type(4)));
typedef unsigned u32x4 __attribute__((ext_vector_type(4)));
constexpr int BM = 256, BK = 64, HALF = 128, HTB = HALF * BK * 2  , STAGE_BYTES = 8 * HTB, NXCD = 8, WGM = 8;

__host__ __device__ __forceinline__ int lds_byte(int r, int c) { const int st = (r >> 4) * 2 + (c >> 5), rr = r & 15, cc = c & 31, ob = rr * 64 + cc * 2; return st * 1024 + (ob ^ (((ob >> 9) & 1) << 5)); }
__host__ __device__ __forceinline__ void stage_rc(int b, int& R, int& C) { const int st = b / 1024, sb = b % 1024, swz = sb ^ (((sb >> 9) & 1) << 5); R = (st >> 1) * 16 + swz / 64; C = (st & 1) * 32 + (swz % 64) / 2; }
__host__ __device__ __forceinline__ int perm32(int rho) { const int n = rho >> 4, i = rho & 15; return 8 * (i >> 2) + 4 * n + (i & 3); }

struct Unit { int pm, pn; };
struct Gemm { const bf16_t* A; const bf16_t* Bt; int M, N, K; };

struct StaticOrder {
    int nM, nN, nwg, G, c;
    __host__ __device__ void init(int M, int N, int G_, int c_) { nM = M / BM; nN = N / BM; nwg = nM * nN; G = G_; c = c_; }
    __host__ __device__ bool next(int i, Unit& u) const {
        const long L = (long)i * G + c; if (L >= nwg) return false;
        int wgid = (int)L; { const int q = nwg / NXCD, r = nwg % NXCD, xcd = wgid % NXCD, off = wgid / NXCD; wgid = (xcd < r ? xcd * (q + 1) : r * (q + 1) + (xcd - r) * q) + off; }
        const int nig = WGM * nN, gid = wgid / nig, fm = gid * WGM, gsz = (nM - fm) < WGM ? (nM - fm) : WGM;
        u.pm = fm + ((wgid % nig) % gsz); u.pn = (wgid % nig) / gsz; return true;
    }
    __device__ __forceinline__ void a_ready(const Unit&) const {}
    __device__ __forceinline__ void done(const Unit&) const {}
};
__device__ __forceinline__ unsigned cvt_pk_bf16(float lo, float hi) { unsigned r; asm volatile("v_cvt_pk_bf16_f32 %0, %1, %2" : "=v"(r) : "v"(lo), "v"(hi)); return r; }
typedef float f32x2 __attribute__((ext_vector_type(2)));
struct EpiStoreBf16 {
    static constexpr bool PERM = true, AFTER_DRAIN = false;
    bf16_t* O; int ldc;
    __device__ __forceinline__ void operator()(const f32x4 (&acc)[2][2][4][2], const Unit& u, int wr, int wc, int fr, int fq) const {
        const int row0 = u.pm * BM + wr * 64 + fr, col0 = u.pn * BM + wc * 32 + 8 * fq;
#pragma unroll
        for (int ai = 0; ai < 2; ++ai)
#pragma unroll
            for (int m = 0; m < 4; ++m) { bf16_t* rowp = O + (size_t)(row0 + ai * HALF + m * 16) * ldc + col0;
#pragma unroll
                for (int bj = 0; bj < 2; ++bj) { const f32x4 v0 = acc[ai][bj][m][0], v1 = acc[ai][bj][m][1];
                    u32x4 w; w.x = cvt_pk_bf16(v0[0], v0[1]); w.y = cvt_pk_bf16(v0[2], v0[3]); w.z = cvt_pk_bf16(v1[0], v1[1]); w.w = cvt_pk_bf16(v1[2], v1[3]);
                    *(u32x4*)(rowp + bj * HALF) = w; } }
    }
};
struct EpiStoreF32 {
    static constexpr bool PERM = false, AFTER_DRAIN = false;
    float* C; int ldc;
    __device__ __forceinline__ void operator()(const f32x4 (&acc)[2][2][4][2], const Unit& u, int wr, int wc, int fr, int fq) const {
        const int row0 = u.pm * BM + wr * 64 + fr, col0 = u.pn * BM + wc * 32 + 4 * fq;
#pragma unroll
        for (int ai = 0; ai < 2; ++ai)
#pragma unroll
            for (int m = 0; m < 4; ++m) { float* rowp = C + (size_t)(row0 + ai * HALF + m * 16) * ldc + col0;
#pragma unroll
                for (int bj = 0; bj < 2; ++bj)
#pragma unroll
                    for (int n = 0; n < 2; ++n) *(f32x4*)(rowp + bj * HALF + n * 16) = acc[ai][bj][m][n]; }
    }
};
struct EpiSwiGLU {
    static constexpr bool PERM = true, AFTER_DRAIN = false;
    bf16_t* O; int ldc;
    __device__ __forceinline__ void operator()(f32x4 (&acc)[2][2][4][2], const Unit& u, int wr, int wc, int fr, int fq) const {
        const int row0 = u.pm * BM + wr * 64 + fr, col0 = u.pn * HALF + wc * 32 + 8 * fq;
#pragma unroll
        for (int ai = 0; ai < 2; ++ai)
#pragma unroll
            for (int m = 0; m < 4; ++m) { bf16_t* rowp = O + (size_t)(row0 + ai * HALF + m * 16) * ldc + col0;
                float g[8], uu[8], e[8];
#pragma unroll
                for (int i = 0; i < 4; ++i) { g[i] = acc[ai][0][m][0][i]; g[4 + i] = acc[ai][0][m][1][i]; uu[i] = acc[ai][1][m][0][i]; uu[4 + i] = acc[ai][1][m][1][i]; }
#pragma unroll
                for (int i = 0; i < 8; ++i) e[i] = __builtin_amdgcn_exp2f(-g[i]);
#pragma unroll
                for (int i = 0; i < 8; ++i) { e[i] = 1.0f + e[i]; g[i] = g[i] * uu[i]; }
#pragma unroll
                for (int i = 0; i < 8; ++i) e[i] = __builtin_amdgcn_rcpf(e[i]);
#pragma unroll
                for (int i = 0; i < 8; ++i) g[i] = g[i] * e[i];
                u32x4 w; w.x = cvt_pk_bf16(g[0], g[1]); w.y = cvt_pk_bf16(g[2], g[3]); w.z = cvt_pk_bf16(g[4], g[5]); w.w = cvt_pk_bf16(g[6], g[7]);
                *(u32x4*)rowp = w; }
    }
};
struct EpiInProj {
    static constexpr bool PERM = true, AFTER_DRAIN = false;
    bf16_t* O; int ldc; float* kmean; float* knp;
    __device__ __forceinline__ void operator()(f32x4 (&acc)[2][2][4][2], const Unit& u, int wr, int wc, int fr, int fq) const {
        const int row0 = u.pm * BM + wr * 64 + fr, col0 = u.pn * BM + wc * 32 + 8 * fq;
#pragma unroll
        for (int ai = 0; ai < 2; ++ai)
#pragma unroll
            for (int m = 0; m < 4; ++m) { bf16_t* rowp = O + (size_t)(row0 + ai * HALF + m * 16) * ldc + col0;
#pragma unroll
                for (int bj = 0; bj < 2; ++bj) { const f32x4 v0 = acc[ai][bj][m][0], v1 = acc[ai][bj][m][1];
                    u32x4 w; w.x = cvt_pk_bf16(v0[0], v0[1]); w.y = cvt_pk_bf16(v0[2], v0[3]); w.z = cvt_pk_bf16(v1[0], v1[1]); w.w = cvt_pk_bf16(v1[2], v1[3]);
                    *(u32x4*)(rowp + bj * HALF) = w; } }
        if (u.pn == 6 || u.pn == 7) {
#pragma unroll
            for (int bj = 0; bj < 2; ++bj) {
                if (u.pn == 7 && bj == 1) continue;
                const int head = 4 * (u.pn - 6) + 2 * bj + (wc >> 1);
#pragma unroll
                for (int ai = 0; ai < 2; ++ai) { float mx = 0.f;
#pragma unroll
                    for (int m = 0; m < 4; ++m) { const f32x4 v0 = acc[ai][bj][m][0], v1 = acc[ai][bj][m][1];
                        float ss = (v0[0] * v0[0] + v0[1] * v0[1]) + (v0[2] * v0[2] + v0[3] * v0[3]) + (v1[0] * v1[0] + v1[1] * v1[1]) + (v1[2] * v1[2] + v1[3] * v1[3]);
                        ss += __shfl_xor(ss, 16); ss += __shfl_xor(ss, 32); mx = fmaxf(mx, ss); }
                    mx = fmaxf(mx, __shfl_xor(mx, 1)); mx = fmaxf(mx, __shfl_xor(mx, 2)); mx = fmaxf(mx, __shfl_xor(mx, 4)); mx = fmaxf(mx, __shfl_xor(mx, 8));
                    if (fr == 0 && fq == 0) knp[((size_t)((u.pm >> 4) * 6 + head) * 64 + ((u.pm & 15) * 4 + ai * 2 + wr)) * 2 + (wc & 1)] = mx * 1.02f; }
            }
        }
        if (u.pn == 1 || u.pn == 2) {
#pragma unroll
            for (int bj = 0; bj < 2; ++bj) {
                if (u.pn == 1 && bj == 0) continue;
                const int cp = u.pn * BM + bj * HALF + wc * 32 + 8 * fq - 384;
                float* dst = kmean + ((size_t)((u.pm >> 4) * 6 + (cp >> 6)) * 16 + (u.pm & 15)) * 64 + (cp & 63);
#pragma unroll
                for (int n = 0; n < 2; ++n)
#pragma unroll
                    for (int i = 0; i < 4; ++i) { float s = 0.f;
#pragma unroll
                        for (int ai = 0; ai < 2; ++ai)
#pragma unroll
                            for (int m = 0; m < 4; ++m) s += acc[ai][bj][m][n][i];
                        s += DPPX(s, 0xB1); s += DPPX(s, 0x4E); s += DPPX(s, 0x141); s += DPPX(s, 0x140);
                        if (fr == 0) atomicAdd(dst + 4 * n + i, s * (1.0f / 256.0f)); }
            }
        }
    }
};
template <class Epi, class Sched, bool ALIGN_EPI = false, bool SP2 = false>
__device__ __forceinline__ void gemm_phase(PG8_LAS unsigned char* lds, const Gemm g, const Sched& S, const Epi& E) {
    int tid_ = threadIdx.x; asm volatile("" : "+v"(tid_));
    const int tid = tid_, wid = __builtin_amdgcn_readfirstlane(tid >> 6), lane = tid & 63, wr = wid >> 2, wc = wid & 3, fr = lane & 15, fq = lane >> 4;
    const int K = g.K, nt = K / BK;
    unsigned voffA[2], voffB[2];
#pragma unroll
    for (int i = 0; i < 2; ++i) { int R, C; stage_rc(tid * 16 + i * 8192, R, C); const int Rb = Epi::PERM ? ((R & ~31) + perm32(R & 31)) : R;
        voffA[i] = (unsigned)(R * K + C) * 2u; voffB[i] = (unsigned)(Rb * K + C) * 2u; }
    const size_t kstep = (size_t)(BK * 2);
    const size_t hstep = (size_t)HALF * K * 2;
    const size_t tstep = 2 * hstep;
    const unsigned ldsw = (unsigned)wid * 1024u;
    const int aoff = lds_byte(wr * 64 + fr, fq * 8), boff = lds_byte(wc * 32 + fr, fq * 8);
#define PG8_SA(b, h) (((b) * 2 + (h)) * HTB)
#define PG8_SB(b, h) ((4 + (b) * 2 + (h)) * HTB)
#define PG8_STAGE(bufoff, gbase, voff) do { _Pragma("unroll") for (int _i = 0; _i < 2; ++_i) \
        __builtin_amdgcn_global_load_lds((const unsigned*)((const char*)(gbase) + (voff)[_i]), (PG8_LAS unsigned*)(lds + (bufoff) + ldsw + _i * 8192), 16, 0, 0); } while (0)
#define PG8_LDA(dst, b, h) do { _Pragma("unroll") for (int m = 0; m < 4; ++m) _Pragma("unroll") for (int k = 0; k < 2; ++k) dst[m][k] = *(const PG8_LAS bf16x8*)(lds + PG8_SA(b, h) + aoff + m * 2048 + k * 1024); } while (0)
#define PG8_LDB(dst, b, h) do { _Pragma("unroll") for (int n = 0; n < 2; ++n) _Pragma("unroll") for (int k = 0; k < 2; ++k) dst[n][k] = *(const PG8_LAS bf16x8*)(lds + PG8_SB(b, h) + boff + n * 2048 + k * 1024); } while (0)
#define PG8_MMA(ai, bj, At, Bt) do { __builtin_amdgcn_s_setprio(1); _Pragma("unroll") for (int m = 0; m < 4; ++m) _Pragma("unroll") for (int n = 0; n < 2; ++n) _Pragma("unroll") for (int k = 0; k < 2; ++k) \
        acc[ai][bj][m][n] = __builtin_amdgcn_mfma_f32_16x16x32_bf16(Bt[n][k], At[m][k], acc[ai][bj][m][n], 0, 0, 0); __builtin_amdgcn_s_setprio(0); } while (0)
#define PG8_WAIT_V(n) asm volatile("s_waitcnt vmcnt(" #n ")" ::: "memory")
#define PG8_WAIT_L(n) asm volatile("s_waitcnt lgkmcnt(" #n ")" ::: "memory")
#define PG8_BAR __builtin_amdgcn_s_barrier()
#define PG8_SCHED __builtin_amdgcn_sched_barrier(0)
    Unit cur, nxt; int ui = 0;
    if (!S.next(0, cur)) return;
    f32x4 acc[2][2][4][2];
#pragma unroll
    for (int a = 0; a < 2; ++a)
#pragma unroll
        for (int b = 0; b < 2; ++b)
#pragma unroll
            for (int m = 0; m < 4; ++m)
#pragma unroll
                for (int n = 0; n < 2; ++n) acc[a][b][m][n] = (f32x4){0.f, 0.f, 0.f, 0.f};
    bf16x8 At[4][2], B0[2][2], B1[2][2];
    const char* cA = (const char*)g.A + (size_t)cur.pm * tstep; const char* cB = (const char*)g.Bt + (size_t)cur.pn * tstep;
    S.a_ready(cur);
    if constexpr (SP2) {
        PG8_STAGE(PG8_SB(0, 0), cB, voffB); PG8_STAGE(PG8_SB(0, 1), cB + hstep, voffB); PG8_STAGE(PG8_SA(0, 0), cA, voffA); PG8_STAGE(PG8_SA(0, 1), cA + hstep, voffA);
        if (wr == 1) PG8_BAR;
        PG8_WAIT_V(2); PG8_BAR;
        PG8_STAGE(PG8_SB(1, 0), cB + kstep, voffB); PG8_STAGE(PG8_SA(1, 0), cA + kstep, voffA); PG8_STAGE(PG8_SB(1, 1), cB + hstep + kstep, voffB);
        PG8_WAIT_V(6); PG8_BAR;
    } else {
        PG8_STAGE(PG8_SB(0, 0), cB, voffB); PG8_STAGE(PG8_SA(0, 0), cA, voffA); PG8_STAGE(PG8_SB(0, 1), cB + hstep, voffB); PG8_STAGE(PG8_SA(0, 1), cA + hstep, voffA);
        if (wr == 1) PG8_BAR;
        PG8_WAIT_V(4); PG8_BAR;
        PG8_STAGE(PG8_SB(1, 0), cB + kstep, voffB); PG8_STAGE(PG8_SA(1, 0), cA + kstep, voffA); PG8_STAGE(PG8_SB(1, 1), cB + hstep + kstep, voffB);
        PG8_WAIT_V(6); PG8_BAR;
    }
    for (;;) {
        const bool has_next = S.next(ui + 1, nxt);
        const char* nA = has_next ? (const char*)g.A + (size_t)nxt.pm * tstep : cA; const char* nB = has_next ? (const char*)g.Bt + (size_t)nxt.pn * tstep : cB;
        for (int t = 0; t < nt; t += 2) {
            const bool last = (t == nt - 2);
            const char* a1 = cA + (size_t)(t + 1) * kstep;
            const char* a2 = last ? nA : cA + (size_t)(t + 2) * kstep; const char* b2 = last ? nB : cB + (size_t)(t + 2) * kstep;
            const char* a3 = a2 + kstep; const char* b3 = b2 + kstep;
            if (last && has_next) S.a_ready(nxt);
            if constexpr (SP2) {
            PG8_LDB(B0, 0, 0); PG8_LDB(B1, 0, 1); PG8_SCHED; PG8_LDA(At, 0, 0); PG8_STAGE(PG8_SA(1, 1), a1 + hstep, voffA);
            PG8_WAIT_V(8); PG8_WAIT_L(0); PG8_BAR; PG8_MMA(0, 0, At, B0); PG8_MMA(0, 1, At, B1); PG8_BAR; PG8_SCHED;
            PG8_LDA(At, 0, 1); PG8_STAGE(PG8_SB(0, 0), b2, voffB); PG8_STAGE(PG8_SB(0, 1), b2 + hstep, voffB); PG8_STAGE(PG8_SA(0, 0), a2, voffA);
            PG8_WAIT_V(8); PG8_WAIT_L(0); PG8_BAR; PG8_MMA(1, 0, At, B0); PG8_MMA(1, 1, At, B1); PG8_BAR; PG8_SCHED;
            PG8_LDB(B0, 1, 0); PG8_LDB(B1, 1, 1); PG8_SCHED; PG8_LDA(At, 1, 0); PG8_STAGE(PG8_SA(0, 1), a2 + hstep, voffA);
            PG8_WAIT_V(8); PG8_WAIT_L(0); PG8_BAR; PG8_MMA(0, 0, At, B0); PG8_MMA(0, 1, At, B1); PG8_BAR; PG8_SCHED;
            PG8_LDA(At, 1, 1); PG8_STAGE(PG8_SB(1, 0), b3, voffB); PG8_STAGE(PG8_SB(1, 1), b3 + hstep, voffB); PG8_STAGE(PG8_SA(1, 0), a3, voffA);
            PG8_WAIT_V(8); PG8_WAIT_L(0); PG8_BAR; PG8_MMA(1, 0, At, B0); PG8_MMA(1, 1, At, B1); PG8_BAR; PG8_SCHED;
            } else {
            PG8_LDB(B0, 0, 0); PG8_SCHED; PG8_LDA(At, 0, 0); PG8_STAGE(PG8_SA(1, 1), a1 + hstep, voffA);
            PG8_WAIT_L(8); PG8_BAR; PG8_WAIT_L(0); PG8_MMA(0, 0, At, B0); PG8_BAR; PG8_SCHED;
            PG8_LDB(B1, 0, 1); PG8_STAGE(PG8_SB(0, 0), b2, voffB);
            PG8_BAR; PG8_WAIT_L(0); PG8_MMA(0, 1, At, B1); PG8_BAR;
            PG8_LDA(At, 0, 1); PG8_STAGE(PG8_SA(0, 0), a2, voffA);
            PG8_BAR; PG8_WAIT_L(0); PG8_MMA(1, 0, At, B0); PG8_BAR; PG8_SCHED;
            PG8_STAGE(PG8_SB(0, 1), b2 + hstep, voffB);
            PG8_WAIT_V(6); PG8_BAR; PG8_MMA(1, 1, At, B1); PG8_BAR;
            PG8_LDB(B0, 1, 0); PG8_SCHED; PG8_LDA(At, 1, 0); PG8_STAGE(PG8_SA(0, 1), a2 + hstep, voffA);
            PG8_WAIT_L(8); PG8_BAR; PG8_WAIT_L(0); PG8_MMA(0, 0, At, B0); PG8_BAR; PG8_SCHED;
            PG8_LDB(B1, 1, 1); PG8_STAGE(PG8_SB(1, 0), b3, voffB);
            PG8_BAR; PG8_WAIT_L(0); PG8_MMA(0, 1, At, B1); PG8_BAR;
            PG8_LDA(At, 1, 1); PG8_STAGE(PG8_SA(1, 0), a3, voffA);
            PG8_BAR; PG8_WAIT_L(0); PG8_MMA(1, 0, At, B0); PG8_BAR; PG8_SCHED;
            PG8_STAGE(PG8_SB(1, 1), b3 + hstep, voffB);
            PG8_WAIT_V(6); PG8_BAR; PG8_MMA(1, 1, At, B1); PG8_BAR;
            }
        }
        if constexpr (ALIGN_EPI) { if (wr == 0) PG8_BAR; }
        if constexpr (!Epi::AFTER_DRAIN) { E(acc, cur, wr, wc, fr, fq); S.done(cur); }
        if (!has_next) break;
#pragma unroll
        for (int a = 0; a < 2; ++a)
#pragma unroll
            for (int b = 0; b < 2; ++b)
#pragma unroll
                for (int m = 0; m < 4; ++m)
#pragma unroll
                    for (int n = 0; n < 2; ++n) acc[a][b][m][n] = (f32x4){0.f, 0.f, 0.f, 0.f};
        cur = nxt; cA = nA; cB = nB; ++ui;
        if constexpr (ALIGN_EPI) { if (wr == 1) PG8_BAR; }
    }
    PG8_WAIT_V(0);
    if constexpr (!ALIGN_EPI) { if (wr == 0) PG8_BAR; }
    PG8_BAR;
    if constexpr (Epi::AFTER_DRAIN) { E.fused(acc, cur, wr, wc, fr, fq, lds, wid, lane); S.done(cur); }
#undef PG8_SA
#undef PG8_SB
#undef PG8_STAGE
#undef PG8_LDA
#undef PG8_LDB
#undef PG8_MMA
#undef PG8_WAIT_V
#undef PG8_WAIT_L
#undef PG8_BAR
#undef PG8_SCHED
}
}

#include <hip/hip_bf16.h>
#include <cmath>
namespace attn_body {
using bf16=__hip_bfloat16;
using bf16x8=__attribute__((ext_vector_type(8)))short;
using s16x4=__attribute__((ext_vector_type(4)))short;
using f32x16=__attribute__((ext_vector_type(16)))float;
using u32x4=__attribute__((ext_vector_type(4)))unsigned;
using f32x4_t=__attribute__((ext_vector_type(4)))float;
constexpr int D=64;
constexpr int NW=8,QBLK=32,QB=QBLK*NW,KVBLK=64;
constexpr int QP=3072, OPITCH=1024;
constexpr int AUX_R0=0, AUX_INFO=1024, AUX_TAB=2048, AUX_BYTES=2048+16384+1024;
__device__ __forceinline__ int crow(int r,int hi){return (r&3)+8*(r>>2)+4*hi;}
#define SBAR() __builtin_amdgcn_sched_barrier(0)
__device__ __forceinline__ void cmask(f32x16&p0,f32x16&p1,int jb,int qrel,int hi){
  const float NEG=-INFINITY; int kb=64*jb+4*hi;
  #pragma unroll
  for(int r=0;r<16;++r){int kv=kb+(r&3)+8*(r>>2); if(kv>qrel)p0[r]=NEG; if(kv+32>qrel)p1[r]=NEG;}
}

constexpr int NSLOT=3, SLOTB=8192;
constexpr int LDS_K=0, LDS_V=NSLOT*SLOTB, LDS_WS=2*NSLOT*SLOTB, LDS_OST=LDS_WS+NW*64*4, LDS_BYTES=LDS_OST+NW*4096;
constexpr float C2=0.125f*1.4426950408889634f;
__device__ __forceinline__ void glds16(const void*gsrc,unsigned lds_dst){unsigned keep;
  asm volatile("s_mov_b32 %0, m0\n\ts_mov_b32 m0, %2\n\ts_nop 0\n\tglobal_load_lds_dwordx4 %1, off\n\ts_mov_b32 m0, %0":"=&s"(keep):"v"(gsrc),"s"(lds_dst):"memory");}
__device__ __forceinline__ float max3f(float a,float b,float c){float r;asm("v_max3_f32 %0, %1, %2, %3":"=v"(r):"v"(a),"v"(b),"v"(c));return r;}
__device__ __forceinline__ float max2f(float a,float b){float r;asm("v_max_f32_e32 %0, %1, %2":"=v"(r):"v"(a),"v"(b));return r;}
__device__ __forceinline__ float fadd_s(float a,float b){float r;asm("v_add_f32_e32 %0, %1, %2":"=v"(r):"v"(a),"v"(b));return r;}
__device__ __forceinline__ float fsub_s(float a,float b){float r;asm("v_sub_f32_e32 %0, %1, %2":"=v"(r):"v"(a),"v"(b));return r;}
typedef float f32x2_t __attribute__((ext_vector_type(2))); typedef __bf16 bf16x2_t __attribute__((ext_vector_type(2)));
__device__ __forceinline__ unsigned cvtpk_s(float lo,float hi){f32x2_t v={lo,hi};bf16x2_t b=__builtin_convertvector(v,bf16x2_t);return __builtin_bit_cast(unsigned,b);}
#define WAIT_BAR(N) asm volatile("s_waitcnt vmcnt(" #N ") lgkmcnt(0)\n\ts_barrier":::"memory")

__device__ __forceinline__ void qkt(f32x16&p0,f32x16&p1,const char*Kslot,const bf16x8*qr,const f32x16&negm,int r32,int hi){
  const char*kb=Kslot+hi*1024+r32*16;
  #pragma unroll
  for(int d0=0;d0<4;++d0){
    const bf16x8 b0=*reinterpret_cast<const bf16x8*>(kb+d0*2048);
    const bf16x8 b1=*reinterpret_cast<const bf16x8*>(kb+d0*2048+512);
    if(d0==0){p0=__builtin_amdgcn_mfma_f32_32x32x16_bf16(b0,qr[0],negm,0,0,0);p1=__builtin_amdgcn_mfma_f32_32x32x16_bf16(b1,qr[0],negm,0,0,0);}
    else{p0=__builtin_amdgcn_mfma_f32_32x32x16_bf16(b0,qr[d0],p0,0,0,0);p1=__builtin_amdgcn_mfma_f32_32x32x16_bf16(b1,qr[d0],p1,0,0,0);}}
}
typedef __attribute__((address_space(3))) const char* lds_cptr;
typedef short v4i16_t __attribute__((ext_vector_type(4)));
__device__ __forceinline__ void kload8(bf16x8*kf,lds_cptr kp){
  kf[0]=*(const __attribute__((address_space(3))) bf16x8*)(kp);      kf[1]=*(const __attribute__((address_space(3))) bf16x8*)(kp+512);
  kf[2]=*(const __attribute__((address_space(3))) bf16x8*)(kp+2048); kf[3]=*(const __attribute__((address_space(3))) bf16x8*)(kp+2560);
  kf[4]=*(const __attribute__((address_space(3))) bf16x8*)(kp+4096); kf[5]=*(const __attribute__((address_space(3))) bf16x8*)(kp+4608);
  kf[6]=*(const __attribute__((address_space(3))) bf16x8*)(kp+6144); kf[7]=*(const __attribute__((address_space(3))) bf16x8*)(kp+6656);
}
__device__ __forceinline__ void kload2(bf16x8*kf,lds_cptr kp,int j){ kf[2*j]=*(const __attribute__((address_space(3))) bf16x8*)(kp+j*2048); kf[2*j+1]=*(const __attribute__((address_space(3))) bf16x8*)(kp+j*2048+512); }
__device__ __forceinline__ s16x4 vtr(lds_cptr p){ return __builtin_bit_cast(s16x4,__builtin_amdgcn_ds_read_tr16_b64_v4i16((__attribute__((address_space(3))) v4i16_t*)p)); }
__device__ __forceinline__ float rowmax(const f32x16&p0,const f32x16&p1){
  float a=max3f(p0[0],p0[1],p1[0]),b=max3f(p0[2],p0[3],p1[1]);a=max3f(a,p1[2],p1[3]);
  #pragma unroll
  for(int r=4;r<16;r+=4){a=max3f(a,p0[r],p0[r+1]);b=max3f(b,p0[r+2],p0[r+3]);a=max3f(a,p1[r],p1[r+1]);b=max3f(b,p1[r+2],p1[r+3]);}
  const float m=max2f(a,b);
  auto rr=__builtin_amdgcn_permlane32_swap(__float_as_uint(m),__float_as_uint(m),false,false);
  return max2f(__uint_as_float(rr[0]),__uint_as_float(rr[1]));
}
__device__ __forceinline__ void pv(f32x16*o,int vb,bf16x8 pa0,bf16x8 pa1,bf16x8 pa2,bf16x8 pa3){
  #pragma unroll
  for(int d0=0;d0<2;++d0){s16x4 lo[4],hi[4];
    #pragma unroll
    for(int ks=0;ks<4;++ks){
      asm volatile("ds_read_b64_tr_b16 %0,%1 offset:%c2":"=&v"(lo[ks]):"v"(vb),"i"(d0*4096+ks*1024):"memory");
      asm volatile("ds_read_b64_tr_b16 %0,%1 offset:%c2":"=&v"(hi[ks]):"v"(vb),"i"(d0*4096+ks*1024+512):"memory");}
    asm volatile("s_waitcnt lgkmcnt(0)":::"memory");SBAR();
    #define PK(k) (bf16x8){lo[k][0],lo[k][1],lo[k][2],lo[k][3],hi[k][0],hi[k][1],hi[k][2],hi[k][3]}
    o[d0]=__builtin_amdgcn_mfma_f32_32x32x16_bf16(pa0,PK(0),o[d0],0,0,0);
    o[d0]=__builtin_amdgcn_mfma_f32_32x32x16_bf16(pa1,PK(1),o[d0],0,0,0);
    o[d0]=__builtin_amdgcn_mfma_f32_32x32x16_bf16(pa2,PK(2),o[d0],0,0,0);
    o[d0]=__builtin_amdgcn_mfma_f32_32x32x16_bf16(pa3,PK(3),o[d0],0,0,0);
    #undef PK
  }
}

#ifndef ATTN_STORE16
#define ATTN_STORE16(p,v) (*(u32x4*)(p)=(v))
#endif
template<int KIND,int THRL> __device__ __forceinline__ void attn_unit(const bf16*Qg,const bf16*__restrict__ Kg,const bf16*__restrict__ Vg,bf16*Og,const int NT,const int tile0,const int q0,const int qb,char*shm,lds_cptr aux){
  int tid_=threadIdx.x; asm volatile("":"+v"(tid_));
  const int tid=tid_,lane=tid&63,r32=lane&31,hi=lane>>5; const int wid=__builtin_amdgcn_readfirstlane(tid>>6);
  const bf16*Qw=Qg+(long)(wid*QBLK)*QP;
  const bf16*Kh=Kg,*Vh=Vg;
  const unsigned lds0=(unsigned)(uintptr_t)shm;
  float*wsf=(float*)(shm+LDS_WS)+wid*64;
  const bf16*ksrc=Kh+(long)lane*QP+wid*8;
  const bf16*vsrc=Vh+(long)(16*(wid&3)+(lane>>2))*QP+(wid>>2)*32+(lane&3)*8;
  const unsigned kdst=lds0+LDS_K+wid*1024, vdst=lds0+LDS_V+wid*1024;
  #define DMA_K(t,slot) glds16(ksrc+(long)(t)*KVBLK*QP,(unsigned)__builtin_amdgcn_readfirstlane(kdst+(slot)))
  #define DMA_V(t,slot) glds16(vsrc+(long)(t)*KVBLK*QP,(unsigned)__builtin_amdgcn_readfirstlane(vdst+(slot)))
  const int vb0=(int)(lds0+LDS_V)+((lane>>4)&1)*32+(lane&3)*8+(4*hi+((lane&15)>>2))*64;
  const char*Kbase=shm+LDS_K; bf16x8 kf[8];
  const lds_cptr shm3=(lds_cptr)shm; const lds_cptr kp0=shm3+LDS_K+hi*1024+r32*16; const lds_cptr vp0=shm3+LDS_V+((lane>>4)&1)*32+(lane&3)*8+(4*hi+((lane&15)>>2))*64;
  DMA_K(0,0);DMA_V(0,0);DMA_K(1,SLOTB);
  bf16x8 qr[4];
  #pragma unroll
  for(int d0=0;d0<4;++d0)qr[d0]=*reinterpret_cast<const bf16x8*>(&Qw[(long)r32*QP+d0*16+hi*8]);
  typedef __attribute__((address_space(3))) const float* lds_fptr; typedef __attribute__((address_space(3))) const unsigned* lds_uptr; typedef __attribute__((address_space(3))) const f32x4_t* lds_f4ptr;
  const int myrow=wid*QBLK+r32; const lds_fptr aux_tab=(lds_fptr)(aux+AUX_TAB);
  float mhat=((lds_fptr)(aux+AUX_R0))[myrow],l_reg=0.f; const unsigned rinfo=((lds_uptr)(aux+AUX_INFO))[myrow];
  f32x16 o[2];o[0]=f32x16{};o[1]=f32x16{};f32x16 negm=f32x16{};
  #define NEGM_SET(tn) do{ if(KIND==1){ const int bn_=(tile0+(tn))>>2; const float nv_=(bn_<qb&&!((rinfo>>bn_)&1u))?-INFINITY:-mhat; _Pragma("unroll") for(int r=0;r<16;++r)negm[r]=nv_; asm volatile("":"+v"(negm)); } }while(0)
  NEGM_SET(0);
  const float NEGI=-INFINITY;
  #define CFENCE() asm volatile("":::"memory")
  #define POST(C0,C1,t) do{ \
    if(KIND==0){ const float nm_=-mhat; asm volatile("s_nop 15\n\ts_nop 7":"+v"(C0),"+v"(C1));   \
      const lds_f4ptr cp_=(lds_f4ptr)(aux_tab+((tile0+(t))*64+4*hi)); \
      _Pragma("unroll") for(int g_=0;g_<4;++g_){ const f32x4_t a_=cp_[2*g_],b_=cp_[8+2*g_]; \
        _Pragma("unroll") for(int i_=0;i_<4;++i_){ C0[4*g_+i_]=fadd_s(C0[4*g_+i_],fsub_s(nm_,a_[i_])); C1[4*g_+i_]=fadd_s(C1[4*g_+i_],fsub_s(nm_,b_[i_])); } if(g_==1)CFENCE(); } } \
    else { const int blk_=(tile0+(t))>>2; \
      const int dw_=(q0+wid*QBLK)-(tile0+(t))*64;     \
      if(blk_>=qb-1&&dw_<176&&dw_>-32){ asm volatile("s_nop 15\n\ts_nop 7":"+v"(C0),"+v"(C1)); const int db_=(q0+myrow)-((tile0+(t))*64+4*hi); \
        _Pragma("unroll") for(int r=0;r<16;++r){ const int d_=db_-((r&3)+8*(r>>2)); const int i0_=d_<0?0:(d_>128?128:d_), e_=d_-32, i1_=e_<0?0:(e_>128?128:e_); C0[r]=fadd_s(C0[r],aux_tab[i0_]); C1[r]=fadd_s(C1[r],aux_tab[i1_]); if((r&3)==3)CFENCE(); } } } \
  }while(0)
  const int qrel=wid*QBLK+r32;
  #define CMASK(P0,P1,t) do{int jb_=(t)-(NT-4); if(jb_>=0)cmask(P0,P1,jb_,qrel,hi);}while(0)
  bool resc=false;
  #define START(P0,P1) do{ const float rm=rowmax(P0,P1); resc=false; \
    { const float dl=max2f(rm,0.f); mhat=fadd_s(mhat,dl); \
      _Pragma("unroll") for(int r=0;r<16;++r){P0[r]=fsub_s(P0[r],dl);P1[r]=fsub_s(P1[r],dl);} \
      NEGM_SET(1); } \
    _Pragma("unroll") for(int r=0;r<16;++r)P0[r]=__builtin_amdgcn_exp2f(P0[r]); }while(0)
  #define RESC() do{ if(resc){ asm volatile("s_waitcnt lgkmcnt(0)":::"memory"); \
      _Pragma("unroll") for(int d_=0;d_<2;++d_) _Pragma("unroll") for(int r=0;r<16;++r)o[d_][r]*=wsf[crow(r,hi)]; } }while(0)
  f32x16 pA0,pA1,pB0,pB1;
  int sl_prev=0,sl_cur=0,sl_next=SLOTB;
  #define ROT() do{sl_prev=sl_cur;sl_cur=sl_next;sl_next=(sl_next==(NSLOT-1)*SLOTB)?0:sl_next+SLOTB;}while(0)
  DMA_K(2,2*SLOTB);
  WAIT_BAR(3);
  qkt(pA0,pA1,Kbase,qr,negm,r32,hi);asm volatile("s_nop 15\n\ts_nop 7":"+v"(pA0),"+v"(pA1));CMASK(pA0,pA1,0);POST(pA0,pA1,0);
  START(pA0,pA1);
  _Pragma("unroll") for(int r=0;r<16;++r)pA1[r]=__builtin_amdgcn_exp2f(pA1[r]);
  WAIT_BAR(0);
  DMA_K(3,0);DMA_V(1,SLOTB);
  ROT();
  kload8(kf,kp0+sl_cur);
  WAIT_BAR(2);
  s16x4 vlo[8],vhi[8]; u32x4 pw0,pw1,pw2,pw3;
  #define PKW(P,B) cvtpk_s(P[B],P[B+1])
  #define PAF(k) __builtin_bit_cast(bf16x8,pw##k)
  #define VFR(i) (bf16x8){vlo[i][0],vlo[i][1],vlo[i][2],vlo[i][3],vhi[i][0],vhi[i][1],vhi[i][2],vhi[i][3]}
  #define PIN(x) asm volatile("":"+v"(x))
  #define MX3(a,b,c) __builtin_fmaxf(__builtin_fmaxf((a),(b)),(c))
  #define GAPA(MF,A0,A1,A2,A3,W0,W1,PW) do{ MF; sacc+=A0; sacc+=A1; sacc+=A2; sacc+=A3; PIN(sacc); W0; W1; PIN(PW); SBAR(); }while(0)
  #define EX(v) __builtin_amdgcn_exp2f(v)
  #define GAPB(MF,X,B) do{ MF; X[B]=EX(X[B]); X[B+1]=EX(X[B+1]); X[B+2]=EX(X[B+2]); X[B+3]=EX(X[B+3]); PIN(X); SBAR(); }while(0)
  #define VRD(i) do{ vlo[i]=vtr(vp_+(((i)>>2)*4096+((i)&3)*1024)); vhi[i]=vtr(vp_+(((i)>>2)*4096+((i)&3)*1024+512)); }while(0)
  #define KRD(G,j) do{ if(G){ kload2(kf,kp0+sl_next,j); SBAR(); } }while(0)
  #define STEP(C0,C1,P0,P1,t,GK,GV,GL) do{ SBAR(); \
    const lds_cptr vp_=vp0+sl_prev; \
    VRD(0); SBAR(); float sacc=(P0[0]+P0[1]); \
    GAPA(C0=__builtin_amdgcn_mfma_f32_32x32x16_bf16(kf[0],qr[0],negm,0,0,0), P0[2],P0[3],P0[4],P0[5],     pw0[0]=PKW(P0,0), pw0[1]=PKW(P0,2), pw0); \
    VRD(4); SBAR(); GAPA(C1=__builtin_amdgcn_mfma_f32_32x32x16_bf16(kf[1],qr[0],negm,0,0,0), P0[6],P0[7],P0[8],P0[9],     pw0[2]=PKW(P0,4), pw0[3]=PKW(P0,6), pw0); \
    VRD(1); SBAR(); GAPA(C0=__builtin_amdgcn_mfma_f32_32x32x16_bf16(kf[2],qr[1],C0,0,0,0),   P0[10],P0[11],P0[12],P0[13], pw1[0]=PKW(P0,8), pw1[1]=PKW(P0,10), pw1); \
    VRD(5); SBAR(); GAPA(C1=__builtin_amdgcn_mfma_f32_32x32x16_bf16(kf[3],qr[1],C1,0,0,0),   P0[14],P0[15],P1[0],P1[1],   pw1[2]=PKW(P0,12),pw1[3]=PKW(P0,14), pw1); \
    VRD(2); SBAR(); GAPA(C0=__builtin_amdgcn_mfma_f32_32x32x16_bf16(kf[4],qr[2],C0,0,0,0),   P1[2],P1[3],P1[4],P1[5],     pw2[0]=PKW(P1,0), pw2[1]=PKW(P1,2), pw2); \
    VRD(6); SBAR(); GAPA(C1=__builtin_amdgcn_mfma_f32_32x32x16_bf16(kf[5],qr[2],C1,0,0,0),   P1[6],P1[7],P1[8],P1[9],     pw2[2]=PKW(P1,4), pw2[3]=PKW(P1,6), pw2); \
    VRD(3); SBAR(); GAPA(C0=__builtin_amdgcn_mfma_f32_32x32x16_bf16(kf[6],qr[3],C0,0,0,0),   P1[10],P1[11],P1[12],P1[13], pw3[0]=PKW(P1,8), pw3[1]=PKW(P1,10), pw3); \
    VRD(7); SBAR(); GAPA(C1=__builtin_amdgcn_mfma_f32_32x32x16_bf16(kf[7],qr[3],C1,0,0,0),   P1[14],P1[15],0.f,0.f,       pw3[2]=PKW(P1,12),pw3[3]=PKW(P1,14), pw3); \
    l_reg+=sacc; \
    if(GK){DMA_K((t)+3,sl_cur);} if(GV){DMA_V((t)+1,sl_next);} \
    CMASK(C0,C1,t); POST(C0,C1,t); \
    { float a=MX3(C0[0],C0[1],C1[0]),b=MX3(C0[2],C0[3],C1[1]); a=MX3(a,C1[2],C1[3]); \
      _Pragma("unroll") for(int r=4;r<16;r+=4){a=MX3(a,C0[r],C0[r+1]);b=MX3(b,C0[r+2],C0[r+3]);a=MX3(a,C1[r],C1[r+1]);b=MX3(b,C1[r+2],C1[r+3]);} \
      float rm=__builtin_fmaxf(a,b); { auto rr=__builtin_amdgcn_permlane32_swap(__float_as_uint(rm),__float_as_uint(rm),false,false); rm=__builtin_fmaxf(__uint_as_float(rr[0]),__uint_as_float(rr[1])); } \
      resc=false; \
      if(__builtin_expect(__any(rm>(float)THRL),0)){ const float dl=__builtin_fmaxf(rm,0.f); mhat+=dl; \
        _Pragma("unroll") for(int r=0;r<16;++r){C0[r]-=dl;C1[r]-=dl;} \
        const float f=__builtin_amdgcn_exp2f(-dl); l_reg*=f; if(hi==0)wsf[r32]=f; resc=true; } \
      if(KIND==1&&(resc||((tile0+(t)+1)&3)==0)) NEGM_SET((t)+1); } \
    SBAR(); \
    GAPB(o[0]=__builtin_amdgcn_mfma_f32_32x32x16_bf16(PAF(0),VFR(0),o[0],0,0,0), C0,0); \
    GAPB(o[1]=__builtin_amdgcn_mfma_f32_32x32x16_bf16(PAF(0),VFR(4),o[1],0,0,0), C0,4); \
    KRD(GL,0); GAPB(o[0]=__builtin_amdgcn_mfma_f32_32x32x16_bf16(PAF(1),VFR(1),o[0],0,0,0), C0,8); \
    KRD(GL,1); GAPB(o[1]=__builtin_amdgcn_mfma_f32_32x32x16_bf16(PAF(1),VFR(5),o[1],0,0,0), C0,12); \
    KRD(GL,2); GAPB(o[0]=__builtin_amdgcn_mfma_f32_32x32x16_bf16(PAF(2),VFR(2),o[0],0,0,0), C1,0); \
    KRD(GL,3); GAPB(o[1]=__builtin_amdgcn_mfma_f32_32x32x16_bf16(PAF(2),VFR(6),o[1],0,0,0), C1,4); \
    GAPB(o[0]=__builtin_amdgcn_mfma_f32_32x32x16_bf16(PAF(3),VFR(3),o[0],0,0,0), C1,8); \
    GAPB(o[1]=__builtin_amdgcn_mfma_f32_32x32x16_bf16(PAF(3),VFR(7),o[1],0,0,0), C1,12); \
    }while(0)
  int t=1;
  #undef CMASK
  #define CMASK(P0,P1,t) do{}while(0)
  for(;t+5<NT;t+=2){
    STEP(pB0,pB1,pA0,pA1,t,true,true,true);     WAIT_BAR(2); RESC(); ROT();
    STEP(pA0,pA1,pB0,pB1,t+1,true,true,true);   WAIT_BAR(2); RESC(); ROT();
  }
  #undef CMASK
  #define CMASK(P0,P1,t) do{int jb_=(t)-(NT-4); if(jb_>=0)cmask(P0,P1,jb_,qrel,hi);}while(0)
  #define ENDW(tt) do{ if((tt)+3<NT){WAIT_BAR(2);} else if((tt)+2<NT){WAIT_BAR(1);} else {WAIT_BAR(0);} }while(0)
  for(;t+1<NT;t+=2){
    STEP(pB0,pB1,pA0,pA1,t,(t+3<NT),(t+1<NT),(t+1<NT));       ENDW(t);   RESC(); ROT();
    STEP(pA0,pA1,pB0,pB1,t+1,(t+4<NT),(t+2<NT),(t+2<NT));     ENDW(t+1); RESC(); ROT();
  }
  STEP(pB0,pB1,pA0,pA1,NT-1,false,false,false); RESC();
  { float sacc=pB0[0]+pB0[1]; _Pragma("unroll") for(int r=2;r<16;++r)sacc+=pB0[r]; _Pragma("unroll") for(int r=0;r<16;++r)sacc+=pB1[r]; l_reg+=sacc;
    pw0=(u32x4){PKW(pB0,0),PKW(pB0,2),PKW(pB0,4),PKW(pB0,6)};pw1=(u32x4){PKW(pB0,8),PKW(pB0,10),PKW(pB0,12),PKW(pB0,14)};pw2=(u32x4){PKW(pB1,0),PKW(pB1,2),PKW(pB1,4),PKW(pB1,6)};pw3=(u32x4){PKW(pB1,8),PKW(pB1,10),PKW(pB1,12),PKW(pB1,14)};
    SBAR(); pv(o,vb0+sl_cur,PAF(0),PAF(1),PAF(2),PAF(3)); }
  #undef PKW
  #undef PAF
  #undef VFR
  #undef PIN
  #undef MX3
  #undef GAPA
  #undef GAPB
  #undef EX
  #undef VRD
  #undef KRD
  #undef STEP
  #undef ENDW
  {auto rr=__builtin_amdgcn_permlane32_swap(__float_as_uint(l_reg),__float_as_uint(l_reg),false,false);l_reg=__uint_as_float(rr[0])+__uint_as_float(rr[1]);}
  if(hi==0)wsf[32+r32]=l_reg;asm volatile("s_waitcnt lgkmcnt(0)":::"memory");
  float rli[16];
  #pragma unroll
  for(int r=0;r<16;++r)rli[r]=__builtin_amdgcn_rcpf(wsf[32+crow(r,hi)]);
  bf16*Ow=Og+(long)(wid*QBLK)*OPITCH;
  { bf16*stg=(bf16*)(shm+LDS_OST)+wid*2048;
    #pragma unroll
    for(int r=0;r<16;++r){const int orow=crow(r,hi);
      #pragma unroll
      for(int d0=0;d0<2;++d0)stg[orow*64+d0*32+r32]=__float2bfloat16(o[d0][r]*rli[r]);}
    asm volatile("s_waitcnt lgkmcnt(0)":::"memory");
    #pragma unroll
    for(int i=0;i<4;++i){const int row=i*8+(lane>>3),ch=lane&7; const u32x4 v=*(const u32x4*)(stg+row*64+ch*8); ATTN_STORE16(Ow+(long)row*OPITCH+ch*8,v);} }
  asm volatile("s_waitcnt lgkmcnt(0)\n\ts_barrier":::"memory");
  #undef DMA_K
  #undef DMA_V
  #undef CMASK
  #undef START
  #undef RESC
  #undef ROT
  #undef POST
  #undef NEGM_SET
  #undef CFENCE
}
constexpr int ATTN_LDS_BYTES=LDS_BYTES;
#undef SBAR
#undef WAIT_BAR
}

#define GAS __attribute__((address_space(1)))
#define LAS __attribute__((address_space(3)))
typedef unsigned short bf16;
typedef unsigned v4u __attribute__((ext_vector_type(4)));
typedef float f32x4 __attribute__((ext_vector_type(4)));
typedef short bf16x8 __attribute__((ext_vector_type(8)));
typedef GAS unsigned gu32;
typedef GAS unsigned long long gu64;
#define RLX_AGENT __ATOMIC_RELAXED, __HIP_MEMORY_SCOPE_AGENT
#define LDS_WAIT() asm volatile("s_waitcnt lgkmcnt(0)" ::: "memory")
#define VM_WAIT() asm volatile("s_waitcnt vmcnt(0)" ::: "memory")
__device__ __forceinline__ unsigned long long rt() { return __builtin_amdgcn_s_memrealtime(); }

#define XB_TMO      128
#define XB_XCNT(j)  (256  + 64 * (j))
#define XB_XSUB(j)  (1280 + 64 * (j))
#define XB_XGEN(j)  (2304 + 64 * (j))
#define XB_TOP      3328
#define XB_TOPGEN   3392
#define XCD_BAR_WORDS 3456
#define XB_SPIN_CAP (1u << 18)

__device__ __forceinline__ unsigned xb_ld(unsigned* p)              { return __hip_atomic_load(p, __ATOMIC_RELAXED, __HIP_MEMORY_SCOPE_AGENT); }
__device__ __forceinline__ unsigned xb_add(unsigned* p, unsigned v) { return __hip_atomic_fetch_add(p, v, __ATOMIC_RELAXED, __HIP_MEMORY_SCOPE_AGENT); }
__device__ __forceinline__ unsigned xb_xcc_id() { return (unsigned)__builtin_amdgcn_s_getreg((3 << 11) | 20) & 0xFu; }
#define XB_SPIN(cond, bar) do { unsigned _sp = 0; while (cond) { __builtin_amdgcn_s_sleep(1); \
    if ((++_sp & 255u) == 0u) { if (xb_ld(&(bar)[XB_TMO])) break; if (_sp > XB_SPIN_CAP) { atomicAdd(&(bar)[XB_TMO], 1u); break; } } } } while (0)

struct XcdBarrier {
    unsigned* bar; unsigned x;
    volatile LAS unsigned* st;
};

__device__ __forceinline__ XcdBarrier xcd_barrier_post(unsigned* bar, volatile LAS unsigned* st) {
    XcdBarrier b; b.bar = bar; b.x = xb_xcc_id(); b.st = st;
    if (threadIdx.x == 0) (void)xb_add(&bar[XB_XCNT(b.x)], 1u);
    return b;
}
__device__ __forceinline__ void xcd_barrier_complete(unsigned* bar, unsigned x, unsigned& nloc, unsigned& nx) {
    const unsigned G = gridDim.x * gridDim.y * gridDim.z;
    unsigned sum, cnt, mine, sp = 0u;
    for (;;) {
        sum = 0u; cnt = 0u; mine = 0u;
#pragma unroll
        for (unsigned j = 0; j < 16; ++j) { const unsigned c = xb_ld(&bar[XB_XCNT(j)]); sum += c; cnt += (c > 0u) ? 1u : 0u; mine = (j == x) ? c : mine; }
        if (sum == G) break;
        __builtin_amdgcn_s_sleep(1);
        if ((++sp & 255u) == 0u) { if (xb_ld(&bar[XB_TMO])) break; if (sp > XB_SPIN_CAP) { atomicAdd(&bar[XB_TMO], 1u); break; } }
    }
    nloc = mine > 0u ? mine : 1u; nx = cnt > 0u ? cnt : 1u;
}

__device__ __forceinline__ void xcd_barrier(const XcdBarrier& b) {
    asm volatile("s_waitcnt vmcnt(0)" ::: "memory");
    __syncthreads();
    if (threadIdx.x == 0) {
        unsigned* bar = b.bar;
        __builtin_amdgcn_s_waitcnt(0);
        unsigned nloc = b.st[0], nx = b.st[1];
        if (nloc == 0u) { xcd_barrier_complete(bar, b.x, nloc, nx); b.st[0] = nloc; b.st[1] = nx; }
        const unsigned old = xb_add(&bar[XB_XSUB(b.x)], 1u);
        const unsigned gen = old / nloc;
        if (old + 1u == (gen + 1u) * nloc) {
            __builtin_amdgcn_fence(__ATOMIC_RELEASE, "agent");
            asm volatile("s_waitcnt vmcnt(0)" ::: "memory");
            const unsigned og = xb_add(&bar[XB_TOP], 1u);
            const unsigned tg = og / nx;
            if (og + 1u == (tg + 1u) * nx) xb_add(&bar[XB_TOPGEN], 1u);
            else XB_SPIN(xb_ld(&bar[XB_TOPGEN]) == tg, bar);
            __builtin_amdgcn_fence(__ATOMIC_ACQUIRE, "agent");
            xb_add(&bar[XB_XGEN(b.x)], 1u);
            asm volatile("s_waitcnt vmcnt(0)" ::: "memory");
        } else {
            XB_SPIN(xb_ld(&bar[XB_XGEN(b.x)]) == gen, bar);
            __builtin_amdgcn_fence(__ATOMIC_ACQUIRE, "agent");
            asm volatile("s_waitcnt vmcnt(0)" ::: "memory");
        }
    }
    __syncthreads();
}

constexpr int NWAVES = 8;
constexpr int RING_OFF = 0, RING_BYTES = 131072;
constexpr int LDSCTL_OFF = RING_BYTES, MISC_OFF = LDSCTL_OFF + 320;
constexpr int LDS_BYTES = 147456;
constexpr int CW_TMO = 0, CW_CODE = 1, CW_Q = 1024, CW_BAR = 4096;
constexpr float PRUNE_TH = 36.f;
constexpr int AUX_OFF = 86016;
constexpr size_t CTL_ZERO_BYTES = 2 * MiB;
constexpr size_t WS_KM = 1 * MiB, KM_LAYER = 256 * 1024;
constexpr int NPH_LAYER = 7, NPH = 1 + DEPTH * NPH_LAYER;

__device__ __forceinline__ void transpose_item(const float* W, int ldsrc, int k0, int srccol0, float scale, const float* gk, bf16* dst, int ldd, LAS float* scr, int lane) {
    float t[32];
#pragma unroll
    for (int i = 0; i < 32; ++i) { const int kk = 2 * i + (lane >> 5); t[i] = W[(size_t)(k0 + kk) * ldsrc + srccol0 + (lane & 31)]; }
#pragma unroll
    for (int i = 0; i < 32; ++i) { const int kk = 2 * i + (lane >> 5); scr[kk * 33 + (lane & 31)] = t[i] * (gk ? scale * gk[k0 + kk] : scale); }
    LDS_WAIT(); asm volatile("" ::: "memory");
    const int c = lane & 7;
#pragma unroll
    for (int j = 0; j < 4; ++j) { const int n = (lane >> 3) + 8 * j; const LAS float* s = scr + (8 * c) * 33 + n;
        v4u o; o.x = pk2(s[0 * 33], s[1 * 33]); o.y = pk2(s[2 * 33], s[3 * 33]); o.z = pk2(s[4 * 33], s[5 * 33]); o.w = pk2(s[6 * 33], s[7 * 33]);
        *(GAS v4u*)(dst + (size_t)n * ldd + k0 + 8 * c) = o; }
    LDS_WAIT(); asm volatile("" ::: "memory");
}

__device__ __forceinline__ float u2f(const unsigned u) { return __builtin_bit_cast(float, u); }
__device__ __forceinline__ void unpack8(const u32x4 w, float* f) {
    f[0] = __builtin_bit_cast(float, w.x << 16); f[1] = __builtin_bit_cast(float, w.x & 0xffff0000u); f[2] = __builtin_bit_cast(float, w.y << 16); f[3] = __builtin_bit_cast(float, w.y & 0xffff0000u);
    f[4] = __builtin_bit_cast(float, w.z << 16); f[5] = __builtin_bit_cast(float, w.z & 0xffff0000u); f[6] = __builtin_bit_cast(float, w.w << 16); f[7] = __builtin_bit_cast(float, w.w & 0xffff0000u);
}
__device__ __forceinline__ u32x4 pack8(const float* f) { u32x4 w; w.x = pk2(f[0], f[1]); w.y = pk2(f[2], f[3]); w.z = pk2(f[4], f[5]); w.w = pk2(f[6], f[7]); return w; }
__device__ __forceinline__ f32x4 ld4(const float* p) { return *(const f32x4*)p; }
__device__ __forceinline__ f32x4 ld4(const LAS float* p) { return *(const LAS f32x4*)p; }
template <bool RF32, bool XF32, class WFP>
__device__ __forceinline__ void rows_compute(const u32x4 (&cr)[4], const u32x4 (&cy)[2], const float rin, const int m, const int lane, const bool has_y, const float (&gp)[16], void* xout, const bool norm_out, float* rs, WFP WF, const bool has_wf, const float bfl, float* logf) {
    float v[16];
    if (RF32) {
#pragma unroll
        for (int q = 0; q < 4; ++q) { v[4 * q] = u2f(cr[q].x); v[4 * q + 1] = u2f(cr[q].y); v[4 * q + 2] = u2f(cr[q].z); v[4 * q + 3] = u2f(cr[q].w); }
    } else { unpack8(cr[0], v); unpack8(cr[1], v + 8); }
#pragma unroll
    for (int i = 0; i < 16; ++i) v[i] *= rin;
    if (has_y) { float yv[16]; unpack8(cy[0], yv); unpack8(cy[1], yv + 8); float ss = 0.f;
#pragma unroll
        for (int i = 0; i < 16; ++i) ss += yv[i] * yv[i];
        const float r = __builtin_amdgcn_rsqf(wave_sum(ss) * (1.f / DM) + RMS_EPS);
#pragma unroll
        for (int i = 0; i < 16; ++i) v[i] += yv[i] * r * gp[i]; }
    float r = 1.f;
    if (norm_out || has_wf) { float ss = 0.f;
#pragma unroll
        for (int i = 0; i < 16; ++i) ss += v[i] * v[i];
        const float ms = wave_sum(ss) * (1.f / DM) + RMS_EPS; r = __builtin_amdgcn_rsqf(ms);
        if (rs && lane == 0) rs[m] = __builtin_amdgcn_sqrtf(ms); }
    if (xout) {
        float w[16];
#pragma unroll
        for (int i = 0; i < 16; ++i) w[i] = norm_out ? v[i] * r : v[i];
        if (XF32) { f32x4* o = (f32x4*)((float*)xout + (size_t)m * DM + 8 * lane); o[0] = (f32x4){w[0], w[1], w[2], w[3]}; o[1] = (f32x4){w[4], w[5], w[6], w[7]}; o[128] = (f32x4){w[8], w[9], w[10], w[11]}; o[129] = (f32x4){w[12], w[13], w[14], w[15]}; }
        else { u32x4* o = (u32x4*)((bf16*)xout + (size_t)m * DM + 8 * lane); o[0] = pack8(w); o[64] = pack8(w + 8); } }
    {
        if (has_wf) {
            float d[8];
#pragma unroll
            for (int h = 0; h < 8; ++h) { d[h] = 0.f;
                if (h < NH) {
#pragma unroll
                    for (int q = 0; q < 4; ++q) { const f32x4 w = ld4(WF + ((h * 4 + q) * 64 + lane) * 4); d[h] += (v[4 * q] * w.x + v[4 * q + 1] * w.y) + (v[4 * q + 2] * w.z + v[4 * q + 3] * w.w); } } }
#define DPPMOV(x_, ctrl_) __builtin_bit_cast(float, __builtin_amdgcn_update_dpp(0, __builtin_bit_cast(int, (x_)), (ctrl_), 0xf, 0xf, false))
            const bool b2 = (lane & 4) != 0, e0 = ((lane ^ (lane >> 2)) & 1) != 0, e1 = (((lane >> 1) ^ (lane >> 2)) & 1) != 0;
            float e4[4], e2[2];
#pragma unroll
            for (int j = 0; j < 4; ++j) { const float snd = e0 ? d[j] : d[j + 4], kp = e0 ? d[j + 4] : d[j]; e4[j] = kp + DPPMOV(snd, 0xB1); }
#pragma unroll
            for (int j = 0; j < 2; ++j) { const float snd = e1 ? e4[j] : e4[j + 2], kp = e1 ? e4[j + 2] : e4[j]; e2[j] = kp + DPPMOV(snd, 0x4E); }
            float e = (b2 ? e2[1] : e2[0]) + DPPMOV(b2 ? e2[0] : e2[1], 0x141);
            e += DPPMOV(e, 0x128);
            e += __shfl_xor(e, 16);
            { auto rr = __builtin_amdgcn_permlane32_swap(__float_as_uint(e), __float_as_uint(e), false, false); e = __uint_as_float(rr[0]) + __uint_as_float(rr[1]); }
#undef DPPMOV
            const int hh = 4 * (int)e0 + 2 * (int)e1 + (int)b2;
            if (lane < 8 && hh < NH) logf[(size_t)m * NH + hh] = e * r + bfl; } }
}
template <bool RF32, bool XF32, class WFP>
__device__ __forceinline__ void rows_phase(const int gw, const int NGW, const int lane, const void* resid, const float* rs_in, const bf16* y, const float* gpost, void* xout, const bool norm_out, float* rs, WFP WF, const bool has_wf, const float* bfv, float* logf) {
    float gp[16];
#pragma unroll
    for (int j = 0; j < 2; ++j)
#pragma unroll
        for (int c = 0; c < 2; ++c) { const int e = 8 * lane + 512 * j + 4 * c;
            const f32x4 a = y ? *(const f32x4*)(gpost + e) : (f32x4){0.f, 0.f, 0.f, 0.f};
#pragma unroll
            for (int i = 0; i < 4; ++i) gp[8 * j + 4 * c + i] = a[i]; }
    const int hh_ = 4 * ((lane ^ (lane >> 2)) & 1) + 2 * (((lane >> 1) ^ (lane >> 2)) & 1) + ((lane >> 2) & 1);
    const float bfl = (has_wf && lane < 8 && hh_ < NH) ? bfv[hh_] : 0.f;
    const bool has_y = (y != nullptr);
    u32x4 r0[4], y0[2], r1[4], y1[2], r2[4], y2[2], r3[4], y3[2], r4[4], y4[2]; float s0 = 1.f, s1 = 1.f, s2 = 1.f, s3 = 1.f, s4 = 1.f;
#define ROWS_LOAD(R, Y, SC, m_) do { if (rs_in) SC = rs_in[(m_)]; \
        if (RF32) { const u32x4* p_ = (const u32x4*)((const float*)resid + (size_t)(m_) * DM + 8 * lane); R[0] = p_[0]; R[1] = p_[1]; R[2] = p_[128]; R[3] = p_[129]; } \
        else { const u32x4* p_ = (const u32x4*)((const bf16*)resid + (size_t)(m_) * DM + 8 * lane); R[0] = p_[0]; R[1] = p_[64]; } \
        if (has_y) { const u32x4* q_ = (const u32x4*)(y + (size_t)(m_) * DM + 8 * lane); Y[0] = q_[0]; Y[1] = q_[64]; } } while (0)
#define ROWS_DO(R, Y, SC, m_) rows_compute<RF32, XF32, WFP>(R, Y, SC, (m_), lane, has_y, gp, xout, norm_out, rs, WF, has_wf, bfl, logf)
#define RFENCE() asm volatile("" ::: "memory")
    int m = gw;
    if (m + 3 * NGW < M) {
        ROWS_LOAD(r0, y0, s0, m); ROWS_LOAD(r1, y1, s1, m + NGW); ROWS_LOAD(r2, y2, s2, m + 2 * NGW); ROWS_LOAD(r3, y3, s3, m + 3 * NGW); RFENCE();
        for (; m + 8 * NGW < M; m += 5 * NGW) {
            ROWS_LOAD(r4, y4, s4, m + 4 * NGW); RFENCE(); ROWS_DO(r0, y0, s0, m); RFENCE();
            ROWS_LOAD(r0, y0, s0, m + 5 * NGW); RFENCE(); ROWS_DO(r1, y1, s1, m + NGW); RFENCE();
            ROWS_LOAD(r1, y1, s1, m + 6 * NGW); RFENCE(); ROWS_DO(r2, y2, s2, m + 2 * NGW); RFENCE();
            ROWS_LOAD(r2, y2, s2, m + 7 * NGW); RFENCE(); ROWS_DO(r3, y3, s3, m + 3 * NGW); RFENCE();
            ROWS_LOAD(r3, y3, s3, m + 8 * NGW); RFENCE(); ROWS_DO(r4, y4, s4, m + 4 * NGW); RFENCE();
        }
        if (m + 4 * NGW < M) ROWS_LOAD(r4, y4, s4, m + 4 * NGW);
        RFENCE(); ROWS_DO(r0, y0, s0, m); RFENCE();
        if (m + 5 * NGW < M) ROWS_LOAD(r0, y0, s0, m + 5 * NGW);
        RFENCE(); ROWS_DO(r1, y1, s1, m + NGW); RFENCE();
        if (m + 6 * NGW < M) ROWS_LOAD(r1, y1, s1, m + 6 * NGW);
        RFENCE(); ROWS_DO(r2, y2, s2, m + 2 * NGW); RFENCE();
        if (m + 7 * NGW < M) ROWS_LOAD(r2, y2, s2, m + 7 * NGW);
        RFENCE(); ROWS_DO(r3, y3, s3, m + 3 * NGW); RFENCE();
        if (m + 4 * NGW < M) ROWS_DO(r4, y4, s4, m + 4 * NGW);
        if (m + 5 * NGW < M) ROWS_DO(r0, y0, s0, m + 5 * NGW);
        if (m + 6 * NGW < M) ROWS_DO(r1, y1, s1, m + 6 * NGW);
        if (m + 7 * NGW < M) ROWS_DO(r2, y2, s2, m + 7 * NGW);
        m = M;
    }
    for (; m < M; m += NGW) { ROWS_LOAD(r0, y0, s0, m); ROWS_DO(r0, y0, s0, m); }
#undef ROWS_LOAD
#undef ROWS_DO
#undef RFENCE
}

struct Args { const float* in[13]; float* out; unsigned char* ws; int ph_lo, ph_hi, li, pad; };

__global__ void __launch_bounds__(NWAVES * 64, 2) mk_fwd(Args args) {
    extern __shared__ __attribute__((aligned(16))) unsigned char lds[];
    LAS unsigned char* L = (LAS unsigned char*)lds;
    volatile LAS unsigned* MISC = (volatile LAS unsigned*)(L + MISC_OFF);
    const int G = gridDim.x; const int bx = blockIdx.x; const int vcu = (G % 8 == 0) ? (bx % 8) * (G / 8) + bx / 8 : bx;
    const int NGW = G * NWAVES;
#define PHASE_IDS() int tid_ = threadIdx.x; asm volatile("" : "+v"(tid_)); const int tid = tid_, lane = tid & 63, wave = __builtin_amdgcn_readfirstlane(tid >> 6), gw = vcu * NWAVES + wave; (void)tid; (void)lane; (void)gw
    unsigned char* ws = args.ws;
    gu32* ctl = (gu32*)(ws + WS_CTL);
    for (int u = threadIdx.x; u < (LDS_BYTES - LDSCTL_OFF) / 4; u += NWAVES * 64) ((LAS unsigned*)(L + LDSCTL_OFF))[u] = 0u;
    __syncthreads();
    XcdBarrier bar = xcd_barrier_post((unsigned*)(ctl + CW_BAR) + args.li * XCD_BAR_WORDS, MISC + 8);
    const int lo = args.ph_lo, hi = args.ph_hi;
#define IN(k) (lo <= (k) && (k) < hi)
#define SEAM(k) do { if (IN(k) && IN((k) + 1)) xcd_barrier(bar); } while (0)
    const float* x = args.in[0]; const float* w_in = args.in[1]; const float* b_f = args.in[2]; const float* conv_w = args.in[3];
    const float* w_out = args.in[4]; const float* rel_bias = args.in[5]; const float* g_pre_mix = args.in[6]; const float* g_post_mix = args.in[7];
    const float* g_pre_ffn = args.in[8]; const float* g_post_ffn = args.in[9]; const float* w_gate = args.in[10]; const float* w_up = args.in[11]; const float* w_down = args.in[12];
    float* out = args.out;
    float* LOGF = (float*)(ws + WS_LOGF); float* RS = (float*)(ws + WS_KMEAN); float* KNP = (float*)(ws + WS_CUM);
    bf16* XN = (bf16*)(ws + WS_XN); bf16* MIXIN = (bf16*)(ws + WS_MIXIN); bf16* XA = (bf16*)(ws + WS_XA); bf16* Y = (bf16*)(ws + WS_XA + 64 * MiB); bf16* P = (bf16*)(ws + WS_P); bf16* H = (bf16*)(ws + WS_H);

    if (IN(0)) { PHASE_IDS();
        LAS float* scr = (LAS float*)(L + RING_OFF + wave * 16384);
        constexpr int I_IN = (PW / 32) * (DM / 64), I_OUT = (DM / 32) * (DM / 64), I_GU = (NGU / 32) * (DM / 64), I_D = (DM / 32) * (DFF / 64), I_L = I_IN + I_OUT + I_GU + I_D;
        for (int it = gw; it < DEPTH * I_L; it += NGW) {
            const int l = it / I_L; int r = it % I_L;
            unsigned char* wl = ws + WS_W + (size_t)l * W_LAYER;
            if (r < I_IN) { const int kb = r / (PW / 32), pb = r % (PW / 32), p0 = pb * 32; const int src = p0 < 2304 ? p0 : p0 + 6;
                const float sc = (p0 < 384 || (p0 >= 1152 && p0 < 1536)) ? C2 : 1.f;
                transpose_item(w_in + (size_t)l * DM * INW, INW, kb * 64, src, sc, g_pre_mix + (size_t)l * DM, (bf16*)(wl + WO_IN) + (size_t)p0 * DM, DM, scr, lane); continue; }
            r -= I_IN;
            if (r < I_OUT) { const int kb = r / (DM / 32), pb = r % (DM / 32);
                transpose_item(w_out + (size_t)l * DM * DM, DM, kb * 64, pb * 32, 1.f, nullptr, (bf16*)(wl + WO_OUT) + (size_t)pb * 32 * DM, DM, scr, lane); continue; }
            r -= I_OUT;
            if (r < I_GU) { const int kb = r / (NGU / 32), pb = r % (NGU / 32), r0 = pb * 32; const int pn = r0 >> 8, bj = (r0 >> 7) & 1, j = r0 & 127;
                transpose_item((bj ? w_up : w_gate) + (size_t)l * DM * DFF, DFF, kb * 64, pn * 128 + j, bj ? 1.0f / LOG2E : LOG2E, g_pre_ffn + (size_t)l * DM, (bf16*)(wl + WO_GU) + (size_t)r0 * DM, DM, scr, lane); continue; }
            r -= I_GU;
            { const int kb = r / (DM / 32), pb = r % (DM / 32);
                transpose_item(w_down + (size_t)l * DFF * DM, DM, kb * 64, pb * 32, 1.f, nullptr, (bf16*)(wl + WO_D) + (size_t)pb * 32 * DFF, DFF, scr, lane); }
        }
        for (int i = gw * 64 + lane; i < DEPTH * NH * DM; i += NGW * 64) { const int l = i / (NH * DM), r = i % (NH * DM), h = r / DM, q = (r >> 8) & 3, ln = (r >> 2) & 63, k = 8 * ln + 512 * (q >> 1) + 4 * (q & 1) + (r & 3);
            ((float*)(ws + WS_W + (size_t)l * W_LAYER + WO_F))[r] = w_in[(size_t)l * DM * INW + (size_t)k * INW + 2304 + h] * g_pre_mix[(size_t)l * DM + k]; }
        __syncthreads();
        { LAS float* wfl = (LAS float*)(L + RING_OFF + 4096);
          for (int i = tid; i < NH * DM; i += NWAVES * 64) { const int k = i / NH, h = i % NH, ln = (k & 511) >> 3, q = 2 * (k >> 9) + ((k >> 2) & 1); wfl[((h * 4 + q) * 64 + ln) * 4 + (k & 3)] = w_in[(size_t)k * INW + 2304 + h] * g_pre_mix[k]; }
          __syncthreads();
          rows_phase<true, false, const LAS float*>(gw, NGW, lane, x, nullptr, nullptr, nullptr, XN, true, nullptr, (const LAS float*)wfl, true, b_f, LOGF); }
    }
    SEAM(0);
    for (int l = 0; l < DEPTH; ++l) {
        const int pb = 1 + l * NPH_LAYER;
        unsigned char* wl = ws + WS_W + (size_t)l * W_LAYER;
        const bf16* Win_t = (const bf16*)(wl + WO_IN); const bf16* Wout_t = (const bf16*)(wl + WO_OUT); const bf16* Wgu_t = (const bf16*)(wl + WO_GU); const bf16* Wd_t = (const bf16*)(wl + WO_D);
        const bool last = (l == DEPTH - 1);
        float* KM = (float*)(ws + WS_CTL + WS_KM + (size_t)l * KM_LAYER);
        if (IN(pb + 0)) { PHASE_IDS();
            for (int e = vcu * (NWAVES * 64) + tid; e < M * NH; e += G * NWAVES * 64) LOGF[e] = log_sigmoid(LOGF[e]);
            pg8::Gemm g{l == 0 ? XN : XA, Win_t, M, PW, DM}; pg8::StaticOrder S; S.init(M, PW, G, bx);
            pg8::EpiInProj E{P, PW, KM, KNP};
            pg8::gemm_phase<pg8::EpiInProj, pg8::StaticOrder, true, true>(L + RING_OFF, g, S, E);
        }
        SEAM(pb + 0);
        if (IN(pb + 1)) { PHASE_IDS();
            constexpr int NATT = 2 * BATCH * NH * NBLK, NCONV = M / 128, NUNITS = NATT + NCONV;
            char* shm = (char*)lds + RING_OFF;
            attn_body::lds_cptr aux = (attn_body::lds_cptr)(L + AUX_OFF);
            LAS float* auxR0 = (LAS float*)(L + AUX_OFF + attn_body::AUX_R0); LAS unsigned* auxInfo = (LAS unsigned*)(L + AUX_OFF + attn_body::AUX_INFO); LAS float* auxTab = (LAS float*)(L + AUX_OFF + attn_body::AUX_TAB);
            LAS float* wtot = (LAS float*)(L + AUX_OFF + attn_body::AUX_TAB + 16384);
            const float* cw = conv_w + (size_t)l * 3 * CCH;
            int idx = bx, iter = 0; unsigned nA = (unsigned)(bx + G);
            while (idx < NUNITS) {
                if (tid == 0) { MISC[16 + ((iter + 1) & 1)] = nA; nA = __hip_atomic_fetch_add(ctl + CW_Q + 64 * l, 1u, RLX_AGENT) + 2u * (unsigned)G; }
                int tq = threadIdx.x; asm volatile("" : "+v"(tq));
                if (idx < NATT) {
                const int kind = idx < NATT / 2 ? 1 : 0, ia = idx - (kind ? 0 : NATT / 2), qb = (NBLK - 1) - ia / (BATCH * NH), bh = ia % (BATCH * NH), b = bh / NH, h = bh % NH;
                const int q0 = qb * MBLK; const size_t row0 = (size_t)b * SEQ;
                const int prow = tq >> 1, half = tq & 1;
                const int cq = kind == 0 ? P_FQ : P_MQ, ck = kind == 0 ? P_FK : P_MK, cv = kind == 0 ? P_FV : P_MV;
                const bf16* Qg = P + (row0 + q0) * PW + cq + h * HD; const bf16* Kb = P + row0 * PW + ck + h * HD; const bf16* Vb = P + row0 * PW + cv + h * HD;
                bf16* Og = MIXIN + (row0 + q0) * DM + (kind == 0 ? 384 : 0) + h * HD;
                int tile0 = 0;
                if (kind == 0) {
                    const int k0 = tile0 * 64, kend = q0 + MBLK, kb = k0 + 8 * tq;
                    float loc[8]; float run = 0.f;
#pragma unroll
                    for (int i = 0; i < 8; ++i) { const int key = kb + i; const float v = key < kend ? LOGF[(row0 + key) * NH + h] : 0.f; run += v; loc[i] = run; }
                    float incl = run;
#pragma unroll
                    for (int o = 1; o < 64; o <<= 1) { const float t = __shfl_up(incl, o); if ((tq & 63) >= o) incl += t; }
                    if ((tq & 63) == 63) wtot[tq >> 6] = incl;
                    __syncthreads();
                    float off = incl - run; for (int w = 0; w < (tq >> 6); ++w) off += wtot[w];
#pragma unroll
                    for (int i = 0; i < 8; ++i) { const int key = kb + i; if (key < kend) auxTab[key] = (off + loc[i]) * LOG2E; }
                } else {
                    const float bfar = rel_bias[31 * NH + h];
                    if (tq <= 128) auxTab[tq] = (rel_bias[c_bucket[tq] * NH + h] - bfar) * LOG2E;
                    for (int i = tq; i < qb * HD; i += NWAVES * 64) auxTab[256 + i] = KM[(size_t)bh * NBLK * HD + i];
                }
                __syncthreads();
                if (kind == 0) {
                    const bf16* qp = Qg + (size_t)prow * PW + half * 32; const bf16* kp = Kb + (size_t)(q0 + prow) * PW + half * 32; float d = 0.f, qq = 0.f;
#pragma unroll
                    for (int c = 0; c < 4; ++c) { const bf16x8 qv = *(const bf16x8*)(qp + 8 * c), kv = *(const bf16x8*)(kp + 8 * c);
#pragma unroll
                        for (int j = 0; j < 8; ++j) { const float qf = bf2f((unsigned short)qv[j]); d += qf * bf2f((unsigned short)kv[j]); qq += qf * qf; } }
                    d += DPPX(d, 0xB1); qq += DPPX(qq, 0xB1);
                    float u2 = (auxTab[q0 + prow] - auxTab[q0]) - d;
#pragma unroll
                    for (int o = 2; o < 64; o <<= 1) { qq = fmaxf(qq, __shfl_xor(qq, o)); u2 = fmaxf(u2, __shfl_xor(u2, o)); }
                    if ((tq & 63) == 0) { wtot[8 + (tq >> 6)] = qq; wtot[16 + (tq >> 6)] = u2; }
                    if (tq == 0) ((LAS unsigned*)wtot)[24] = (unsigned)(4 * qb);
                    __syncthreads();
                    float U1 = wtot[8], U2 = wtot[16];
#pragma unroll
                    for (int w = 1; w < 8; ++w) { U1 = fmaxf(U1, wtot[8 + w]); U2 = fmaxf(U2, wtot[16 + w]); }
                    U1 = sqrtf(U1) * 1.0001f;
                    if (tq < 4 * qb) { const float* kn = KNP + ((size_t)bh * 64 + tq) * 2; const float bound = U1 * sqrtf(kn[0] + kn[1]) + U2 + (auxTab[q0] - auxTab[64 * tq + 63]);
                        if (!(bound <= -PRUNE_TH)) __hip_atomic_fetch_min((LAS unsigned*)wtot + 24, (unsigned)tq, __ATOMIC_RELAXED, __HIP_MEMORY_SCOPE_WORKGROUP); }
                    __syncthreads();
                    tile0 = (int)(((LAS unsigned*)wtot)[24] & ~1u);
                }
                {   const bf16* qp = Qg + (size_t)prow * PW + half * 32; const bf16* kp = Kb + (size_t)(q0 + prow) * PW + half * 32; float q[32]; float d = 0.f;
#pragma unroll
                    for (int c = 0; c < 4; ++c) { const bf16x8 qv = *(const bf16x8*)(qp + 8 * c), kv = *(const bf16x8*)(kp + 8 * c);
#pragma unroll
                        for (int j = 0; j < 8; ++j) { q[8 * c + j] = bf2f((unsigned short)qv[j]); d += q[8 * c + j] * bf2f((unsigned short)kv[j]); } }
                    d += DPPX(d, 0xB1);
                    if (kind == 0) { if (half == 0) { auxR0[prow] = d - auxTab[q0 + prow]; auxInfo[prow] = 0u; } }
                    else {
                        int s0 = -1, s1 = -1, s2 = -1; float g0 = -INFINITY, g1 = -INFINITY, g2 = -INFINITY;
                        for (int n = 0; n < qb; ++n) { const LAS f32x4* km = (const LAS f32x4*)(auxTab + 256 + n * HD + half * 32); float g = 0.f;
#pragma unroll
                            for (int j = 0; j < 8; ++j) { const f32x4 kk = km[j]; g += (q[4 * j] * kk.x + q[4 * j + 1] * kk.y) + (q[4 * j + 2] * kk.z + q[4 * j + 3] * kk.w); }
                            g += DPPX(g, 0xB1);
                            if (g > g0) { g2 = g1; s2 = s1; g1 = g0; s1 = s0; g0 = g; s0 = n; } else if (g > g1) { g2 = g1; s2 = s1; g1 = g; s1 = n; } else if (g > g2) { g2 = g; s2 = n; } }
                        unsigned msk = 0u; if (s0 >= 0) msk |= 1u << s0; if (s1 >= 0) msk |= 1u << s1; if (s2 >= 0) msk |= 1u << s2;
                        if (half == 0) { auxR0[prow] = d + auxTab[0]; auxInfo[prow] = msk; }
                    }
                }
                __syncthreads();
                if (kind == 0) attn_body::attn_unit<0, 8>((const attn_body::bf16*)Qg, (const attn_body::bf16*)(Kb + (size_t)tile0 * 64 * PW), (const attn_body::bf16*)(Vb + (size_t)tile0 * 64 * PW), (attn_body::bf16*)Og, 4 * (qb + 1) - tile0, tile0, q0, qb, shm, aux);
                else attn_body::attn_unit<1, 8>((const attn_body::bf16*)Qg, (const attn_body::bf16*)Kb, (const attn_body::bf16*)Vb, (attn_body::bf16*)Og, 4 * (qb + 1), 0, q0, qb, shm, aux);
                } else {
                    const int cg = tq & 31, rg = tq >> 5; const size_t r0 = (size_t)(idx - NATT) * 128 + rg * 8; const int c0 = cg * 8;
                    float w0[8], w1[8], w2[8], u2[8], u1[8];
#pragma unroll
                    for (int j = 0; j < 8; ++j) { w0[j] = cw[c0 + j]; w1[j] = cw[CCH + c0 + j]; w2[j] = cw[2 * CCH + c0 + j]; u2[j] = 0.f; u1[j] = 0.f; }
                    if ((r0 % SEQ) != 0) {
                        const bf16x8 a2 = *(const bf16x8*)(P + (r0 - 2) * PW + P_CC + c0), h2 = *(const bf16x8*)(P + (r0 - 2) * PW + P_CH + c0);
                        const bf16x8 a1 = *(const bf16x8*)(P + (r0 - 1) * PW + P_CC + c0), h1 = *(const bf16x8*)(P + (r0 - 1) * PW + P_CH + c0);
#pragma unroll
                        for (int j = 0; j < 8; ++j) { u2[j] = bf2f((unsigned short)a2[j]) * bf2f((unsigned short)h2[j]); u1[j] = bf2f((unsigned short)a1[j]) * bf2f((unsigned short)h1[j]); }
                    }
#pragma unroll
                    for (int rr = 0; rr < 8; ++rr) { const size_t m = r0 + rr;
                        const bf16x8 a = *(const bf16x8*)(P + m * PW + P_CC + c0), hh = *(const bf16x8*)(P + m * PW + P_CH + c0), bb = *(const bf16x8*)(P + m * PW + P_CB + c0);
                        float o8[8];
#pragma unroll
                        for (int j = 0; j < 8; ++j) { const float u0 = bf2f((unsigned short)a[j]) * bf2f((unsigned short)hh[j]); o8[j] = bf2f((unsigned short)bb[j]) * (w0[j] * u2[j] + w1[j] * u1[j] + w2[j] * u0); u2[j] = u1[j]; u1[j] = u0; }
                        u32x4 w; w.x = pk2(o8[0], o8[1]); w.y = pk2(o8[2], o8[3]); w.z = pk2(o8[4], o8[5]); w.w = pk2(o8[6], o8[7]);
                        *(u32x4*)(MIXIN + m * DM + 768 + c0) = w; }
                    __syncthreads();
                }
                idx = (int)MISC[16 + ((iter + 1) & 1)]; ++iter;
            }
        }
        SEAM(pb + 1);
        if (IN(pb + 2)) { PHASE_IDS();
            pg8::Gemm g{MIXIN, Wout_t, M, DM, DM}; pg8::StaticOrder S; S.init(M, DM, G, bx);
            pg8::EpiStoreBf16 E{Y, DM};
            pg8::gemm_phase<pg8::EpiStoreBf16, pg8::StaticOrder, true, true>(L + RING_OFF, g, S, E);
        }
        SEAM(pb + 2);
        if (IN(pb + 3)) { PHASE_IDS();
            if (l == 0) rows_phase<true, false, const float*>(gw, NGW, lane, x, nullptr, Y, g_post_mix + (size_t)l * DM, XA, true, RS, (const float*)nullptr, false, nullptr, nullptr);
            else rows_phase<false, false, const float*>(gw, NGW, lane, XA, RS, Y, g_post_mix + (size_t)l * DM, XA, true, RS, (const float*)nullptr, false, nullptr, nullptr);
        }
        SEAM(pb + 3);
        if (IN(pb + 4)) { PHASE_IDS();
            pg8::Gemm g{XA, Wgu_t, M, NGU, DM}; pg8::StaticOrder S; S.init(M, NGU, G, bx);
            pg8::EpiSwiGLU E{H, DFF};
            pg8::gemm_phase<pg8::EpiSwiGLU, pg8::StaticOrder, true, true>(L + RING_OFF, g, S, E);
        }
        SEAM(pb + 4);
        if (IN(pb + 5)) { PHASE_IDS();
            pg8::Gemm g{H, Wd_t, M, DM, DFF}; pg8::StaticOrder S; S.init(M, DM, G, bx);
            pg8::EpiStoreBf16 E{Y, DM};
            pg8::gemm_phase<pg8::EpiStoreBf16, pg8::StaticOrder, true, true>(L + RING_OFF, g, S, E);
        }
        SEAM(pb + 5);
        if (IN(pb + 6)) { PHASE_IDS();
            if (!last) { const float* WFn = (const float*)(ws + WS_W + (size_t)(l + 1) * W_LAYER + WO_F);
                rows_phase<false, false, const float*>(gw, NGW, lane, XA, RS, Y, g_post_ffn + (size_t)l * DM, XA, true, RS, WFn, true, b_f + (size_t)(l + 1) * NH, LOGF); }
            else rows_phase<false, true, const float*>(gw, NGW, lane, XA, RS, Y, g_post_ffn + (size_t)l * DM, out, false, nullptr, (const float*)nullptr, false, nullptr, nullptr);
        }
        SEAM(pb + 6);
    }
#undef IN
#undef SEAM
}

#ifndef MK_MODE
#define MK_MODE 2
#endif
extern "C" void kernel_launch(void* const* d_in, const int* in_sizes, int n_in, void* d_out, int out_size, void* d_ws, size_t ws_size, hipStream_t stream) {
    if (n_in != 13 || in_sizes[0] != M * DM || out_size != M * DM || ws_size < WS_END) { fprintf(stderr, "kernel_launch: unexpected shapes (n_in %d, in0 %d, out %d, ws %zu)\n", n_in, n_in > 0 ? in_sizes[0] : -1, out_size, ws_size); return; }
    static int grid = 0;
    if (grid == 0) {
        int dev = 0, cus = 0, per_cu = 0;
        if (hipGetDevice(&dev) != hipSuccess || hipDeviceGetAttribute(&cus, hipDeviceAttributeMultiprocessorCount, dev) != hipSuccess) { fprintf(stderr, "kernel_launch: device query failed\n"); grid = -1; return; }
        if (hipFuncSetAttribute((const void*)mk_fwd, hipFuncAttributeMaxDynamicSharedMemorySize, LDS_BYTES) != hipSuccess) { fprintf(stderr, "kernel_launch: hipFuncSetAttribute failed\n"); grid = -1; return; }
        if (hipOccupancyMaxActiveBlocksPerMultiprocessor(&per_cu, (const void*)mk_fwd, NWAVES * 64, LDS_BYTES) != hipSuccess || per_cu < 1) fprintf(stderr, "kernel_launch: occupancy query reports %d\n", per_cu);
        (void)hipGetLastError();
        grid = cus;
    }
    if (grid < 0) return;
    if (hipMemsetAsync((char*)d_ws + WS_CTL, 0, CTL_ZERO_BYTES, stream) != hipSuccess) { fprintf(stderr, "kernel_launch: hipMemsetAsync of the control words failed; nothing launched\n"); return; }
    Args a{};
    for (int i = 0; i < 13; ++i) a.in[i] = (const float*)d_in[i];
    a.out = (float*)d_out; a.ws = (unsigned char*)d_ws;
#if MK_MODE == 2
    a.ph_lo = 0; a.ph_hi = NPH; a.li = 0;
    hipLaunchKernelGGL(mk_fwd, dim3(grid), dim3(NWAVES * 64), LDS_BYTES, stream, a);
#else
    for (int p = 0; p < NPH; ++p) { a.ph_lo = p; a.ph_hi = p + 1; a.li = p; hipLaunchKernelGGL(mk_fwd, dim3(grid), dim3(NWAVES * 64), LDS_BYTES, stream, a); }
#endif
}
```
